# Optimizing an MI355X kernel written in HIP

```python
import jax
import jax.numpy as jnp
from jax import lax
import numpy as np

D_MODEL = 1024
BATCH = 16
SEQ = 4096
DEPTH = 4

GRID_W = 64
CTX_LEN = 256
EPS = 1e-6
F32 = jnp.float32
A_HEADS = 4
A_DK = 128
A_DV = 128
A_WIDTH = A_HEADS * A_DK
A_VWIDTH = A_HEADS * A_DV
CHUNK = 64
B_HEADS = 8
B_KV_HEADS = 2
B_HD = 64
B_GROUP = B_HEADS // B_KV_HEADS
B_WIDTH = B_HEADS * B_HD
B_KV_WIDTH = B_KV_HEADS * B_HD
Q_BLOCK = 128
ROPE_THETA = 10000.0
AXIS_DIM = B_HD // 2
N_GROUPS = 4
EXPERTS_PER_GROUP = 8
N_EXPERTS = N_GROUPS * EXPERTS_PER_GROUP
TOP_K = 2
D_EXPERT = 512
ROW_BLOCK = 128
IN_SIZES = (A_WIDTH, A_WIDTH, A_WIDTH, A_VWIDTH, A_VWIDTH, B_WIDTH, B_KV_WIDTH, B_KV_WIDTH, D_MODEL, D_MODEL)
D_IN = A_WIDTH * 3 + A_VWIDTH * 2 + B_WIDTH + 2 * B_KV_WIDTH + 2 * D_MODEL
N_MOD = 6

kernel_name = 'hybrid_hgrn2_gqa_hier_moe_dit'


def rmsnorm(x, g):
    xf = x.astype(F32)
    y = xf * lax.rsqrt(jnp.mean(xf * xf, axis=-1, keepdims=True) + EPS)
    return (y * g.astype(F32)).astype(x.dtype)


def split_in(z):
    parts, off = [], 0
    for s in IN_SIZES:
        parts.append(z[..., off:off + s])
        off += s
    return parts


def to_heads(t, n_heads):
    bsz, n, w = t.shape
    return t.reshape(bsz, n, n_heads, w // n_heads).transpose(0, 2, 1, 3)


def from_heads(t):
    bsz, h, n, d = t.shape
    return t.transpose(0, 2, 1, 3).reshape(bsz, n, h * d)


def axial_rope_tables(rows):
    t = jnp.arange(rows * GRID_W)
    r = (t // GRID_W).astype(F32)
    col = (t % GRID_W).astype(F32)
    inv = ROPE_THETA ** (-jnp.arange(0, AXIS_DIM, 2, dtype=F32) / AXIS_DIM)
    ang = jnp.stack([r[:, None] * inv, col[:, None] * inv], axis=1)
    return jnp.cos(ang), jnp.sin(ang)


def apply_rope(x, cos, sin):
    shp = x.shape
    xa = x.astype(F32).reshape(shp[:-1] + (2, 2, AXIS_DIM // 2))
    x1, x2 = xa[..., 0, :], xa[..., 1, :]
    out = jnp.stack([x1 * cos - x2 * sin, x2 * cos + x1 * sin], axis=-2)
    return out.reshape(shp).astype(x.dtype)


def hgrn_gates(zf, lb):
    zf = zf.astype(F32)
    logf = jnp.logaddexp(jnp.log(lb), jnp.log1p(-lb) + jax.nn.log_sigmoid(zf))
    k = (1.0 - lb) * jax.nn.sigmoid(-zf)
    return k, logf


def gla_final_state(k, v, logf):
    b = jnp.cumsum(logf, axis=-2)
    return jnp.einsum('bhsk,bhsv->bhkv', k * jnp.exp(b[..., -1:, :] - b), v)


def gla_chunk_scan(q, k, v, logf, s0):
    bsz, h, n, _ = q.shape
    dv = v.shape[-1]
    nc = n // CHUNK

    def chunks(t):
        return jnp.moveaxis(t.reshape(bsz, h, nc, CHUNK, t.shape[-1]), 2, 0)

    lower = jnp.tril(jnp.ones((CHUNK, CHUNK), bool))[:, :, None]

    def step(state, inp):
        qc, kc, vc, lfc = inp
        b = jnp.cumsum(lfc, axis=-2)
        o_inter = jnp.einsum('bhtk,bhkv->bhtv', qc * jnp.exp(b), state)
        diff = b[..., :, None, :] - b[..., None, :, :]
        decay = jnp.exp(jnp.where(lower, diff, -jnp.inf))
        scores = jnp.einsum('bhtk,bhsk,bhtsk->bhts', qc, kc, decay)
        o_intra = jnp.einsum('bhts,bhsv->bhtv', scores, vc)
        b_last = b[..., -1:, :]
        new_state = jnp.exp(b_last[..., 0, :])[..., None] * state + jnp.einsum('bhsk,bhsv->bhkv', kc * jnp.exp(b_last - b), vc)
        return new_state, o_inter + o_intra

    _, o = lax.scan(step, s0, (chunks(q), chunks(k), chunks(v), chunks(logf)))
    return jnp.moveaxis(o, 0, 2).reshape(bsz, h, n, dv)


def gated_head_norm(o, gz, g):
    bsz, h, n, dv = o.shape
    o = o.transpose(0, 2, 1, 3)
    o = o * lax.rsqrt(jnp.mean(o * o, axis=-1, keepdims=True) + EPS) * g.astype(F32).reshape(h, dv)
    gate = jax.nn.silu(gz.astype(F32)).reshape(bsz, n, h, dv)
    return (o * gate).reshape(bsz, n, h * dv).astype(gz.dtype)


def hgrn2_mixer(parts_lat, parts_ctx, lb_fwd, lb_bwd, norm_g, need_ctx):
    def prep(qz, ffz, fbz, iz):
        q = jax.nn.silu(to_heads(qz, A_HEADS).astype(F32)) * (A_DK ** -0.5)
        v = to_heads(iz, A_HEADS).astype(F32)
        kf, lf = hgrn_gates(to_heads(ffz, A_HEADS), lb_fwd)
        kb, lbw = hgrn_gates(to_heads(fbz, A_HEADS), lb_bwd)
        return q, v, kf, lf, kb, lbw

    def flip(t):
        return jnp.flip(t, axis=-2)

    ql, vl, kfl, lfl, kbl, lbl = prep(*parts_lat[:4])
    qc, vc, kfc, lfc, kbc, lbc = prep(*parts_ctx[:4])
    s_fwd = gla_final_state(kfc, vc, lfc)
    s_bwd = gla_final_state(flip(kbc), flip(vc), flip(lbc))
    o_lat = gla_chunk_scan(ql, kfl, vl, lfl, s_fwd) + flip(gla_chunk_scan(flip(ql), flip(kbl), flip(vl), flip(lbl), s_bwd))
    out_lat = gated_head_norm(o_lat, parts_lat[4], norm_g)
    if not need_ctx:
        return out_lat, None
    zero = jnp.zeros_like(s_fwd)
    o_ctx = gla_chunk_scan(qc, kfc, vc, lfc, zero) + flip(gla_chunk_scan(flip(qc), flip(kbc), flip(vc), flip(lbc), zero))
    return out_lat, gated_head_norm(o_ctx, parts_ctx[4], norm_g)


def attend(q, k, v):
    s = jnp.einsum('bkgqd,bkld->bkgql', q, k).astype(F32) * (B_HD ** -0.5)
    p = jax.nn.softmax(s, axis=-1).astype(v.dtype)
    return jnp.einsum('bkgql,bkld->bkgqd', p, v)


def gqa_mixer(parts_lat, parts_ctx, q_norm_g, k_norm_g, cos, sin, need_ctx):
    def prep(qz, kz, vz):
        q = rmsnorm(to_heads(qz, B_HEADS), q_norm_g)
        k = rmsnorm(to_heads(kz, B_KV_HEADS), k_norm_g)
        v = to_heads(vz, B_KV_HEADS)
        return q, k, v

    ql, kl, vl = prep(*parts_lat[5:8])
    qc, kc, vc = prep(*parts_ctx[5:8])
    ql = apply_rope(ql, cos, sin)
    kl = apply_rope(kl, cos, sin)
    k_all = jnp.concatenate([kc, kl], axis=2)
    v_all = jnp.concatenate([vc, vl], axis=2)
    bsz, _, n, _ = ql.shape
    nb = n // Q_BLOCK
    qg = jnp.moveaxis(ql.reshape(bsz, B_KV_HEADS, B_GROUP, nb, Q_BLOCK, B_HD), 3, 0)
    o = lax.map(lambda qb: attend(qb, k_all, v_all), qg)
    o = jnp.moveaxis(o, 0, 3).reshape(bsz, B_HEADS, n, B_HD)
    out_lat = from_heads(o)
    if not need_ctx:
        return out_lat, None
    l = qc.shape[2]
    oc = attend(qc.reshape(bsz, B_KV_HEADS, B_GROUP, l, B_HD), kc, vc).reshape(bsz, B_HEADS, l, B_HD)
    return out_lat, from_heads(oc)


def hier_moe(xf, w_rg, b_rg, w_re, b_re, w_gate, w_up, w_down):
    t, d = xf.shape
    glog = (xf @ w_rg).astype(F32) + b_rg.astype(F32)
    gsel = jnp.argmax(glog, axis=-1)
    p_group = jnp.take_along_axis(jax.nn.softmax(glog, axis=-1), gsel[:, None], axis=1)[:, 0]
    elog_all = ((xf @ w_re).astype(F32) + b_re.astype(F32)).reshape(t, N_GROUPS, EXPERTS_PER_GROUP)
    elog = jnp.take_along_axis(elog_all, gsel[:, None, None], axis=1)[:, 0]
    top_p, top_i = lax.top_k(jax.nn.softmax(elog, axis=-1), TOP_K)
    weights = top_p / jnp.sum(top_p, axis=-1, keepdims=True) * p_group[:, None]
    expert_id = (gsel[:, None].astype(jnp.int32) * EXPERTS_PER_GROUP + top_i.astype(jnp.int32)).reshape(-1)
    m = t * TOP_K
    n_blocks = (m + ROW_BLOCK - 1) // ROW_BLOCK + N_EXPERTS
    r = n_blocks * ROW_BLOCK
    order = jnp.argsort(expert_id)
    e_sorted = expert_id[order]
    tok_sorted = (order // TOP_K).astype(jnp.int32)
    w_sorted = weights.reshape(-1)[order]
    counts = jnp.bincount(expert_id, length=N_EXPERTS)
    padded = (counts + ROW_BLOCK - 1) // ROW_BLOCK * ROW_BLOCK
    pad_end = jnp.cumsum(padded)
    start = jnp.cumsum(counts) - counts
    dest = (pad_end - padded)[e_sorted] + jnp.arange(m) - start[e_sorted]
    row_tok = jnp.full((r,), t, jnp.int32).at[dest].set(tok_sorted)
    row_w = jnp.zeros((r,), F32).at[dest].set(w_sorted)
    block_e = jnp.minimum(jnp.searchsorted(pad_end, jnp.arange(n_blocks) * ROW_BLOCK, side='right'), N_EXPERTS - 1)
    x_pad = jnp.concatenate([xf, jnp.zeros((1, d), xf.dtype)], axis=0)

    def expert_block(args):
        toks, wts, e = args
        xb = x_pad[toks]
        hb = jax.nn.silu(xb @ w_gate[e]) * (xb @ w_up[e])
        return (hb @ w_down[e]) * wts[:, None].astype(xf.dtype)

    yb = lax.map(expert_block, (row_tok.reshape(n_blocks, ROW_BLOCK), row_w.reshape(n_blocks, ROW_BLOCK), block_e))
    y = jax.ops.segment_sum(yb.reshape(r, d), row_tok, num_segments=t + 1)
    return y[:t]


def trunk_layer(h, hc, mod_lat, mod_ctx, cos, sin, norm1_g, norm2_g, w_in, lb_fwd, lb_bwd, hgrn_norm_g,
                q_norm_g, k_norm_g, w_up_a, w_up_b, w_out, w_rg, b_rg, w_re, b_re, w_gate, w_up, w_down, need_ctx):
    sh1, sc1, g1, sh2, sc2, g2 = jnp.split(mod_lat, N_MOD, axis=-1)
    csh1, csc1, cg1, csh2, csc2, cg2 = jnp.split(mod_ctx, N_MOD, axis=-1)
    xl = rmsnorm(h, norm1_g) * (1.0 + sc1) + sh1
    xc = rmsnorm(hc, norm1_g) * (1.0 + csc1) + csh1
    pl = split_in(xl @ w_in)
    pc = split_in(xc @ w_in)
    a_l, a_c = hgrn2_mixer(pl, pc, lb_fwd, lb_bwd, hgrn_norm_g, need_ctx)
    b_l, b_c = gqa_mixer(pl, pc, q_norm_g, k_norm_g, cos, sin, need_ctx)

    def merge(parts, ya, yb):
        return (jax.nn.sigmoid(parts[8]) * (ya @ w_up_a) + jax.nn.sigmoid(parts[9]) * (yb @ w_up_b)) @ w_out

    h = h + g1 * merge(pl, a_l, b_l)
    if need_ctx:
        hc = hc + cg1 * merge(pc, a_c, b_c)
    bsz, n, d = h.shape
    xl2 = rmsnorm(h, norm2_g) * (1.0 + sc2) + sh2
    if need_ctx:
        xc2 = rmsnorm(hc, norm2_g) * (1.0 + csc2) + csh2
        tokens = jnp.concatenate([xl2.reshape(-1, d), xc2.reshape(-1, d)], axis=0)
        y = hier_moe(tokens, w_rg, b_rg, w_re, b_re, w_gate, w_up, w_down)
        h = h + g2 * y[:bsz * n].reshape(bsz, n, d)
        hc = hc + cg2 * y[bsz * n:].reshape(hc.shape)
    else:
        y = hier_moe(xl2.reshape(-1, d), w_rg, b_rg, w_re, b_re, w_gate, w_up, w_down)
        h = h + g2 * y.reshape(bsz, n, d)
    return h, hc


def setup_inputs(seed: int = 0) -> dict:
    key = jax.random.key(seed)
    ks = jax.random.split(key, 24)

    def nrm(k, shape, scale):
        return jax.random.normal(k, shape, F32) * scale

    def gain(k, shape):
        return 1.0 + 0.05 * jax.random.normal(k, shape, F32)

    return {
        'x': nrm(ks[0], (BATCH, SEQ, D_MODEL), 1.0),
        'c': nrm(ks[1], (BATCH, D_MODEL), 1.0),
        'ctx': nrm(ks[2], (BATCH, CTX_LEN, D_MODEL), 1.0),
        'c_ctx': nrm(ks[3], (D_MODEL,), 1.0),
        'w_ada': nrm(ks[4], (DEPTH, D_MODEL, N_MOD * D_MODEL), 0.3 * D_MODEL ** -0.5),
        'b_ada': nrm(ks[5], (DEPTH, N_MOD * D_MODEL), 0.02),
        'norm1_g': gain(ks[6], (DEPTH, D_MODEL)),
        'norm2_g': gain(ks[7], (DEPTH, D_MODEL)),
        'w_in': nrm(ks[8], (DEPTH, D_MODEL, D_IN), D_MODEL ** -0.5),
        'lb_logits': nrm(ks[9], (2, DEPTH, A_WIDTH), 0.5),
        'hgrn_norm_g': gain(ks[10], (DEPTH, A_VWIDTH)),
        'q_norm_g': gain(ks[11], (DEPTH, B_HD)),
        'k_norm_g': gain(ks[12], (DEPTH, B_HD)),
        'w_up_a': nrm(ks[13], (DEPTH, A_VWIDTH, D_MODEL), A_VWIDTH ** -0.5),
        'w_up_b': nrm(ks[14], (DEPTH, B_WIDTH, D_MODEL), B_WIDTH ** -0.5),
        'w_out': nrm(ks[15], (DEPTH, D_MODEL, D_MODEL), D_MODEL ** -0.5),
        'w_router_group': nrm(ks[16], (DEPTH, D_MODEL, N_GROUPS), D_MODEL ** -0.5),
        'b_router_group': nrm(ks[17], (DEPTH, N_GROUPS), 0.01),
        'w_router_expert': nrm(ks[18], (DEPTH, D_MODEL, N_EXPERTS), D_MODEL ** -0.5),
        'b_router_expert': nrm(ks[19], (DEPTH, N_EXPERTS), 0.01),
        'w_gate': nrm(ks[20], (DEPTH, N_EXPERTS, D_MODEL, D_EXPERT), D_MODEL ** -0.5),
        'w_up': nrm(ks[21], (DEPTH, N_EXPERTS, D_MODEL, D_EXPERT), D_MODEL ** -0.5),
        'w_down': nrm(ks[22], (DEPTH, N_EXPERTS, D_EXPERT, D_MODEL), D_EXPERT ** -0.5),
        'final_norm_g': gain(ks[23], (D_MODEL,)),
    }


def reference(x, c, ctx, c_ctx, w_ada, b_ada, norm1_g, norm2_g, w_in, lb_logits, hgrn_norm_g, q_norm_g,
              k_norm_g, w_up_a, w_up_b, w_out, w_router_group, b_router_group, w_router_expert,
              b_router_expert, w_gate, w_up, w_down, final_norm_g):
    rows = x.shape[1] // GRID_W
    cos, sin = axial_rope_tables(rows)
    lb = jnp.cumsum(jax.nn.softmax(lb_logits.astype(F32), axis=1), axis=1)
    lb = lb - lb[:, :1]
    c_act = jax.nn.silu(c)
    cc_act = jax.nn.silu(c_ctx)
    h, hc = x, ctx
    for l in range(DEPTH):
        mod_lat = (c_act @ w_ada[l] + b_ada[l])[:, None, :]
        mod_ctx = cc_act @ w_ada[l] + b_ada[l]
        h, hc = trunk_layer(h, hc, mod_lat, mod_ctx, cos, sin, norm1_g[l], norm2_g[l], w_in[l],
                            lb[0, l].reshape(A_HEADS, 1, A_DK), lb[1, l].reshape(A_HEADS, 1, A_DK),
                            hgrn_norm_g[l], q_norm_g[l], k_norm_g[l], w_up_a[l], w_up_b[l], w_out[l],
                            w_router_group[l], b_router_group[l], w_router_expert[l], b_router_expert[l],
                            w_gate[l], w_up[l], w_down[l], l < DEPTH - 1)
    return rmsnorm(h, final_norm_g)
```

```cpp
#include <hip/hip_runtime.h>
#include <hip/hip_bf16.h>
#include <cstdio>
#include <cstdint>
#include <cmath>

#ifndef MK_PER_PHASE
#define MK_PER_PHASE 0
#endif

constexpr int D = 1024, NBATCH = 16, SEQ = 4096, CTXL = 256, DEPTH = 4;
constexpr int TL = NBATCH * SEQ, TC = NBATCH * CTXL, TT = TL + TC;
constexpr int NZ = 5376, KVLEN = CTXL + SEQ;
constexpr int NEXP = 32, DEXP = 512, RCAP = 2 * TT + NEXP * 256;
constexpr int NCHUNK = TT / 64;
constexpr float EPSN = 1e-6f;
constexpr float QC2 = 0.125f * 1.4426950408889634f;

constexpr size_t MiB = 1u << 20;
constexpr size_t WS_CTL = 0, CTL_ZERO_BYTES = 1 * MiB;
constexpr size_t WS_MOD = 1 * MiB;
constexpr size_t WS_TAB = 3 * MiB;
constexpr size_t WS_WR = 4 * MiB;
constexpr size_t WR_CVEC = (size_t)17 * 1024 * 48 * 4;
constexpr size_t WS_RT = 8 * MiB;
constexpr size_t RT_INFO = 0;
constexpr size_t RT_W = RT_INFO + (size_t)TT * 16;
constexpr size_t RT_DEST = RT_W + (size_t)TT * 8;
constexpr size_t RT_CNT = RT_DEST + (size_t)TT * 8;
constexpr size_t RT_OFF = RT_CNT + 256 * 32 * 4;
constexpr size_t RT_ROWTOK = RT_OFF + 256;
constexpr size_t RT_ROWW = RT_ROWTOK + (size_t)RCAP * 4;
static_assert(RT_ROWW + (size_t)RCAP * 4 <= 4 * MiB, "routing arrays");
constexpr size_t WS_HC = 12 * MiB;
constexpr size_t WS_W = 28 * MiB;
constexpr size_t W_IN = 0;
constexpr size_t W_IN8 = W_IN + (size_t)3328 * 1024 * 2;
constexpr size_t W_UP = W_IN + (size_t)NZ * 1024 * 2;
constexpr size_t W_OUT = W_UP + (size_t)1024 * 1024 * 2;
constexpr size_t W_GU = W_OUT + (size_t)1024 * 1024 * 2;
constexpr size_t W_PSTRIDE = 47 * MiB;
constexpr size_t W_DN0 = WS_W + 94 * MiB, W_DN1 = 1206 * MiB;
static_assert(W_GU + (size_t)32 * 1024 * 1024 <= W_PSTRIDE && W_DN0 + 16 * MiB <= 139 * MiB, "weights");
constexpr size_t WS_XN = 139 * MiB;
constexpr size_t WS_Z = 275 * MiB;
constexpr size_t SZ512 = (size_t)TT * 512 * 2;
constexpr size_t Z_QF = WS_Z, Z_KF = Z_QF + SZ512, Z_QB = Z_KF + SZ512, Z_KB = Z_QB + SZ512, Z_VA = Z_KB + SZ512, Z_OG = Z_VA + SZ512;
constexpr size_t Z_Y2 = Z_OG + SZ512;
constexpr size_t Z_OB = Z_Y2 + 2 * SZ512;
constexpr size_t Z_KG = Z_OB + SZ512;
constexpr size_t Z_VG = Z_KG + (size_t)NBATCH * KVLEN * 128 * 2;
constexpr size_t Z_SG = Z_VG + (size_t)NBATCH * KVLEN * 128 * 2;
constexpr size_t Z_DEC = Z_SG + (size_t)TT * 2048 * 2;
constexpr size_t WS_END = Z_DEC + (size_t)NCHUNK * 2 * 3 * 512 * 4;
constexpr size_t Z_H = WS_Z;
constexpr size_t Z_YB = Z_H + (size_t)RCAP * 512 * 2;
static_assert(Z_YB + (size_t)RCAP * 1024 * 2 <= Z_SG, "MoE overlay");
constexpr size_t WS_NEED = W_DN1 + 16 * MiB;
static_assert(WS_END <= W_DN1 && WS_NEED <= (size_t)1252 * MiB, "d_ws budget");
constexpr int CW_TMO = 0, CW_BAR = 4096;

constexpr int RING_OFF = 0, RING_BYTES = 131072;
constexpr int LDSCTL_OFF = RING_BYTES, PTRS_OFF = LDSCTL_OFF + 512, MISC_OFF = LDSCTL_OFF + 1024;
constexpr int LDS_BYTES = 147456;
constexpr int NWAVES = 8;

#define GAS __attribute__((address_space(1)))
#define LAS __attribute__((address_space(3)))
typedef unsigned short bf16;
typedef unsigned v4u __attribute__((ext_vector_type(4)));
typedef unsigned v2u __attribute__((ext_vector_type(2)));
typedef float f32x4 __attribute__((ext_vector_type(4)));
typedef float f32x2 __attribute__((ext_vector_type(2)));
typedef int i32x4 __attribute__((ext_vector_type(4)));
typedef short bf16x8 __attribute__((ext_vector_type(8)));
typedef GAS unsigned gu32;
#define RLX_AGENT __ATOMIC_RELAXED, __HIP_MEMORY_SCOPE_AGENT
#define LDS_WAIT() asm volatile("s_waitcnt lgkmcnt(0)" ::: "memory")
#define VM_WAIT() asm volatile("s_waitcnt vmcnt(0)" ::: "memory")
__device__ __forceinline__ unsigned f2bf(float f) { unsigned u = __builtin_bit_cast(unsigned, f); return (u + 0x7fffu + ((u >> 16) & 1u)) >> 16; }
typedef __bf16 bf16x2_t __attribute__((ext_vector_type(2)));
__device__ __forceinline__ unsigned pk2(float lo, float hi) { const f32x2 v = {lo, hi}; const bf16x2_t b = __builtin_convertvector(v, bf16x2_t); return __builtin_bit_cast(unsigned, b); }
__device__ __forceinline__ float bf2f(unsigned short b) { return __builtin_bit_cast(float, (unsigned)b << 16); }
__device__ __forceinline__ float bflo(unsigned w) { return __builtin_bit_cast(float, w << 16); }
__device__ __forceinline__ float bfhi(unsigned w) { return __builtin_bit_cast(float, w & 0xffff0000u); }
__device__ __forceinline__ v2u pk4(f32x4 v) { v2u r; r.x = pk2(v[0], v[1]); r.y = pk2(v[2], v[3]); return r; }
__device__ __forceinline__ f32x4 unpk4(v2u w) { return (f32x4){bflo(w.x), bfhi(w.x), bflo(w.y), bfhi(w.y)}; }
__device__ __forceinline__ float sigmoidf_(float z) { const float e = __expf(-fabsf(z)); const float r = __builtin_amdgcn_rcpf(1.f + e); return z >= 0.f ? r : e * r; }
__device__ __forceinline__ float siluf_(float z) { return z * sigmoidf_(z); }
__device__ __forceinline__ float shx(float v, int mask, int lane) { return __builtin_bit_cast(float, __builtin_amdgcn_ds_bpermute((lane ^ mask) << 2, __builtin_bit_cast(int, v))); }
__device__ __forceinline__ float shl(float v, int src) { return __builtin_bit_cast(float, __builtin_amdgcn_ds_bpermute(src << 2, __builtin_bit_cast(int, v))); }
__device__ __forceinline__ float wave_sum(float v, int lane) {
#pragma unroll
    for (int o = 1; o < 64; o <<= 1) v += shx(v, o, lane);
    return v;
}
namespace pg8 {
constexpr int BM = 256, BK = 64, HALF = 128, HTB = HALF * BK * 2, STAGE_BYTES = 8 * HTB, NXCD = 8, WGM = 8;
__host__ __device__ __forceinline__ int lds_byte(int r, int c) { const int st = (r >> 4) * 2 + (c >> 5), rr = r & 15, cc = c & 31, ob = rr * 64 + cc * 2; return st * 1024 + (ob ^ (((ob >> 9) & 1) << 5)); }
__host__ __device__ __forceinline__ void stage_rc(int b, int& R, int& C) { const int st = b / 1024, sb = b % 1024, swz = sb ^ (((sb >> 9) & 1) << 5); R = (st >> 1) * 16 + swz / 64; C = (st & 1) * 32 + (swz % 64) / 2; }

typedef int v4i_t __attribute__((ext_vector_type(4)));
struct Unit { int pm, pn, be; };
struct Gemm { const bf16* A; const bf16* Bt; int K, lda, ldb; size_t bstride; const int* rowidx; };

struct StaticOrder {
    int nM, nN, nwg, G, c, wgm;
    __device__ void init(int M, int N, int G_, int c_, int wgm_ = WGM) { nM = M / BM; nN = N / BM; nwg = nM * nN; G = G_; c = c_; wgm = wgm_; }
    __device__ bool next(int i, Unit& u) const {
        const long L = (long)i * G + c; if (L >= nwg) return false;
        int wgid = (int)L; { const int q = nwg / NXCD, r = nwg % NXCD, xcd = wgid % NXCD, off = wgid / NXCD; wgid = (xcd < r ? xcd * (q + 1) : r * (q + 1) + (xcd - r) * q) + off; }
        const int nig = wgm * nN, gid = wgid / nig, fm = gid * wgm, gsz = (nM - fm) < wgm ? (nM - fm) : wgm;
        u.pm = fm + ((wgid % nig) % gsz); u.pn = (wgid % nig) / gsz; u.be = 0; return true;
    }
};
struct SimpleOrder {
    int nM, nN, G, c;
    __device__ bool next(int i, Unit& u) const { const int L = i * G + c; if (L >= nM * nN) return false; u.pm = L / nN; u.pn = L % nN; u.be = 0; return true; }
};
struct MoeOrder {
    const LAS int* toff; int G, c;
    __device__ bool next(int i, Unit& u) const {
        int L = i * G + c; const int nt = toff[32];
        if ((G & 31) == 0) { const int xcd = c & 7, j = c >> 3; L = ((i * (G >> 2) + xcd * (G >> 5) + (j >> 2)) << 2) | (j & 3); }
        if (L >= nt * 4) return false;
        u.pm = L >> 2; u.pn = L & 3;
        const int ln = (int)__builtin_amdgcn_mbcnt_lo(~0u, 0u);
        const unsigned long long bal = __builtin_amdgcn_ballot_w64(ln >= 1 && toff[ln] <= u.pm);
        u.be = __builtin_popcount((unsigned)bal); return true;
    }
};
__device__ __forceinline__ unsigned cvt_pk_bf16(float lo, float hi) { unsigned r; asm volatile("v_cvt_pk_bf16_f32 %0, %1, %2" : "=v"(r) : "v"(lo), "v"(hi)); return r; }
__device__ __forceinline__ v2u cpk4(f32x4 v) { v2u r; r.x = cvt_pk_bf16(v[0], v[1]); r.y = cvt_pk_bf16(v[2], v[3]); return r; }
__device__ __forceinline__ v4u cpk8(f32x4 a, f32x4 b) { v4u r; r.x = cvt_pk_bf16(a[0], a[1]); r.y = cvt_pk_bf16(a[2], a[3]); r.z = cvt_pk_bf16(b[0], b[1]); r.w = cvt_pk_bf16(b[2], b[3]); return r; }
__device__ __forceinline__ f32x4 unlo4(v4u w) { return (f32x4){bflo(w.x), bfhi(w.x), bflo(w.y), bfhi(w.y)}; }
__device__ __forceinline__ f32x4 unhi4(v4u w) { return (f32x4){bflo(w.z), bfhi(w.z), bflo(w.w), bfhi(w.w)}; }

template <class Epi, class Sched, bool ALIGN_EPI, bool GATHER, bool F8 = false, int WSCALE = 0x7A7A7A7A, bool IDENT = false>
__device__ __forceinline__ void gemm_phase(LAS unsigned char* lds, const Gemm g, const Sched& S, const Epi& E) {
    int tid_ = threadIdx.x; asm volatile("" : "+v"(tid_));
    const int tid = tid_, wid = __builtin_amdgcn_readfirstlane(tid >> 6), lane = tid & 63, wr = wid >> 2, wc = wid & 3, fr = lane & 15, fq = lane >> 4;
    const int K = g.K, nt = K / BK;
    int RA[2], CA[2];
    unsigned voA[2][2], voAn[2][2], voffB[2];
#pragma unroll
    for (int i = 0; i < 2; ++i) { stage_rc(tid * 16 + i * 8192, RA[i], CA[i]); voffB[i] = (unsigned)(RA[i] * g.ldb + CA[i]) * 2u;
#pragma unroll
        for (int h = 0; h < 2; ++h) { voA[h][i] = (unsigned)((h * HALF + RA[i]) * g.lda + CA[i]) * 2u; voAn[h][i] = voA[h][i]; } }
    const size_t kstep = (size_t)(BK * 2);
    const size_t hstepB = (size_t)HALF * g.ldb * 2, tstepB = 2 * hstepB, tstepA = (size_t)BM * g.lda * 2;
    const unsigned ldsw = (unsigned)wid * 1024u;
    const int aoff = lds_byte(wr * 64 + fr, fq * 8), boff = lds_byte(wc * 32 + fr, fq * 8);
#define PG8_SA(b, h) (((b) * 2 + (h)) * HTB)
#define PG8_SB(b, h) ((4 + (b) * 2 + (h)) * HTB)
#define PG8_STGA(bufoff, kptr, vo, h) do { _Pragma("unroll") for (int _i = 0; _i < 2; ++_i) \
        __builtin_amdgcn_global_load_lds((const unsigned*)((const char*)(kptr) + (vo)[h][_i]), (LAS unsigned*)(lds + (bufoff) + ldsw + _i * 8192), 16, 0, 0); } while (0)
#define PG8_STGB(bufoff, gbase) do { _Pragma("unroll") for (int _i = 0; _i < 2; ++_i) \
        __builtin_amdgcn_global_load_lds((const unsigned*)((const char*)(gbase) + voffB[_i]), (LAS unsigned*)(lds + (bufoff) + ldsw + _i * 8192), 16, 0, 0); } while (0)
#define PG8_LDA(dst, b, h) do { _Pragma("unroll") for (int m = 0; m < 4; ++m) _Pragma("unroll") for (int k = 0; k < 2; ++k) dst[m][k] = *(const LAS bf16x8*)(lds + PG8_SA(b, h) + aoff + m * 2048 + k * 1024); } while (0)
#define PG8_LDB(dst, b, h) do { _Pragma("unroll") for (int n = 0; n < 2; ++n) _Pragma("unroll") for (int k = 0; k < 2; ++k) dst[n][k] = *(const LAS bf16x8*)(lds + PG8_SB(b, h) + boff + n * 2048 + k * 1024); } while (0)
#define PG8_CAT8(x0, x1) __builtin_shufflevector(__builtin_bit_cast(v4i_t, x0), __builtin_bit_cast(v4i_t, x1), 0, 1, 2, 3, 4, 5, 6, 7)
#define PG8_MMA(ai, bj, At, Bt) do { __builtin_amdgcn_s_setprio(1); \
        if constexpr (F8) { _Pragma("unroll") for (int m = 0; m < 4; ++m) _Pragma("unroll") for (int n = 0; n < 2; ++n) \
            acc[ai][bj][m][n] = __builtin_amdgcn_mfma_scale_f32_16x16x128_f8f6f4(PG8_CAT8(Bt[n][0], Bt[n][1]), PG8_CAT8(At[m][0], At[m][1]), acc[ai][bj][m][n], 0, 0, 0, WSCALE, 0, 0x7F7F7F7F); } \
        else { _Pragma("unroll") for (int m = 0; m < 4; ++m) _Pragma("unroll") for (int n = 0; n < 2; ++n) _Pragma("unroll") for (int k = 0; k < 2; ++k) \
            acc[ai][bj][m][n] = __builtin_amdgcn_mfma_f32_16x16x32_bf16(Bt[n][k], At[m][k], acc[ai][bj][m][n], 0, 0, 0); } \
        __builtin_amdgcn_s_setprio(0); } while (0)
#define PG8_WAIT_V(n) asm volatile("s_waitcnt vmcnt(" #n ")" ::: "memory")
#define PG8_WAIT_L(n) asm volatile("s_waitcnt lgkmcnt(" #n ")" ::: "memory")
#define PG8_BAR __builtin_amdgcn_s_barrier()
#define PG8_SCHED __builtin_amdgcn_sched_barrier(0)
    Unit cur, nxt; int ui = 0;
    if (!S.next(0, cur)) return;
    f32x4 acc[2][2][4][2];
#pragma unroll
    for (int a = 0; a < 2; ++a)
#pragma unroll
        for (int b = 0; b < 2; ++b)
#pragma unroll
            for (int m = 0; m < 4; ++m)
#pragma unroll
                for (int n = 0; n < 2; ++n) acc[a][b][m][n] = (f32x4){0.f, 0.f, 0.f, 0.f};
    bf16x8 At[4][2], B0[2][2], B1[2][2];
    if constexpr (GATHER) {
#pragma unroll
        for (int h = 0; h < 2; ++h)
#pragma unroll
            for (int i = 0; i < 2; ++i) voA[h][i] = (unsigned)((IDENT ? cur.pm * BM + h * HALF + RA[i] : g.rowidx[cur.pm * BM + h * HALF + RA[i]]) * g.lda + CA[i]) * 2u;
    }
    const char* cA = GATHER ? (const char*)g.A : (const char*)g.A + (size_t)cur.pm * tstepA;
    const char* cB = (const char*)(g.Bt + (size_t)cur.be * g.bstride) + (size_t)cur.pn * tstepB;
    PG8_STGB(PG8_SB(0, 0), cB); PG8_STGB(PG8_SB(0, 1), cB + hstepB); PG8_STGA(PG8_SA(0, 0), cA, voA, 0); PG8_STGA(PG8_SA(0, 1), cA, voA, 1);
    if (wr == 1) PG8_BAR;
    PG8_WAIT_V(2); PG8_BAR;
    PG8_STGB(PG8_SB(1, 0), cB + kstep); PG8_STGA(PG8_SA(1, 0), cA + kstep, voA, 0); PG8_STGB(PG8_SB(1, 1), cB + hstepB + kstep);
    PG8_WAIT_V(6); PG8_BAR;
    for (;;) {
        const bool has_next = S.next(ui + 1, nxt);
        const char* nA = cA; const char* nB = cB;
        if (has_next) {
            nA = GATHER ? (const char*)g.A : (const char*)g.A + (size_t)nxt.pm * tstepA;
            nB = (const char*)(g.Bt + (size_t)nxt.be * g.bstride) + (size_t)nxt.pn * tstepB;
            if constexpr (GATHER) {
#pragma unroll
                for (int h = 0; h < 2; ++h)
#pragma unroll
                    for (int i = 0; i < 2; ++i) voAn[h][i] = (unsigned)((IDENT ? nxt.pm * BM + h * HALF + RA[i] : g.rowidx[nxt.pm * BM + h * HALF + RA[i]]) * g.lda + CA[i]) * 2u;
            }
        } else if constexpr (GATHER) {
#pragma unroll
            for (int h = 0; h < 2; ++h)
#pragma unroll
                for (int i = 0; i < 2; ++i) voAn[h][i] = voA[h][i];
        }
#pragma unroll 1
        for (int t = 0; t < nt; t += 2) {
            if constexpr (Epi::MIDK > 0) { if (t == Epi::MIDK) E.mid(acc, cur, wr, wc, fr, fq); }
            const bool last = (t == nt - 2);
            const char* a1 = cA + (size_t)(t + 1) * kstep;
            const char* a2 = last ? nA : cA + (size_t)(t + 2) * kstep; const char* b2 = last ? nB : cB + (size_t)(t + 2) * kstep;
            const char* a3 = a2 + kstep; const char* b3 = b2 + kstep;
            PG8_LDB(B0, 0, 0); PG8_LDB(B1, 0, 1); PG8_SCHED; PG8_LDA(At, 0, 0); PG8_STGA(PG8_SA(1, 1), a1, voA, 1);
            if constexpr (GATHER) { if (last) {
#pragma unroll
                for (int h = 0; h < 2; ++h)
#pragma unroll
                    for (int i = 0; i < 2; ++i) voA[h][i] = voAn[h][i]; } }
            PG8_WAIT_V(8); PG8_WAIT_L(0); PG8_BAR; PG8_MMA(0, 0, At, B0); PG8_MMA(0, 1, At, B1); PG8_BAR; PG8_SCHED;
            PG8_LDA(At, 0, 1); PG8_STGB(PG8_SB(0, 0), b2); PG8_STGB(PG8_SB(0, 1), b2 + hstepB); PG8_STGA(PG8_SA(0, 0), a2, voA, 0);
            PG8_WAIT_V(8); PG8_WAIT_L(0); PG8_BAR; PG8_MMA(1, 0, At, B0); PG8_MMA(1, 1, At, B1); PG8_BAR; PG8_SCHED;
            PG8_LDB(B0, 1, 0); PG8_LDB(B1, 1, 1); PG8_SCHED; PG8_LDA(At, 1, 0); PG8_STGA(PG8_SA(0, 1), a2, voA, 1);
            PG8_WAIT_V(8); PG8_WAIT_L(0); PG8_BAR; PG8_MMA(0, 0, At, B0); PG8_MMA(0, 1, At, B1); PG8_BAR; PG8_SCHED;
            PG8_LDA(At, 1, 1); PG8_STGB(PG8_SB(1, 0), b3); PG8_STGB(PG8_SB(1, 1), b3 + hstepB); PG8_STGA(PG8_SA(1, 0), a3, voA, 0);
            PG8_WAIT_V(8); PG8_WAIT_L(0); PG8_BAR; PG8_MMA(1, 0, At, B0); PG8_MMA(1, 1, At, B1); PG8_BAR; PG8_SCHED;
        }
        if constexpr (ALIGN_EPI) { if (wr == 0) PG8_BAR; }
        E(acc, cur, wr, wc, fr, fq);
        if (!has_next) break;
#pragma unroll
        for (int a = 0; a < 2; ++a)
#pragma unroll
            for (int b = 0; b < 2; ++b)
#pragma unroll
                for (int m = 0; m < 4; ++m)
#pragma unroll
                    for (int n = 0; n < 2; ++n) acc[a][b][m][n] = (f32x4){0.f, 0.f, 0.f, 0.f};
        cur = nxt; cA = nA; cB = nB; ++ui;
        if constexpr (ALIGN_EPI) { if (wr == 1) PG8_BAR; }
    }
    PG8_WAIT_V(0);
    if constexpr (!ALIGN_EPI) { if (wr == 0) PG8_BAR; }
    PG8_BAR;
#undef PG8_SA
#undef PG8_SB
#undef PG8_STGA
#undef PG8_STGB
#undef PG8_LDA
#undef PG8_LDB
#undef PG8_MMA
#undef PG8_CAT8
#undef PG8_WAIT_V
#undef PG8_WAIT_L
#undef PG8_BAR
#undef PG8_SCHED
}

__device__ __forceinline__ float expc(float x) { return __expf(fminf(x, 80.f)); }
template <int N> __device__ __forceinline__ float row_shr(float x) { return __builtin_bit_cast(float, __builtin_amdgcn_update_dpp(0, __builtin_bit_cast(int, x), 0x110 + N, 0xF, 0xF, true)); }
__device__ __forceinline__ float scan16d(float x) { x += row_shr<1>(x); x += row_shr<2>(x); x += row_shr<4>(x); x += row_shr<8>(x); return x; }
__device__ __forceinline__ float exp2c(float x) { return __builtin_amdgcn_exp2f(fminf(x, 115.f)); }

struct EpiZ {
    static constexpr int MIDK = 0;
    unsigned char* ws; int layer;
    const float *qg, *kg;
    __device__ __forceinline__ void operator()(const f32x4 (&acc)[2][2][4][2], const Unit& u, int wr, int wc, int fr_, int fq_) const {
        int fr = fr_, fq = fq_; asm volatile("" : "+v"(fr), "+v"(fq));
        bf16* const QF = (bf16*)(ws + Z_QF); bf16* const KF = (bf16*)(ws + Z_KF); bf16* const QB = (bf16*)(ws + Z_QB); bf16* const KB = (bf16*)(ws + Z_KB); bf16* const VA = (bf16*)(ws + Z_VA);
        bf16* const OG = (bf16*)(ws + Z_OG); bf16* const Y2 = (bf16*)(ws + Z_Y2); bf16* const KG = (bf16*)(ws + Z_KG); bf16* const VG = (bf16*)(ws + Z_VG); bf16* const SG = (bf16*)(ws + Z_SG);
        float* const DEC = (float*)(ws + Z_DEC); const float* const COS = (const float*)(ws + WS_TAB); const float* const SIN = COS + 1024;
        const float* const LBf = COS + 2048 + (0 * 4 + layer) * 512; const float* const LBb = COS + 2048 + (1 * 4 + layer) * 512;
        const int pn = u.pn;
        if (pn < 8) {
            const int ch0 = 64 * pn + 16 * wc + 4 * fq;
#pragma unroll
            for (int ai = 0; ai < 2; ++ai) {
                const int row0 = u.pm * BM + ai * HALF + wr * 64;
                const int cg = row0 >> 6;
                const int hdA = pn >> 1;
                const unsigned ro0 = (unsigned)(((cg * 4 + hdA) * 64 + fr) * 128 + 64 * (pn & 1) + 16 * wc + 4 * fq);
                const unsigned rv0 = (unsigned)((((cg * 4 + hdA) * 2 + (pn & 1)) * 64 + fr) * 64 + 16 * wc + 4 * fq);
                f32x4 qs[4];
#pragma unroll
                for (int m = 0; m < 4; ++m)
#pragma unroll
                    for (int jj = 0; jj < 4; ++jj) qs[m][jj] = siluf_(acc[ai][0][m][0][jj]) * 0.08838834764831845f;
                {
                    const f32x4 lb = *(const f32x4*)(LBf + ch0);
                    f32x4 pf[4], kf[4]; f32x4 off = (f32x4){0.f, 0.f, 0.f, 0.f}, ref = off;
#pragma unroll
                    for (int m = 0; m < 4; ++m) {
#pragma unroll
                        for (int jj = 0; jj < 4; ++jj) { const float z = acc[ai][0][m][1][jj]; const float e = __builtin_amdgcn_exp2f(-1.4426950408889634f * fabsf(z)); const float r = __builtin_amdgcn_rcpf(1.f + e);
                            const float sp = z >= 0.f ? r : e * r, sm = z >= 0.f ? e * r : r; const float f = lb[jj] + (1.f - lb[jj]) * sp;
                            kf[m][jj] = (1.f - lb[jj]) * sm; const float p = scan16d(__builtin_amdgcn_logf(fmaxf(f, 1e-37f))) + off[jj]; pf[m][jj] = p; off[jj] = shl(p, (fr + 16 * fq) | 15); }
                        if (m == 1) ref = off;
                    }
                    const f32x4 tot = off;
#pragma unroll
                    for (int m = 0; m < 4; ++m) { f32x4 qo, ko;
#pragma unroll
                        for (int jj = 0; jj < 4; ++jj) { const float q = qs[m][jj]; const float d = pf[m][jj] - ref[jj];
                            qo[jj] = q * exp2c(d); ko[jj] = kf[m][jj] * exp2c(-d); }
                        *(v2u*)(QF + ro0 + m * 16 * 128) = cpk4(qo); *(v2u*)(KF + ro0 + m * 16 * 128) = cpk4(ko); }
                    if (fr == 0) { float* d0 = DEC + ((size_t)(cg * 2 + 0) * 3) * 512 + ch0; f32x4 a, b, c;
#pragma unroll
                        for (int jj = 0; jj < 4; ++jj) { a[jj] = __builtin_amdgcn_exp2f(ref[jj]); b[jj] = __builtin_amdgcn_exp2f(tot[jj]); c[jj] = __builtin_amdgcn_exp2f(tot[jj] - ref[jj]); }
                        *(f32x4*)(d0) = a; *(f32x4*)(d0 + 512) = b; *(f32x4*)(d0 + 1024) = c; }
                }
                __builtin_amdgcn_sched_barrier(0);
                {
                    const f32x4 lb = *(const f32x4*)(LBb + ch0);
                    f32x4 pb[4], kb[4]; f32x4 off = (f32x4){0.f, 0.f, 0.f, 0.f}, half = off;
#pragma unroll
                    for (int m = 0; m < 4; ++m) {
                        if (m == 2) half = off;
#pragma unroll
                        for (int jj = 0; jj < 4; ++jj) { const float z = acc[ai][1][m][0][jj]; const float e = __builtin_amdgcn_exp2f(-1.4426950408889634f * fabsf(z)); const float r = __builtin_amdgcn_rcpf(1.f + e);
                            const float sp = z >= 0.f ? r : e * r, sm = z >= 0.f ? e * r : r; const float f = lb[jj] + (1.f - lb[jj]) * sp;
                            kb[m][jj] = (1.f - lb[jj]) * sm; const float lf = __builtin_amdgcn_logf(fmaxf(f, 1e-37f)); const float p = scan16d(lf) + off[jj]; pb[m][jj] = p - lf; off[jj] = shl(p, (fr + 16 * fq) | 15); }
                    }
                    const f32x4 tot = off;
                    const f32x4 ref = tot - half;
#pragma unroll
                    for (int m = 0; m < 4; ++m) { f32x4 qo, ko;
#pragma unroll
                        for (int jj = 0; jj < 4; ++jj) { const float q = qs[m][jj]; const float d = (tot[jj] - pb[m][jj]) - ref[jj];
                            qo[jj] = q * exp2c(d); ko[jj] = kb[m][jj] * exp2c(-d); }
                        *(v2u*)(QB + ro0 + m * 16 * 128) = cpk4(qo); *(v2u*)(KB + ro0 + m * 16 * 128) = cpk4(ko); }
                    if (fr == 0) { float* d1 = DEC + ((size_t)(cg * 2 + 1) * 3) * 512 + ch0; f32x4 a, b, c;
#pragma unroll
                        for (int jj = 0; jj < 4; ++jj) { a[jj] = __builtin_amdgcn_exp2f(ref[jj]); b[jj] = __builtin_amdgcn_exp2f(tot[jj]); c[jj] = __builtin_amdgcn_exp2f(tot[jj] - ref[jj]); }
                        *(f32x4*)(d1) = a; *(f32x4*)(d1 + 512) = b; *(f32x4*)(d1 + 1024) = c; }
                }
                __builtin_amdgcn_sched_barrier(0);
#pragma unroll
                for (int m = 0; m < 4; ++m) *(v2u*)(VA + rv0 + m * 16 * 64) = cpk4(acc[ai][1][m][1]);
                __builtin_amdgcn_sched_barrier(0);
            }
        } else if (pn < 10) {
            const int c0 = (pn - 8) * BM + 32 * wc + 8 * fq;
#pragma unroll
            for (int ai = 0; ai < 2; ++ai)
#pragma unroll
                for (int m = 0; m < 4; ++m) {
                    bf16* rowp = OG + (size_t)(u.pm * BM + ai * HALF + wr * 64 + 16 * m + fr) * 512 + c0;
#pragma unroll
                    for (int bj = 0; bj < 2; ++bj) { f32x4 o[2];
#pragma unroll
                        for (int n = 0; n < 2; ++n) { const f32x4 v = acc[ai][bj][m][n];
#pragma unroll
                            for (int jj = 0; jj < 4; ++jj) o[n][jj] = v[jj] * sigmoidf_(v[jj]); }
                        *(v4u*)(rowp + bj * HALF) = cpk8(o[0], o[1]); }
                }
        } else if (pn >= 13) {
            const int c0 = (pn - 13) * HALF + 32 * wc + 4 * fq;
#pragma unroll
            for (int ai = 0; ai < 2; ++ai)
#pragma unroll
                for (int m = 0; m < 4; ++m) {
                    bf16* rowp = SG + (size_t)(u.pm * BM + ai * HALF + wr * 64 + 16 * m + fr) * 2048 + c0;
#pragma unroll
                    for (int n = 0; n < 2; ++n) { const f32x4 za = acc[ai][0][m][n], zb = acc[ai][1][m][n]; f32x4 rt, sb;
#pragma unroll
                        for (int jj = 0; jj < 4; ++jj) { const float a = sigmoidf_(za[jj]), b = fmaxf(sigmoidf_(zb[jj]), 1e-30f); sb[jj] = b; rt[jj] = a * __builtin_amdgcn_rcpf(b); }
                        *(v2u*)(rowp + 16 * n) = cpk4(rt); *(v2u*)(rowp + 1024 + 16 * n) = cpk4(sb); }
                }
        } else {
            const bool isq = pn < 12, isv = (!isq) && wc >= 2; const int kvh = wc & 1;
            const float* gv = isq ? qg : kg; const float osc = isq ? QC2 : 1.f;
            f32x4 gg[2][2];
#pragma unroll
            for (int bj = 0; bj < 2; ++bj)
#pragma unroll
                for (int n = 0; n < 2; ++n) gg[bj][n] = *(const f32x4*)(gv + 32 * bj + 16 * n + 4 * fq);
            const bool latent = u.pm < (TL / BM);
#pragma unroll
            for (int ai = 0; ai < 2; ++ai)
#pragma unroll
                for (int m = 0; m < 4; ++m) {
                    const int r = u.pm * BM + ai * HALF + wr * 64 + 16 * m + fr;
                    f32x4 y[2][2];
#pragma unroll
                    for (int bj = 0; bj < 2; ++bj)
#pragma unroll
                        for (int n = 0; n < 2; ++n) y[bj][n] = acc[ai][bj][m][n];
                    bf16* dst;
                    if (isq) dst = Y2 + (size_t)r * 1024 + 512 + 64 * (4 * (pn - 10) + wc) + 4 * fq;
                    else { int b, pos; if (latent) { b = r >> 12; pos = CTXL + (r & 4095); } else { const int rc = r - TL; b = rc >> 8; pos = rc & 255; }
                           dst = (isv ? VG : KG) + ((size_t)b * KVLEN + pos) * 128 + 64 * kvh + 4 * fq; }
                    if (!isv) {
                        float ss = 0.f;
#pragma unroll
                        for (int bj = 0; bj < 2; ++bj)
#pragma unroll
                            for (int n = 0; n < 2; ++n) { const f32x4 v = y[bj][n]; ss += (v[0] * v[0] + v[1] * v[1]) + (v[2] * v[2] + v[3] * v[3]); }
                        ss += shx(ss, 16, fr + 16 * fq); ss += shx(ss, 32, fr + 16 * fq);
                        const float rs = rsqrtf(ss * (1.f / 64.f) + EPSN);
#pragma unroll
                        for (int bj = 0; bj < 2; ++bj)
#pragma unroll
                            for (int n = 0; n < 2; ++n) y[bj][n] = y[bj][n] * rs * gg[bj][n];
                        if (latent) {
                            const int t = r & 4095;
#pragma unroll
                            for (int bj = 0; bj < 2; ++bj) { const int pos = bj ? (t & 63) : (t >> 6);
                                const f32x4 cs = *(const f32x4*)(COS + pos * 16 + 4 * fq), sn = *(const f32x4*)(SIN + pos * 16 + 4 * fq);
                                const f32x4 x1 = y[bj][0], x2 = y[bj][1]; y[bj][0] = x1 * cs - x2 * sn; y[bj][1] = x2 * cs + x1 * sn; }
                        }
                    }
#pragma unroll
                    for (int bj = 0; bj < 2; ++bj)
#pragma unroll
                        for (int n = 0; n < 2; ++n) *(v2u*)(dst + 32 * bj + 16 * n) = cpk4(y[bj][n] * osc);
                }
        }
    }
};
template <bool ADD> struct EpiMerge {
    static constexpr int MIDK = 0;
    bf16* MB; const bf16* SG; int goff;
    __device__ __forceinline__ void operator()(const f32x4 (&acc)[2][2][4][2], const Unit& u, int wr, int wc, int fr_, int fq_) const {
        int fr = fr_, fq = fq_; asm volatile("" : "+v"(fr), "+v"(fq));
#pragma unroll
        for (int ai = 0; ai < 2; ++ai)
#pragma unroll
            for (int m = 0; m < 4; ++m) { const size_t r = (size_t)(u.pm * BM + ai * HALF + wr * 64 + 16 * m + fr); const int c0 = u.pn * BM + 32 * wc + 4 * fq;
#pragma unroll
                for (int bj = 0; bj < 2; ++bj)
#pragma unroll
                    for (int n = 0; n < 2; ++n) { const int c = c0 + bj * HALF + 16 * n;
                        const f32x4 gte = unpk4(*(const v2u*)(SG + r * 2048 + goff + c)); f32x4 o = gte * acc[ai][bj][m][n];
                        if (ADD) o += unpk4(*(const v2u*)(MB + r * 1024 + c));
                        *(v2u*)(MB + r * 1024 + c) = cpk4(o); } }
    }
};
struct EpiGates {
    static constexpr int MIDK = 0;
    bf16* SG;
    __device__ __forceinline__ void operator()(const f32x4 (&acc)[2][2][4][2], const Unit& u, int wr, int wc, int fr_, int fq_) const {
        int fr = fr_, fq = fq_; asm volatile("" : "+v"(fr), "+v"(fq));
        const int c0 = u.pn * HALF + 32 * wc + 8 * fq;
#pragma unroll
        for (int ai = 0; ai < 2; ++ai)
#pragma unroll
            for (int m = 0; m < 4; ++m) {
                bf16* rowp = SG + (size_t)(u.pm * BM + ai * HALF + wr * 64 + 16 * m + fr) * 2048 + c0;
                f32x4 rt[2], sb[2];
#pragma unroll
                for (int n = 0; n < 2; ++n) { const f32x4 za = acc[ai][0][m][n], zb = acc[ai][1][m][n];
#pragma unroll
                    for (int jj = 0; jj < 4; ++jj) { const float a = sigmoidf_(za[jj]), b = fmaxf(sigmoidf_(zb[jj]), 1e-30f); sb[n][jj] = b; rt[n][jj] = a * __builtin_amdgcn_rcpf(b); } }
                *(v4u*)(rowp) = cpk8(rt[0], rt[1]); *(v4u*)(rowp + 1024) = cpk8(sb[0], sb[1]);
            }
    }
};
struct EpiMergeF {
    static constexpr int MIDK = 8;
    bf16* MB; const bf16* SG;
    __device__ __forceinline__ void mid(f32x4 (&acc)[2][2][4][2], const Unit& u, int wr, int wc, int fr_, int fq_) const {
        int fr = fr_, fq = fq_; asm volatile("" : "+v"(fr), "+v"(fq));
#pragma unroll
        for (int ai = 0; ai < 2; ++ai) {
            v4u rt[4][2];
#pragma unroll
            for (int m = 0; m < 4; ++m) { const size_t r = (size_t)(u.pm * BM + ai * HALF + wr * 64 + 16 * m + fr); const int c0 = u.pn * BM + 32 * wc + 8 * fq;
#pragma unroll
                for (int bj = 0; bj < 2; ++bj) rt[m][bj] = *(const v4u*)(SG + r * 2048 + c0 + bj * HALF); }
#pragma unroll
            for (int m = 0; m < 4; ++m)
#pragma unroll
                for (int bj = 0; bj < 2; ++bj) { acc[ai][bj][m][0] *= unlo4(rt[m][bj]); acc[ai][bj][m][1] *= unhi4(rt[m][bj]); }
            __builtin_amdgcn_sched_barrier(0);
        }
    }
    __device__ __forceinline__ void operator()(const f32x4 (&acc)[2][2][4][2], const Unit& u, int wr, int wc, int fr_, int fq_) const {
        int fr = fr_, fq = fq_; asm volatile("" : "+v"(fr), "+v"(fq));
#pragma unroll
        for (int ai = 0; ai < 2; ++ai)
#pragma unroll
            for (int m = 0; m < 4; ++m) { const size_t r = (size_t)(u.pm * BM + ai * HALF + wr * 64 + 16 * m + fr); const int c0 = u.pn * BM + 32 * wc + 8 * fq;
#pragma unroll
                for (int bj = 0; bj < 2; ++bj) { const int c = c0 + bj * HALF;
                    const v4u sbw = *(const v4u*)(SG + r * 2048 + 1024 + c);
                    *(v4u*)(MB + r * 1024 + c) = cpk8(unlo4(sbw) * acc[ai][bj][m][0], unhi4(sbw) * acc[ai][bj][m][1]); } }
    }
};
struct EpiOut {
    static constexpr int MIDK = 0;
    bf16* hw; const bf16* hr; const float* modl;
    const float* sl; const float* sc;
    bool first;
    __device__ __forceinline__ void operator()(const f32x4 (&acc)[2][2][4][2], const Unit& u, int wr, int wc, int fr_, int fq_) const {
        int fr = fr_, fq = fq_; asm volatile("" : "+v"(fr), "+v"(fq));
        const bool latent = u.pm < (TL / BM); const int brow = latent ? (u.pm >> 4) : 16;
        const float* g1 = modl + (size_t)brow * 6144 + 2048;
        const int c0 = u.pn * BM + 32 * wc + 8 * fq;
        const size_t r0 = (size_t)u.pm * BM + wr * 64 + fr;
        if (first) {
            const float* sb_ = latent ? sl + (size_t)u.pm * BM * 1024 : sc + (size_t)(u.pm - TL / BM) * BM * 1024;
#pragma unroll
            for (int ai = 0; ai < 2; ++ai)
#pragma unroll
                for (int m = 0; m < 4; ++m) { const float* rows = sb_ + (size_t)(ai * HALF + wr * 64 + 16 * m + fr) * 1024; bf16* rowp = hw + (r0 + ai * HALF + 16 * m) * 1024;
#pragma unroll
                    for (int bj = 0; bj < 2; ++bj) { const int c = c0 + bj * HALF;
                        const f32x4 h0 = *(const f32x4*)(rows + c) + *(const f32x4*)(g1 + c) * acc[ai][bj][m][0], h1 = *(const f32x4*)(rows + c + 4) + *(const f32x4*)(g1 + c + 4) * acc[ai][bj][m][1];
                        *(v4u*)(rowp + c) = cpk8(h0, h1); } }
        } else {
#pragma unroll
            for (int ai = 0; ai < 2; ++ai)
#pragma unroll
                for (int m = 0; m < 4; ++m) { const size_t ro = (r0 + ai * HALF + 16 * m) * 1024;
#pragma unroll
                    for (int bj = 0; bj < 2; ++bj) { const int c = c0 + bj * HALF; const v4u hv = *(const v4u*)(hr + ro + c);
                        const f32x4 h0 = unlo4(hv) + *(const f32x4*)(g1 + c) * acc[ai][bj][m][0], h1 = unhi4(hv) + *(const f32x4*)(g1 + c + 4) * acc[ai][bj][m][1];
                        *(v4u*)(hw + ro + c) = cpk8(h0, h1); } }
        }
    }
};
struct EpiSwiGLU {
    static constexpr int MIDK = 0;
    unsigned char* H;
    __device__ __forceinline__ void operator()(const f32x4 (&acc)[2][2][4][2], const Unit& u, int wr, int wc, int fr_, int fq_) const {
        int fr = fr_, fq = fq_; asm volatile("" : "+v"(fr), "+v"(fq));
#pragma unroll
        for (int ai = 0; ai < 2; ++ai)
#pragma unroll
            for (int m = 0; m < 4; ++m) { unsigned char* rowp = H + (size_t)(u.pm * BM + ai * HALF + wr * 64 + 16 * m + fr) * 512 + 128 * u.pn + 32 * wc + 8 * fq;
                v2u w8;
#pragma unroll
                for (int n = 0; n < 2; ++n) { const f32x4 gt = acc[ai][0][m][n], up = acc[ai][1][m][n]; f32x4 o;
#pragma unroll
                    for (int jj = 0; jj < 4; ++jj) o[jj] = siluf_(gt[jj]) * up[jj];
                    int r = 0; r = __builtin_amdgcn_cvt_pk_fp8_f32(o[0], o[1], r, false); r = __builtin_amdgcn_cvt_pk_fp8_f32(o[2], o[3], r, true);
                    if (n == 0) w8.x = (unsigned)r; else w8.y = (unsigned)r; }
                *(v2u*)(rowp) = w8; }
    }
};
struct EpiDown {
    static constexpr int MIDK = 0;
    unsigned char* YB; const float* roww;
    __device__ __forceinline__ void operator()(const f32x4 (&acc)[2][2][4][2], const Unit& u, int wr, int wc, int fr_, int fq_) const {
        int fr = fr_, fq = fq_; asm volatile("" : "+v"(fr), "+v"(fq));
#pragma unroll
        for (int ai = 0; ai < 2; ++ai)
#pragma unroll
            for (int m = 0; m < 4; ++m) { const size_t r = (size_t)(u.pm * BM + ai * HALF + wr * 64 + 16 * m + fr); const float w = 16.f * roww[r];
                unsigned char* rowp = YB + r * 1024 + u.pn * BM + 32 * wc + 8 * fq;
#pragma unroll
                for (int bj = 0; bj < 2; ++bj) { const f32x4 a = acc[ai][bj][m][0] * w, b = acc[ai][bj][m][1] * w; v2u o;
                    int r0 = 0; r0 = __builtin_amdgcn_cvt_pk_fp8_f32(a[0], a[1], r0, false); r0 = __builtin_amdgcn_cvt_pk_fp8_f32(a[2], a[3], r0, true);
                    int r1 = 0; r1 = __builtin_amdgcn_cvt_pk_fp8_f32(b[0], b[1], r1, false); r1 = __builtin_amdgcn_cvt_pk_fp8_f32(b[2], b[3], r1, true);
                    o.x = (unsigned)r0; o.y = (unsigned)r1; *(v2u*)(rowp + bj * HALF) = o; } }
    }
};
}
#include <hip/hip_bf16.h>
#include <cmath>
namespace attn_body {
using bf16=__hip_bfloat16;
using bf16x8=__attribute__((ext_vector_type(8)))short;
using s16x4=__attribute__((ext_vector_type(4)))short;
using f32x16=__attribute__((ext_vector_type(16)))float;
using u32x4=__attribute__((ext_vector_type(4)))unsigned;
constexpr int D=64,QP=1024,KP=128;
constexpr int NW=8,QBLK=32,QB=QBLK*NW,KVBLK=64;
constexpr int ATTN_UNIT_ROWS=QB;
__device__ __forceinline__ int crow(int r,int hi){return (r&3)+8*(r>>2)+4*hi;}
#define SBAR() __builtin_amdgcn_sched_barrier(0)

constexpr int NSLOT=3, SLOTB=8192;
constexpr int LDS_K=0, LDS_V=NSLOT*SLOTB, LDS_WS=2*NSLOT*SLOTB, LDS_OST=LDS_WS+NW*64*4, LDS_BYTES=LDS_OST+NW*4096;
constexpr float C2=0.125f*1.4426950408889634f;
__device__ __forceinline__ void glds16(const void*gsrc,unsigned lds_dst){unsigned keep;
  asm volatile("s_mov_b32 %0, m0\n\ts_mov_b32 m0, %2\n\ts_nop 0\n\tglobal_load_lds_dwordx4 %1, off\n\ts_mov_b32 m0, %0":"=&s"(keep):"v"(gsrc),"s"(lds_dst):"memory");}
__device__ __forceinline__ float max3f(float a,float b,float c){float r;asm("v_max3_f32 %0, %1, %2, %3":"=v"(r):"v"(a),"v"(b),"v"(c));return r;}
__device__ __forceinline__ float max2f(float a,float b){float r;asm("v_max_f32_e32 %0, %1, %2":"=v"(r):"v"(a),"v"(b));return r;}
__device__ __forceinline__ float fadd_s(float a,float b){float r;asm("v_add_f32_e32 %0, %1, %2":"=v"(r):"v"(a),"v"(b));return r;}
__device__ __forceinline__ float fsub_s(float a,float b){float r;asm("v_sub_f32_e32 %0, %1, %2":"=v"(r):"v"(a),"v"(b));return r;}
typedef float f32x2_t __attribute__((ext_vector_type(2))); typedef __bf16 bf16x2_t __attribute__((ext_vector_type(2)));
__device__ __forceinline__ unsigned cvtpk_s(float lo,float hi){f32x2_t v={lo,hi};bf16x2_t b=__builtin_convertvector(v,bf16x2_t);return __builtin_bit_cast(unsigned,b);}
#define WAIT_BAR(N) asm volatile("s_waitcnt vmcnt(" #N ") lgkmcnt(0)\n\ts_barrier":::"memory")

__device__ __forceinline__ void qkt(f32x16&p0,f32x16&p1,const char*Kslot,const bf16x8*qr,const f32x16&negm,int r32,int hi){
  const char*kb=Kslot+hi*1024+r32*16;
  #pragma unroll
  for(int d0=0;d0<4;++d0){
    const bf16x8 b0=*reinterpret_cast<const bf16x8*>(kb+d0*2048);
    const bf16x8 b1=*reinterpret_cast<const bf16x8*>(kb+d0*2048+512);
    if(d0==0){p0=__builtin_amdgcn_mfma_f32_32x32x16_bf16(b0,qr[0],negm,0,0,0);p1=__builtin_amdgcn_mfma_f32_32x32x16_bf16(b1,qr[0],negm,0,0,0);}
    else{p0=__builtin_amdgcn_mfma_f32_32x32x16_bf16(b0,qr[d0],p0,0,0,0);p1=__builtin_amdgcn_mfma_f32_32x32x16_bf16(b1,qr[d0],p1,0,0,0);}}
}
typedef __attribute__((address_space(3))) const char* lds_cptr;
typedef short v4i16_t __attribute__((ext_vector_type(4)));
__device__ __forceinline__ void kload8(bf16x8*kf,lds_cptr kp){
  kf[0]=*(const __attribute__((address_space(3))) bf16x8*)(kp);      kf[1]=*(const __attribute__((address_space(3))) bf16x8*)(kp+512);
  kf[2]=*(const __attribute__((address_space(3))) bf16x8*)(kp+2048); kf[3]=*(const __attribute__((address_space(3))) bf16x8*)(kp+2560);
  kf[4]=*(const __attribute__((address_space(3))) bf16x8*)(kp+4096); kf[5]=*(const __attribute__((address_space(3))) bf16x8*)(kp+4608);
  kf[6]=*(const __attribute__((address_space(3))) bf16x8*)(kp+6144); kf[7]=*(const __attribute__((address_space(3))) bf16x8*)(kp+6656);
}
__device__ __forceinline__ void kload2(bf16x8*kf,lds_cptr kp,int j){ kf[2*j]=*(const __attribute__((address_space(3))) bf16x8*)(kp+j*2048); kf[2*j+1]=*(const __attribute__((address_space(3))) bf16x8*)(kp+j*2048+512); }
__device__ __forceinline__ s16x4 vtr(lds_cptr p){ return __builtin_bit_cast(s16x4,__builtin_amdgcn_ds_read_tr16_b64_v4i16((__attribute__((address_space(3))) v4i16_t*)p)); }
__device__ __forceinline__ float rowmax(const f32x16&p0,const f32x16&p1){
  float a=max3f(p0[0],p0[1],p1[0]),b=max3f(p0[2],p0[3],p1[1]);a=max3f(a,p1[2],p1[3]);
  #pragma unroll
  for(int r=4;r<16;r+=4){a=max3f(a,p0[r],p0[r+1]);b=max3f(b,p0[r+2],p0[r+3]);a=max3f(a,p1[r],p1[r+1]);b=max3f(b,p1[r+2],p1[r+3]);}
  const float m=max2f(a,b);
  auto rr=__builtin_amdgcn_permlane32_swap(__float_as_uint(m),__float_as_uint(m),false,false);
  return max2f(__uint_as_float(rr[0]),__uint_as_float(rr[1]));
}
__device__ __forceinline__ void pv(f32x16*o,int vb,bf16x8 pa0,bf16x8 pa1,bf16x8 pa2,bf16x8 pa3){
  #pragma unroll
  for(int d0=0;d0<2;++d0){s16x4 lo[4],hi[4];
    #pragma unroll
    for(int ks=0;ks<4;++ks){
      asm volatile("ds_read_b64_tr_b16 %0,%1 offset:%c2":"=&v"(lo[ks]):"v"(vb),"i"(d0*4096+ks*1024):"memory");
      asm volatile("ds_read_b64_tr_b16 %0,%1 offset:%c2":"=&v"(hi[ks]):"v"(vb),"i"(d0*4096+ks*1024+512):"memory");}
    asm volatile("s_waitcnt lgkmcnt(0)":::"memory");SBAR();
    #define PK(k) (bf16x8){lo[k][0],lo[k][1],lo[k][2],lo[k][3],hi[k][0],hi[k][1],hi[k][2],hi[k][3]}
    o[d0]=__builtin_amdgcn_mfma_f32_32x32x16_bf16(pa0,PK(0),o[d0],0,0,0);
    o[d0]=__builtin_amdgcn_mfma_f32_32x32x16_bf16(pa1,PK(1),o[d0],0,0,0);
    o[d0]=__builtin_amdgcn_mfma_f32_32x32x16_bf16(pa2,PK(2),o[d0],0,0,0);
    o[d0]=__builtin_amdgcn_mfma_f32_32x32x16_bf16(pa3,PK(3),o[d0],0,0,0);
    #undef PK
  }
}

#ifndef ATTN_STORE16
#define ATTN_STORE16(p,v) (*(u32x4*)(p)=(v))
#endif
template<int THRL> __device__ __forceinline__ void attn_unit(const bf16*Qb,const bf16*__restrict__ Kh,const bf16*__restrict__ Vh,bf16*Ob,const int NT,char*shm){
  int tid_=threadIdx.x; asm volatile("":"+v"(tid_));
  const int tid=tid_,lane=tid&63,r32=lane&31,hi=lane>>5; const int wid=__builtin_amdgcn_readfirstlane(tid>>6);
  const bf16*Qw=Qb+(long)(wid*QBLK)*QP;
  const unsigned lds0=(unsigned)(uintptr_t)shm;
  float*wsf=(float*)(shm+LDS_WS)+wid*64;
  const bf16*ksrc=Kh+(long)lane*KP+wid*8;
  const bf16*vsrc=Vh+(long)(16*(wid&3)+(lane>>2))*KP+(wid>>2)*32+(lane&3)*8;
  const unsigned kdst=lds0+LDS_K+wid*1024, vdst=lds0+LDS_V+wid*1024;
  #define DMA_K(t,slot) glds16(ksrc+(long)(t)*KVBLK*KP,(unsigned)__builtin_amdgcn_readfirstlane(kdst+(slot)))
  #define DMA_V(t,slot) glds16(vsrc+(long)(t)*KVBLK*KP,(unsigned)__builtin_amdgcn_readfirstlane(vdst+(slot)))
  const int vb0=(int)(lds0+LDS_V)+((lane>>4)&1)*32+(lane&3)*8+(4*hi+((lane&15)>>2))*64;
  const char*Kbase=shm+LDS_K; bf16x8 kf[8];
  const lds_cptr shm3=(lds_cptr)shm; const lds_cptr kp0=shm3+LDS_K+hi*1024+r32*16; const lds_cptr vp0=shm3+LDS_V+((lane>>4)&1)*32+(lane&3)*8+(4*hi+((lane&15)>>2))*64;
  DMA_K(0,0);DMA_V(0,0);DMA_K(1,SLOTB);
  bf16x8 qr[4];
  #pragma unroll
  for(int d0=0;d0<4;++d0)qr[d0]=*reinterpret_cast<const bf16x8*>(&Qw[(long)r32*QP+d0*16+hi*8]);
  float mhat=0.f,l_reg=0.f;f32x16 o[2];o[0]=f32x16{};o[1]=f32x16{};f32x16 negm=f32x16{};asm volatile("":"+v"(negm));
  #define CMASK(P0,P1,t) do{}while(0)
  bool resc=false;
  #define START(P0,P1) do{ const float rm=rowmax(P0,P1); resc=false; \
    { const float dl=rm; mhat=fadd_s(mhat,dl); \
      _Pragma("unroll") for(int r=0;r<16;++r){P0[r]=fsub_s(P0[r],dl);P1[r]=fsub_s(P1[r],dl);} \
      _Pragma("unroll") for(int r=0;r<16;++r)negm[r]=-mhat; asm volatile("":"+v"(negm)); } \
    _Pragma("unroll") for(int r=0;r<16;++r)P0[r]=__builtin_amdgcn_exp2f(P0[r]); }while(0)
  #define RESC() do{ if(resc){ asm volatile("s_waitcnt lgkmcnt(0)":::"memory"); \
      _Pragma("unroll") for(int d_=0;d_<2;++d_) _Pragma("unroll") for(int r=0;r<16;++r)o[d_][r]*=wsf[crow(r,hi)]; } }while(0)
  f32x16 pA0,pA1,pB0,pB1;
  int sl_prev=0,sl_cur=0,sl_next=SLOTB;
  #define ROT() do{sl_prev=sl_cur;sl_cur=sl_next;sl_next=(sl_next==(NSLOT-1)*SLOTB)?0:sl_next+SLOTB;}while(0)
  DMA_K(2,2*SLOTB);
  WAIT_BAR(3);
  qkt(pA0,pA1,Kbase,qr,negm,r32,hi);asm volatile("s_nop 15\n\ts_nop 7":"+v"(pA0),"+v"(pA1));CMASK(pA0,pA1,0);
  START(pA0,pA1);
  _Pragma("unroll") for(int r=0;r<16;++r)pA1[r]=__builtin_amdgcn_exp2f(pA1[r]);
  WAIT_BAR(0);
  DMA_K(3,0);DMA_V(1,SLOTB);
  ROT();
  kload8(kf,kp0+sl_cur);
  WAIT_BAR(2);
  s16x4 vlo[8],vhi[8]; u32x4 pw0,pw1,pw2,pw3;
  #define PKW(P,B) cvtpk_s(P[B],P[B+1])
  #define PAF(k) __builtin_bit_cast(bf16x8,pw##k)
  #define VFR(i) (bf16x8){vlo[i][0],vlo[i][1],vlo[i][2],vlo[i][3],vhi[i][0],vhi[i][1],vhi[i][2],vhi[i][3]}
  #define PIN(x) asm volatile("":"+v"(x))
  #define MX3(a,b,c) __builtin_fmaxf(__builtin_fmaxf((a),(b)),(c))
  #define GAPA(MF,A0,A1,A2,A3,W0,W1,PW) do{ MF; sacc+=A0; sacc+=A1; sacc+=A2; sacc+=A3; PIN(sacc); W0; W1; PIN(PW); SBAR(); }while(0)
  #define EX(v) __builtin_amdgcn_exp2f(v)
  #define GAPB(MF,X,B) do{ MF; X[B]=EX(X[B]); X[B+1]=EX(X[B+1]); X[B+2]=EX(X[B+2]); X[B+3]=EX(X[B+3]); PIN(X); SBAR(); }while(0)
  #define VRD(i) do{ vlo[i]=vtr(vp_+(((i)>>2)*4096+((i)&3)*1024)); vhi[i]=vtr(vp_+(((i)>>2)*4096+((i)&3)*1024+512)); }while(0)
  #define KRD(G,j) do{ if(G){ kload2(kf,kp0+sl_next,j); SBAR(); } }while(0)
  #define STEP(C0,C1,P0,P1,t,GK,GV,GL) do{ SBAR(); \
    const lds_cptr vp_=vp0+sl_prev; \
    VRD(0); SBAR(); float sacc=(P0[0]+P0[1]); \
    GAPA(C0=__builtin_amdgcn_mfma_f32_32x32x16_bf16(kf[0],qr[0],negm,0,0,0), P0[2],P0[3],P0[4],P0[5],     pw0[0]=PKW(P0,0), pw0[1]=PKW(P0,2), pw0); \
    VRD(4); SBAR(); GAPA(C1=__builtin_amdgcn_mfma_f32_32x32x16_bf16(kf[1],qr[0],negm,0,0,0), P0[6],P0[7],P0[8],P0[9],     pw0[2]=PKW(P0,4), pw0[3]=PKW(P0,6), pw0); \
    VRD(1); SBAR(); GAPA(C0=__builtin_amdgcn_mfma_f32_32x32x16_bf16(kf[2],qr[1],C0,0,0,0),   P0[10],P0[11],P0[12],P0[13], pw1[0]=PKW(P0,8), pw1[1]=PKW(P0,10), pw1); \
    VRD(5); SBAR(); GAPA(C1=__builtin_amdgcn_mfma_f32_32x32x16_bf16(kf[3],qr[1],C1,0,0,0),   P0[14],P0[15],P1[0],P1[1],   pw1[2]=PKW(P0,12),pw1[3]=PKW(P0,14), pw1); \
    VRD(2); SBAR(); GAPA(C0=__builtin_amdgcn_mfma_f32_32x32x16_bf16(kf[4],qr[2],C0,0,0,0),   P1[2],P1[3],P1[4],P1[5],     pw2[0]=PKW(P1,0), pw2[1]=PKW(P1,2), pw2); \
    VRD(6); SBAR(); GAPA(C1=__builtin_amdgcn_mfma_f32_32x32x16_bf16(kf[5],qr[2],C1,0,0,0),   P1[6],P1[7],P1[8],P1[9],     pw2[2]=PKW(P1,4), pw2[3]=PKW(P1,6), pw2); \
    VRD(3); SBAR(); GAPA(C0=__builtin_amdgcn_mfma_f32_32x32x16_bf16(kf[6],qr[3],C0,0,0,0),   P1[10],P1[11],P1[12],P1[13], pw3[0]=PKW(P1,8), pw3[1]=PKW(P1,10), pw3); \
    VRD(7); SBAR(); GAPA(C1=__builtin_amdgcn_mfma_f32_32x32x16_bf16(kf[7],qr[3],C1,0,0,0),   P1[14],P1[15],0.f,0.f,       pw3[2]=PKW(P1,12),pw3[3]=PKW(P1,14), pw3); \
    l_reg+=sacc; \
    if(GK){DMA_K((t)+3,sl_cur);} if(GV){DMA_V((t)+1,sl_next);} \
    CMASK(C0,C1,t); \
    { float a=MX3(C0[0],C0[1],C1[0]),b=MX3(C0[2],C0[3],C1[1]); a=MX3(a,C1[2],C1[3]); \
      _Pragma("unroll") for(int r=4;r<16;r+=4){a=MX3(a,C0[r],C0[r+1]);b=MX3(b,C0[r+2],C0[r+3]);a=MX3(a,C1[r],C1[r+1]);b=MX3(b,C1[r+2],C1[r+3]);} \
      float rm=__builtin_fmaxf(a,b); { auto rr=__builtin_amdgcn_permlane32_swap(__float_as_uint(rm),__float_as_uint(rm),false,false); rm=__builtin_fmaxf(__uint_as_float(rr[0]),__uint_as_float(rr[1])); } \
      resc=false; \
      if(__builtin_expect(__any(rm>(float)THRL),0)){ const float dl=__builtin_fmaxf(rm,0.f); mhat+=dl; \
        _Pragma("unroll") for(int r=0;r<16;++r){C0[r]-=dl;C1[r]-=dl;} \
        _Pragma("unroll") for(int r=0;r<16;++r)negm[r]=-mhat; asm volatile("":"+v"(negm)); \
        const float f=__builtin_amdgcn_exp2f(-dl); l_reg*=f; if(hi==0)wsf[r32]=f; resc=true; } } \
    SBAR(); \
    GAPB(o[0]=__builtin_amdgcn_mfma_f32_32x32x16_bf16(PAF(0),VFR(0),o[0],0,0,0), C0,0); \
    GAPB(o[1]=__builtin_amdgcn_mfma_f32_32x32x16_bf16(PAF(0),VFR(4),o[1],0,0,0), C0,4); \
    KRD(GL,0); GAPB(o[0]=__builtin_amdgcn_mfma_f32_32x32x16_bf16(PAF(1),VFR(1),o[0],0,0,0), C0,8); \
    KRD(GL,1); GAPB(o[1]=__builtin_amdgcn_mfma_f32_32x32x16_bf16(PAF(1),VFR(5),o[1],0,0,0), C0,12); \
    KRD(GL,2); GAPB(o[0]=__builtin_amdgcn_mfma_f32_32x32x16_bf16(PAF(2),VFR(2),o[0],0,0,0), C1,0); \
    KRD(GL,3); GAPB(o[1]=__builtin_amdgcn_mfma_f32_32x32x16_bf16(PAF(2),VFR(6),o[1],0,0,0), C1,4); \
    GAPB(o[0]=__builtin_amdgcn_mfma_f32_32x32x16_bf16(PAF(3),VFR(3),o[0],0,0,0), C1,8); \
    GAPB(o[1]=__builtin_amdgcn_mfma_f32_32x32x16_bf16(PAF(3),VFR(7),o[1],0,0,0), C1,12); \
    }while(0)
  int t=1;
  #undef CMASK
  #define CMASK(P0,P1,t) do{}while(0)
  for(;t+5<NT;t+=2){
    STEP(pB0,pB1,pA0,pA1,t,true,true,true);     WAIT_BAR(2); RESC(); ROT();
    STEP(pA0,pA1,pB0,pB1,t+1,true,true,true);   WAIT_BAR(2); RESC(); ROT();
  }
  #undef CMASK
  #define CMASK(P0,P1,t) do{}while(0)
  #define ENDW(tt) do{ if((tt)+3<NT){WAIT_BAR(2);} else if((tt)+2<NT){WAIT_BAR(1);} else {WAIT_BAR(0);} }while(0)
  for(;t+1<NT;t+=2){
    STEP(pB0,pB1,pA0,pA1,t,(t+3<NT),(t+1<NT),(t+1<NT));       ENDW(t);   RESC(); ROT();
    STEP(pA0,pA1,pB0,pB1,t+1,(t+4<NT),(t+2<NT),(t+2<NT));     ENDW(t+1); RESC(); ROT();
  }
  STEP(pB0,pB1,pA0,pA1,NT-1,false,false,false); RESC();
  { float sacc=pB0[0]+pB0[1]; _Pragma("unroll") for(int r=2;r<16;++r)sacc+=pB0[r]; _Pragma("unroll") for(int r=0;r<16;++r)sacc+=pB1[r]; l_reg+=sacc;
    pw0=(u32x4){PKW(pB0,0),PKW(pB0,2),PKW(pB0,4),PKW(pB0,6)};pw1=(u32x4){PKW(pB0,8),PKW(pB0,10),PKW(pB0,12),PKW(pB0,14)};pw2=(u32x4){PKW(pB1,0),PKW(pB1,2),PKW(pB1,4),PKW(pB1,6)};pw3=(u32x4){PKW(pB1,8),PKW(pB1,10),PKW(pB1,12),PKW(pB1,14)};
    SBAR(); pv(o,vb0+sl_cur,PAF(0),PAF(1),PAF(2),PAF(3)); }
  #undef PKW
  #undef PAF
  #undef VFR
  #undef PIN
  #undef MX3
  #undef GAPA
  #undef GAPB
  #undef EX
  #undef VRD
  #undef KRD
  #undef STEP
  #undef ENDW
  {auto rr=__builtin_amdgcn_permlane32_swap(__float_as_uint(l_reg),__float_as_uint(l_reg),false,false);l_reg=__uint_as_float(rr[0])+__uint_as_float(rr[1]);}
  if(hi==0)wsf[32+r32]=l_reg;asm volatile("s_waitcnt lgkmcnt(0)":::"memory");
  float rli[16];
  #pragma unroll
  for(int r=0;r<16;++r)rli[r]=__builtin_amdgcn_rcpf(wsf[32+crow(r,hi)]);
  bf16*Ow=Ob+(long)(wid*QBLK)*QP;
  { bf16*stg=(bf16*)(shm+LDS_OST)+wid*2048;
    #pragma unroll
    for(int r=0;r<16;++r){const int orow=crow(r,hi);
      #pragma unroll
      for(int d0=0;d0<2;++d0)stg[orow*64+d0*32+r32]=__float2bfloat16(o[d0][r]*rli[r]);}
    asm volatile("s_waitcnt lgkmcnt(0)":::"memory");
    #pragma unroll
    for(int i=0;i<4;++i){const int row=i*8+(lane>>3),ch=lane&7; const u32x4 v=*(const u32x4*)(stg+row*64+ch*8); ATTN_STORE16(Ow+(long)row*QP+ch*8,v);} }
  asm volatile("s_waitcnt lgkmcnt(0)\n\ts_barrier":::"memory");
  #undef DMA_K
  #undef DMA_V
  #undef CMASK
  #undef START
  #undef RESC
  #undef ROT
}
constexpr int ATTN_LDS_BYTES=LDS_BYTES;
#undef SBAR
#undef WAIT_BAR
}
#define XB_TMO      128
#define XB_XCNT(j)  (256  + 64 * (j))
#define XB_XSUB(j)  (1280 + 64 * (j))
#define XB_XGEN(j)  (2304 + 64 * (j))
#define XB_TOP      3328
#define XB_TOPGEN   3392
#define XCD_BAR_WORDS 3456
#define XB_SPIN_CAP (1u << 18)

__device__ __forceinline__ unsigned xb_ld(unsigned* p)              { return __hip_atomic_load(p, __ATOMIC_RELAXED, __HIP_MEMORY_SCOPE_AGENT); }
__device__ __forceinline__ unsigned xb_add(unsigned* p, unsigned v) { return __hip_atomic_fetch_add(p, v, __ATOMIC_RELAXED, __HIP_MEMORY_SCOPE_AGENT); }
__device__ __forceinline__ unsigned xb_xcc_id() { return (unsigned)__builtin_amdgcn_s_getreg((3 << 11) | 20) & 0xFu; }
#define XB_SPIN(cond, bar) do { unsigned _sp = 0; while (cond) { __builtin_amdgcn_s_sleep(1); \
    if ((++_sp & 255u) == 0u) { if (xb_ld(&(bar)[XB_TMO])) break; if (_sp > XB_SPIN_CAP) { atomicAdd(&(bar)[XB_TMO], 1u); break; } } } } while (0)

struct XcdBarrier {
    unsigned* bar; unsigned x;
    volatile LAS unsigned* st;
};

__device__ __forceinline__ XcdBarrier xcd_barrier_post(unsigned* bar, volatile LAS unsigned* st) {
    XcdBarrier b; b.bar = bar; b.x = xb_xcc_id(); b.st = st;
    if (threadIdx.x == 0) (void)xb_add(&bar[XB_XCNT(b.x)], 1u);
    return b;
}
__device__ __forceinline__ void xcd_barrier_complete(unsigned* bar, unsigned x, unsigned& nloc, unsigned& nx) {
    const unsigned G = gridDim.x * gridDim.y * gridDim.z;
    unsigned sum, cnt, mine, sp = 0u;
    for (;;) {
        sum = 0u; cnt = 0u; mine = 0u;
#pragma unroll
        for (unsigned j = 0; j < 16; ++j) { const unsigned c = xb_ld(&bar[XB_XCNT(j)]); sum += c; cnt += (c > 0u) ? 1u : 0u; mine = (j == x) ? c : mine; }
        if (sum == G) break;
        __builtin_amdgcn_s_sleep(1);
        if ((++sp & 255u) == 0u) { if (xb_ld(&bar[XB_TMO])) break; if (sp > XB_SPIN_CAP) { atomicAdd(&bar[XB_TMO], 1u); break; } }
    }
    nloc = mine > 0u ? mine : 1u; nx = cnt > 0u ? cnt : 1u;
}

__device__ __forceinline__ void xcd_barrier(const XcdBarrier& b) {
    asm volatile("s_waitcnt vmcnt(0)" ::: "memory");
    __syncthreads();
    if (threadIdx.x == 0) {
        unsigned* bar = b.bar;
        __builtin_amdgcn_s_waitcnt(0);
        unsigned nloc = b.st[0], nx = b.st[1];
        if (nloc == 0u) { xcd_barrier_complete(bar, b.x, nloc, nx); b.st[0] = nloc; b.st[1] = nx; }
        const unsigned old = xb_add(&bar[XB_XSUB(b.x)], 1u);
        const unsigned gen = old / nloc;
        if (old + 1u == (gen + 1u) * nloc) {
            __builtin_amdgcn_fence(__ATOMIC_RELEASE, "agent");
            asm volatile("s_waitcnt vmcnt(0)" ::: "memory");
            const unsigned og = xb_add(&bar[XB_TOP], 1u);
            const unsigned tg = og / nx;
            if (og + 1u == (tg + 1u) * nx) xb_add(&bar[XB_TOPGEN], 1u);
            else XB_SPIN(xb_ld(&bar[XB_TOPGEN]) == tg, bar);
            __builtin_amdgcn_fence(__ATOMIC_ACQUIRE, "agent");
            xb_add(&bar[XB_XGEN(b.x)], 1u);
            asm volatile("s_waitcnt vmcnt(0)" ::: "memory");
        } else {
            XB_SPIN(xb_ld(&bar[XB_XGEN(b.x)]) == gen, bar);
            __builtin_amdgcn_fence(__ATOMIC_ACQUIRE, "agent");
            asm volatile("s_waitcnt vmcnt(0)" ::: "memory");
        }
    }
    __syncthreads();
}


struct Frame {
    LAS unsigned char* lds;
    volatile LAS unsigned* MISC;
    gu32* ctl;
    int tid, lane, wave, G, bx;
    float* out; unsigned char* ws;
};
__device__ __forceinline__ const float* inptr(const Frame& F, int i) {
    const LAS unsigned* t = (const LAS unsigned*)(F.lds + PTRS_OFF) + 2 * i;
    const unsigned lo = __builtin_amdgcn_readfirstlane(t[0]), hi = __builtin_amdgcn_readfirstlane(t[1]);
    return (const float*)(((unsigned long long)hi << 32) | lo);
}
#define INP(i) inptr(F, (i))
#define PHASE_FRAME(F0) Frame F = (F0); { int t_ = F.tid; asm volatile("" : "+v"(t_)); F.tid = t_; F.lane = t_ & 63; F.wave = __builtin_amdgcn_readfirstlane(t_ >> 6); }
enum { I_X = 0, I_C, I_CTX, I_CCTX, I_WADA, I_BADA, I_N1G, I_N2G, I_WIN, I_LBL, I_HNG, I_QNG, I_KNG, I_WUA, I_WUB, I_WOUT, I_WRG, I_BRG, I_WRE, I_BRE, I_WG, I_WU, I_WD, I_FNG };

template <class RowMap> __device__ __forceinline__ void transpose_item(const float* W, int N, bf16* WT, int ldk, int koff, LAS float* scr, int kb, int nb, int lane, RowMap rm) {
    const int k0 = 64 * kb, n0 = 32 * nb;
    float tv[32];
#pragma unroll
    for (int i = 0; i < 32; ++i) tv[i] = W[(size_t)(k0 + 2 * i + (lane >> 5)) * N + n0 + (lane & 31)];
#pragma unroll
    for (int i = 0; i < 32; ++i) scr[(2 * i + (lane >> 5)) * 33 + (lane & 31)] = tv[i];
    LDS_WAIT(); asm volatile("" ::: "memory");
    const int c = lane & 7;
#pragma unroll
    for (int j = 0; j < 4; ++j) { const int n = (lane >> 3) + 8 * j; const LAS float* s = scr + (8 * c) * 33 + n;
        v4u o; o.x = pk2(s[0 * 33], s[1 * 33]); o.y = pk2(s[2 * 33], s[3 * 33]); o.z = pk2(s[4 * 33], s[5 * 33]); o.w = pk2(s[6 * 33], s[7 * 33]);
        *(GAS v4u*)(WT + (size_t)rm(n0 + n) * ldk + koff + k0 + 8 * c) = o; }
    LDS_WAIT(); asm volatile("" ::: "memory");
}
__device__ __forceinline__ unsigned pk4_f8(float a, float b, float c, float d) { int r = 0; r = __builtin_amdgcn_cvt_pk_fp8_f32(a, b, r, false); r = __builtin_amdgcn_cvt_pk_fp8_f32(c, d, r, true); return (unsigned)r; }
template <class RowMap> __device__ __forceinline__ void transpose_item_f8(const float* W, int N, unsigned char* WT8, int ldk, int koff, LAS float* scr, int kb, int nb, int lane, RowMap rm, float mul) {
    const int k0 = 64 * kb, n0 = 32 * nb;
    float tv[32];
#pragma unroll
    for (int i = 0; i < 32; ++i) tv[i] = W[(size_t)(k0 + 2 * i + (lane >> 5)) * N + n0 + (lane & 31)];
#pragma unroll
    for (int i = 0; i < 32; ++i) scr[(2 * i + (lane >> 5)) * 33 + (lane & 31)] = tv[i] * mul;
    LDS_WAIT(); asm volatile("" ::: "memory");
    const int c = lane & 7;
#pragma unroll
    for (int j = 0; j < 4; ++j) { const int n = (lane >> 3) + 8 * j; const LAS float* s = scr + (8 * c) * 33 + n;
        v2u o; o.x = pk4_f8(s[0 * 33], s[1 * 33], s[2 * 33], s[3 * 33]); o.y = pk4_f8(s[4 * 33], s[5 * 33], s[6 * 33], s[7 * 33]);
        *(GAS v2u*)(WT8 + (size_t)rm(n0 + n) * ldk + koff + k0 + 8 * c) = o; }
    LDS_WAIT(); asm volatile("" ::: "memory");
}
__device__ __forceinline__ int pperm(int c) { return (c & ~31) | (((c >> 2) & 1) << 4) | (((c >> 3) & 3) << 2) | (c & 3); }
struct RmId { __device__ __forceinline__ int operator()(int n) const { return n; } };
struct RmPerm { __device__ __forceinline__ int operator()(int n) const { return pperm(n); } };
struct RmGate { int up; __device__ __forceinline__ int operator()(int n) const { return 256 * (n >> 7) + 128 * up + pperm(n & 127); } };
struct RmWin { __device__ __forceinline__ int operator()(int n) const {
    if (n < 2048) { const int s = n >> 9, ch = n & 511, tile = ch >> 6, cw = ch & 63; return tile * 256 + 128 * (s >> 1) + 32 * (cw >> 4) + 16 * (s & 1) + (cw & 15); }
    if (n < 2560) return pperm(n);
    if (n < 3072) { const int hq = (n - 2560) >> 6, d = n & 63; return 2560 + (hq >> 2) * 256 + 128 * (d >> 5) + 32 * (hq & 3) + 16 * ((d >> 4) & 1) + (d & 15); }
    if (n < 3328) { const int hh = (n - 3072) >> 6, d = n & 63; return 3072 + 128 * (d >> 5) + 32 * hh + 16 * ((d >> 4) & 1) + (d & 15); }
    { const int q = n - 3328, gb = q >> 10, col = q & 1023; return 3328 + 256 * (col >> 7) + 128 * gb + pperm(col & 127); } } };
#define WSP(T, off) ((T*)(F.ws + (off)))

__device__ __forceinline__ void p0_prologue(const Frame& F0) {
    PHASE_FRAME(F0);
    LAS float* cact = (LAS float*)(F.lds);
    LAS float* red = (LAS float*)(F.lds + 69632);
    float* MOD = WSP(float, WS_MOD);
    for (int i = F.tid; i < 17 * 1024; i += NWAVES * 64) { const int r = i >> 10, k = i & 1023; const float v = r < 16 ? INP(I_C)[r * 1024 + k] : INP(I_CCTX)[k]; cact[i] = siluf_(v); }
    __syncthreads();
    for (int it = F.bx; it < 4 * 96; it += F.G) {
        const int l = it / 96, cgp = it % 96, col = cgp * 64 + F.lane;
        const float* w = INP(I_WADA) + (size_t)l * 1024 * 6144 + col;
        float acc[17];
#pragma unroll
        for (int r = 0; r < 17; ++r) acc[r] = 0.f;
        const int k0 = F.wave * 128;
#pragma unroll 4
        for (int k = k0; k < k0 + 128; ++k) { const float wv = w[(size_t)k * 6144];
#pragma unroll
            for (int r = 0; r < 17; ++r) acc[r] += cact[r * 1024 + k] * wv; }
#pragma unroll
        for (int r = 0; r < 17; ++r) red[(F.wave * 17 + r) * 64 + F.lane] = acc[r];
        __syncthreads();
        for (int i = F.tid; i < 17 * 64; i += NWAVES * 64) { const int r = i >> 6, ln = i & 63; float s = 0.f;
#pragma unroll
            for (int w8 = 0; w8 < 8; ++w8) s += red[(w8 * 17 + r) * 64 + ln];
            MOD[((size_t)l * 17 + r) * 6144 + cgp * 64 + ln] = s + INP(I_BADA)[l * 6144 + cgp * 64 + ln]; }
        __syncthreads();
    }
    { int* ident = (int*)(F.ws + WS_TAB + 65536); for (int i = F.bx * (NWAVES * 64) + F.tid; i < RCAP; i += F.G * NWAVES * 64) ident[i] = i; }
    if (F.bx == F.G - 1) {
        float* COS = WSP(float, WS_TAB); float* SIN = COS + 1024; float* LB = WSP(float, WS_TAB + 8192);
        for (int i = F.tid; i < 1024; i += NWAVES * 64) { const int pos = i >> 4, fi = i & 15;
            const float inv = (float)pow(10000.0, -(double)fi / 16.0); const float ang = (float)pos * inv;
            COS[i] = (float)cos((double)ang); SIN[i] = (float)sin((double)ang); }
        for (int i = F.tid; i < 1024; i += NWAVES * 64) { const int dir = i >> 9, ch = i & 511;
            float lg[4], mx = -1e30f;
#pragma unroll
            for (int l = 0; l < 4; ++l) { lg[l] = INP(I_LBL)[(dir * 4 + l) * 512 + ch]; mx = fmaxf(mx, lg[l]); }
            float den = 0.f;
#pragma unroll
            for (int l = 0; l < 4; ++l) { lg[l] = expf(lg[l] - mx); den += lg[l]; }
            float cum = 0.f;
#pragma unroll
            for (int l = 0; l < 4; ++l) { LB[(dir * 4 + l) * 512 + ch] = cum; if (l < 3) cum += lg[l + 1] / den; } }
    }
}

__device__ __forceinline__ void row_pass(const Frame& F0, int l, int mode) {
    PHASE_FRAME(F0);
    const int gw = F.bx * NWAVES + F.wave, NGW = F.G * NWAVES;
    const float* MOD = WSP(float, WS_MOD); bf16* XN = WSP(bf16, WS_XN);
    const bf16* HR = (mode == 2) ? WSP(bf16, Z_SG) : (const bf16*)F.out; bf16* HW = (bf16*)F.out;
    const unsigned char* YB = F.ws + Z_YB; const int* DEST = (const int*)(F.ws + WS_RT + RT_DEST);
    const int nrows = (mode == 2) ? TL : TT;
    constexpr int NR = 4;
    for (int m0 = gw; m0 < nrows; m0 += NR * NGW) {
        int d0[NR], d1[NR];
        if (mode != 0) {
#pragma unroll
            for (int q = 0; q < NR; ++q) { const int m = m0 + q * NGW; d0[q] = 0; d1[q] = 0; if (m < nrows) { d0[q] = DEST[2 * m]; d1[q] = DEST[2 * m + 1]; } }
        }
        f32x4 v[NR][4]; unsigned y0[NR][4], y1[NR][4];
#pragma unroll
        for (int q = 0; q < NR; ++q) { const int m = m0 + q * NGW; if (m < nrows) {
            if (mode == 0) { const float* src = (m < TL) ? INP(I_X) + (size_t)m * 1024 : INP(I_CTX) + (size_t)(m - TL) * 1024;
#pragma unroll
                for (int j = 0; j < 4; ++j) v[q][j] = *((const GAS f32x4*)src + F.lane + 64 * j);
            } else {
#pragma unroll
                for (int j = 0; j < 4; ++j) v[q][j] = unpk4(*((const GAS v2u*)(HR + (size_t)m * 1024) + F.lane + 64 * j));
#pragma unroll
                for (int j = 0; j < 4; ++j) { y0[q][j] = *((const GAS unsigned*)(YB + (size_t)d0[q] * 1024) + F.lane + 64 * j); y1[q][j] = *((const GAS unsigned*)(YB + (size_t)d1[q] * 1024) + F.lane + 64 * j); }
            } } }
#pragma unroll
        for (int q = 0; q < NR; ++q) { const int m = m0 + q * NGW; if (m < nrows) {
            const bool latent = m < TL; const int brow = latent ? (m >> 12) : 16;
            if (mode != 0) {
                const float* g2 = MOD + ((size_t)(l - 1) * 17 + brow) * 6144 + 5120;
#pragma unroll
                for (int j = 0; j < 4; ++j) { const f32x4 gg = *((const GAS f32x4*)g2 + F.lane + 64 * j);
                    const f32x2 a0 = __builtin_amdgcn_cvt_pk_f32_fp8((int)y0[q][j], false), a1 = __builtin_amdgcn_cvt_pk_f32_fp8((int)y0[q][j], true);
                    const f32x2 b0 = __builtin_amdgcn_cvt_pk_f32_fp8((int)y1[q][j], false), b1 = __builtin_amdgcn_cvt_pk_f32_fp8((int)y1[q][j], true);
                    v[q][j] += gg * ((f32x4){a0[0] + b0[0], a0[1] + b0[1], a1[0] + b1[0], a1[1] + b1[1]} * 0.0625f); }
            }
            float ss = 0.f;
#pragma unroll
            for (int j = 0; j < 4; ++j) ss += (v[q][j][0] * v[q][j][0] + v[q][j][1] * v[q][j][1]) + (v[q][j][2] * v[q][j][2] + v[q][j][3] * v[q][j][3]);
            const float rs = rsqrtf(wave_sum(ss, F.lane) * (1.f / 1024.f) + EPSN);
            if (mode == 2) {
#pragma unroll
                for (int j = 0; j < 4; ++j) { const f32x4 g = *((const GAS f32x4*)INP(I_FNG) + F.lane + 64 * j); *((GAS f32x4*)(F.out + (size_t)m * 1024) + F.lane + 64 * j) = v[q][j] * rs * g; }
            } else {
                const float* mod = MOD + ((size_t)l * 17 + brow) * 6144; const float* ng = INP(I_N1G) + l * 1024;
#pragma unroll
                for (int j = 0; j < 4; ++j) {
                    if (mode != 0) *((GAS v2u*)(HW + (size_t)m * 1024) + F.lane + 64 * j) = pk4(v[q][j]);
                    const f32x4 g = *((const GAS f32x4*)ng + F.lane + 64 * j), sh = *((const GAS f32x4*)mod + F.lane + 64 * j), sc = *((const GAS f32x4*)(mod + 1024) + F.lane + 64 * j);
                    const f32x4 y = v[q][j] * rs * g * (sc + 1.f) + sh;
                    *((GAS v2u*)(XN + (size_t)m * 1024) + F.lane + 64 * j) = pk4(y);
                    *((GAS unsigned*)(F.ws + Z_OB + (size_t)m * 1024) + F.lane + 64 * j) = pk4_f8(y[0], y[1], y[2], y[3]); }
            }
        } }
    }
}

__device__ __forceinline__ void convert_items(const Frame& F0, int l, int part, int nparts, int worker, int nworkers) {
    PHASE_FRAME(F0);
    LAS float* scr = (LAS float*)(F.lds + F.wave * 16384);
    unsigned char* W = F.ws + WS_W + (size_t)(l & 1) * W_PSTRIDE; unsigned char* WDN = F.ws + ((l & 1) ? W_DN1 : W_DN0);
    constexpr int N_IN = 16 * 168, N_UA = 8 * 32, N_OUT = 16 * 32, N_G = 32 * 256;
    constexpr int NITEMS = N_IN + 2 * N_UA + N_OUT + 3 * N_G;
    const int it_lo = (int)((long)NITEMS * part / nparts), it_hi = (int)((long)NITEMS * (part + 1) / nparts);
    for (int it = it_lo + worker; it < it_hi; it += nworkers) {
        int r = it;
        if (r < N_IN) { const int nb = r % 168;
            if (nb < 104) transpose_item(INP(I_WIN) + (size_t)l * 1024 * NZ, NZ, (bf16*)(W + W_IN), 1024, 0, scr, r / 168, nb, F.lane, RmWin{});
            else transpose_item_f8(INP(I_WIN) + (size_t)l * 1024 * NZ, NZ, W + W_IN8 - (size_t)3328 * 1024, 1024, 0, scr, r / 168, nb, F.lane, RmWin{}, 32.f);
            continue; } r -= N_IN;
        if (r < N_UA) { transpose_item(INP(I_WUA) + (size_t)l * 512 * 1024, 1024, (bf16*)(W + W_UP), 1024, 0, scr, r / 32, r % 32, F.lane, RmPerm{}); continue; } r -= N_UA;
        if (r < N_UA) { transpose_item(INP(I_WUB) + (size_t)l * 512 * 1024, 1024, (bf16*)(W + W_UP), 1024, 512, scr, r / 32, r % 32, F.lane, RmPerm{}); continue; } r -= N_UA;
        if (r < N_OUT) { transpose_item(INP(I_WOUT) + (size_t)l * 1024 * 1024, 1024, (bf16*)(W + W_OUT), 1024, 0, scr, r / 32, r % 32, F.lane, RmPerm{}); continue; } r -= N_OUT;
        if (r < N_G) { const int e = r >> 8, r2 = r & 255; transpose_item_f8(INP(I_WG) + ((size_t)l * 32 + e) * 1024 * 512, 512, W + W_GU + (size_t)e * 1024 * 1024, 1024, 0, scr, r2 / 16, r2 % 16, F.lane, RmGate{0}, 32.f); continue; } r -= N_G;
        if (r < N_G) { const int e = r >> 8, r2 = r & 255; transpose_item_f8(INP(I_WU) + ((size_t)l * 32 + e) * 1024 * 512, 512, W + W_GU + (size_t)e * 1024 * 1024, 1024, 0, scr, r2 / 16, r2 % 16, F.lane, RmGate{1}, 32.f); continue; } r -= N_G;
        { const int e = r >> 8, r2 = r & 255; transpose_item_f8(INP(I_WD) + ((size_t)l * 32 + e) * 512 * 1024, 1024, WDN + (size_t)e * 1024 * 512, 512, 0, scr, r2 / 32, r2 % 32, F.lane, RmPerm{}, 16.f); }
    }
}

__device__ __forceinline__ void convert_layer(const Frame& F0, int l) {
    PHASE_FRAME(F0);
    const int gw = F.bx * NWAVES + F.wave, NGW = F.G * NWAVES;
    const float* MOD = WSP(float, WS_MOD) + (size_t)l * 17 * 6144; float* WP = WSP(float, WS_WR); float* CV = WSP(float, WS_WR + WR_CVEC);
    const float* wrg = INP(I_WRG) + (size_t)l * 1024 * 4; const float* wre = INP(I_WRE) + (size_t)l * 1024 * 32; const float* n2g = INP(I_N2G) + l * 1024;
    const int gt = F.bx * NWAVES * 64 + F.tid, NGT = F.G * NWAVES * 64;
    for (int i = gt; i < 17 * 1024 * 48; i += NGT) { const int b = i / (1024 * 48), k = (i / 48) & 1023, j = i % 48;
        const float w = j < 4 ? wrg[k * 4 + j] : (j < 36 ? wre[k * 32 + (j - 4)] : 0.f);
        WP[i] = n2g[k] * (1.f + MOD[(size_t)b * 6144 + 4096 + k]) * w; }
    for (int it = gw; it < 17 * 48; it += NGW) { const int b = it / 48, j = it % 48; float s = 0.f;
        if (j < 36) { for (int k = F.lane; k < 1024; k += 64) { const float w = j < 4 ? wrg[k * 4 + j] : wre[k * 32 + (j - 4)]; s += MOD[(size_t)b * 6144 + 3072 + k] * w; }
            s = wave_sum(s, F.lane) + (j < 4 ? INP(I_BRG)[l * 4 + j] : INP(I_BRE)[l * 32 + (j - 4)]); }
        if (F.lane == 0) CV[it] = s; }
}

__device__ __forceinline__ void p3_scan(const Frame& F0) {
    PHASE_FRAME(F0);
    constexpr int PQ = 272, PT = 144;
    constexpr int O_Q = 0, O_V = O_Q + 2 * 64 * PQ, O_K = O_V + 2 * 64 * PT, O_A = O_K + 64 * PQ, O_ST = O_A + 64 * PT, O_DEC = O_ST + 64 * PQ;
    static_assert(O_DEC + 1536 <= RING_BYTES, "scan LDS");
    typedef short v4i16_t __attribute__((ext_vector_type(4)));
    LAS unsigned char* L = F.lds;
    const int tid = F.tid, lane = F.lane, wave = F.wave, fr = lane & 15, fq = lane >> 4;
    const float* DEC = WSP(float, Z_DEC);
    for (int u0 = F.bx; u0 < 256; u0 += F.G) {
        const int unit = (u0 & ~15) | ((u0 & 7) << 1) | ((u0 >> 3) & 1);
        const int dvh = unit & 1, dir = (unit >> 1) & 1, hd = (unit >> 2) & 3, b = unit >> 4;
        const bf16* Qp = dir ? WSP(bf16, Z_QB) : WSP(bf16, Z_QF); const bf16* Kp = dir ? WSP(bf16, Z_KB) : WSP(bf16, Z_KF); const bf16* Vp = WSP(bf16, Z_VA);
        bf16* Op = dir ? WSP(bf16, Z_OB) + hd * 128 + dvh * 64 : WSP(bf16, Z_Y2) + hd * 128 + dvh * 64; const int opitch = dir ? 512 : 1024;
        f32x4 S[4];
#pragma unroll
        for (int vt = 0; vt < 4; ++vt) S[vt] = (f32x4){0.f, 0.f, 0.f, 0.f};
        int prow[2], pc16[2];
#pragma unroll
        for (int i = 0; i < 2; ++i) { const int p = tid + 512 * i; prow[i] = p >> 4; pc16[i] = p & 15; }
        const int vrow = tid >> 3, vc8 = tid & 7;
        v4u gq[2][2], gk[2][2], gv[2]; f32x4 gdec[2];
        gdec[0] = (f32x4){0.f, 0.f, 0.f, 0.f}; gdec[1] = gdec[0];
#define SCAN_CG(s) ((s) < 4 ? (1024 + 4 * b + (dir ? 3 - (s) : (s))) : (64 * b + (dir ? 67 - (s) : (s) - 4)))
#define SCAN_LOAD(s, R) do { const int cg_ = SCAN_CG(s); const size_t r0_ = (size_t)cg_ * 64; \
        const size_t tq_ = ((size_t)cg_ * 4 + hd) * 64 * 128; (void)r0_; \
        _Pragma("unroll") for (int i = 0; i < 2; ++i) { gq[R][i] = *(const GAS v4u*)(Qp + tq_ + prow[i] * 128 + 8 * pc16[i]); gk[R][i] = *(const GAS v4u*)(Kp + tq_ + prow[i] * 128 + 8 * pc16[i]); } \
        gv[R] = *(const GAS v4u*)(Vp + (((size_t)cg_ * 4 + hd) * 2 + dvh) * 64 * 64 + vrow * 64 + 8 * vc8); \
        if (tid < 96) gdec[R] = *(const GAS f32x4*)(DEC + ((size_t)(cg_ * 2 + dir) * 3 + (tid >> 5)) * 512 + hd * 128 + 4 * (tid & 31)); } while (0)
#define SCAN_BAR() asm volatile("s_waitcnt lgkmcnt(0)\n\ts_barrier" ::: "memory")
#define SCAN_TRF(dst, base, pitch, c0, kk) do { const LAS unsigned char* p_ = (base) + (32 * (kk) + 8 * fq + ((lane & 15) >> 2)) * (pitch) + 2 * ((c0) + 4 * (lane & 3)); \
            const v4i16_t r0_ = __builtin_amdgcn_ds_read_tr16_b64_v4i16((LAS v4i16_t*)p_), r1_ = __builtin_amdgcn_ds_read_tr16_b64_v4i16((LAS v4i16_t*)(p_ + 4 * (pitch))); \
            dst = (bf16x8){r0_[0], r0_[1], r0_[2], r0_[3], r1_[0], r1_[1], r1_[2], r1_[3]}; } while (0)
#define SCAN_STEP(s, R) do { \
            const int cg = SCAN_CG(s); const int oq = O_Q + (R) * 64 * PQ, ov = O_V + (R) * 64 * PT; \
            _Pragma("unroll") for (int i = 0; i < 2; ++i) { \
                *(LAS v4u*)(L + oq + prow[i] * PQ + 16 * pc16[i]) = gq[R][i]; \
                *(LAS v4u*)(L + O_K + prow[i] * PQ + 16 * pc16[i]) = gk[R][i]; } \
            *(LAS v4u*)(L + ov + vrow * PT + 16 * vc8) = gv[R]; \
            if (tid < 96) *(LAS f32x4*)(L + O_DEC + (tid >> 5) * 512 + 16 * (tid & 31)) = gdec[R]; \
            SCAN_BAR(); \
            if ((s) + 2 < 68) SCAN_LOAD((s) + 2, R); \
            { const f32x4 dm4 = *(const LAS f32x4*)(L + O_DEC + 4 * (16 * wave + 4 * fq)); \
              _Pragma("unroll") for (int vt = 0; vt < 4; ++vt) *(LAS v2u*)(L + O_ST + (16 * vt + fr) * PQ + 2 * (16 * wave + 4 * fq)) = pk4(S[vt] * dm4); } \
            bf16x8 bqk[2][4], va[2];                        \
            { const int st_ = wave >> 1; bf16x8 af[4]; \
              _Pragma("unroll") for (int kk = 0; kk < 4; ++kk) af[kk] = *(const LAS bf16x8*)(L + O_K + (16 * st_ + fr) * PQ + 2 * (32 * kk + 8 * fq)); \
              _Pragma("unroll") for (int tl = 0; tl < 2; ++tl) _Pragma("unroll") for (int kk = 0; kk < 4; ++kk) bqk[tl][kk] = *(const LAS bf16x8*)(L + oq + (16 * (2 * (wave & 1) + tl) + fr) * PQ + 2 * (32 * kk + 8 * fq)); \
              _Pragma("unroll") for (int tl = 0; tl < 2; ++tl) { const int tt = 2 * (wave & 1) + tl; const int tq = 16 * tt + fr; f32x4 o = (f32x4){0.f, 0.f, 0.f, 0.f}; \
                  const bool dead = dir ? (st_ < tt) : (st_ > tt); \
                  if (!dead) { f32x4 a = (f32x4){0.f, 0.f, 0.f, 0.f}; \
                      _Pragma("unroll") for (int kk = 0; kk < 4; ++kk) a = __builtin_amdgcn_mfma_f32_16x16x32_bf16(af[kk], bqk[tl][kk], a, 0, 0, 0); \
                      _Pragma("unroll") for (int rg = 0; rg < 4; ++rg) { const int sk = 16 * st_ + 4 * fq + rg; const bool keep = dir ? (sk >= tq) : (sk <= tq); o[rg] = keep ? a[rg] : 0.f; } } \
                  *(LAS v2u*)(L + O_A + tq * PT + 2 * (16 * st_ + 4 * fq)) = pk4(o); } } \
            { const f32x4 dl4 = *(const LAS f32x4*)(L + O_DEC + 512 + 4 * (16 * wave + 4 * fq)), dlm4 = *(const LAS f32x4*)(L + O_DEC + 1024 + 4 * (16 * wave + 4 * fq)); \
              bf16x8 af[2]; \
              _Pragma("unroll") for (int kk = 0; kk < 2; ++kk) SCAN_TRF(af[kk], L + O_K, PQ, 16 * wave, kk); \
              _Pragma("unroll") for (int vt = 0; vt < 4; ++vt) { f32x4 g = (f32x4){0.f, 0.f, 0.f, 0.f}; \
                  _Pragma("unroll") for (int kk = 0; kk < 2; ++kk) { bf16x8 bv; SCAN_TRF(bv, L + ov, PT, 16 * vt, kk); g = __builtin_amdgcn_mfma_f32_16x16x32_bf16(af[kk], bv, g, 0, 0, 0); if (vt == (wave >> 1)) va[kk] = bv; } \
                  S[vt] = dl4 * S[vt] + dlm4 * g; } } \
            SCAN_BAR(); \
            { const int vt = wave >> 1; const size_t r0 = (size_t)cg * 64; \
              bf16x8 sa[4]; \
              _Pragma("unroll") for (int kk = 0; kk < 4; ++kk) sa[kk] = *(const LAS bf16x8*)(L + O_ST + (16 * vt + fr) * PQ + 2 * (32 * kk + 8 * fq)); \
              _Pragma("unroll") for (int tl = 0; tl < 2; ++tl) { const int tt = 2 * (wave & 1) + tl; f32x4 o = (f32x4){0.f, 0.f, 0.f, 0.f}; \
                  _Pragma("unroll") for (int kk = 0; kk < 4; ++kk) o = __builtin_amdgcn_mfma_f32_16x16x32_bf16(sa[kk], bqk[tl][kk], o, 0, 0, 0); \
                  _Pragma("unroll") for (int kk = 0; kk < 2; ++kk) { const bf16x8 ba = *(const LAS bf16x8*)(L + O_A + (16 * tt + fr) * PT + 2 * (32 * kk + 8 * fq)); o = __builtin_amdgcn_mfma_f32_16x16x32_bf16(va[kk], ba, o, 0, 0, 0); } \
                  *(GAS v2u*)(Op + (r0 + 16 * tt + fr) * opitch + 16 * vt + 4 * fq) = pk4(o); } } \
        } while (0)
        SCAN_LOAD(0, 0); SCAN_LOAD(1, 1);
#pragma unroll 1
        for (int s = 0; s < 68; s += 2) { SCAN_STEP(s, 0); SCAN_STEP(s + 1, 1); }
        SCAN_BAR();
#undef SCAN_CG
#undef SCAN_LOAD
#undef SCAN_BAR
#undef SCAN_TRF
#undef SCAN_STEP
    }
}

__device__ __forceinline__ void p4_attention(const Frame& F0, bool need_ctx, char* lds_generic, bool dummy_out) {
    PHASE_FRAME(F0);
    typedef attn_body::bf16 abf;
    abf* Y2 = (abf*)(F.ws + Z_Y2); const abf* KG = (const abf*)(F.ws + Z_KG); const abf* VG = (const abf*)(F.ws + Z_VG);
    const int nunits = 2048 + (need_ctx ? 128 : 0);
    for (int u = F.bx; u < nunits; u += F.G) {
        int b, h, kvh, NT; size_t qrow;
        if (u < 2048) { const int grp = u >> 6, j = u & 63; b = grp >> 1; kvh = grp & 1; h = 4 * kvh + (j >> 4); qrow = (size_t)b * SEQ + (size_t)(j & 15) * 256; NT = KVLEN / 64; }
        else { const int u2 = u - 2048; b = u2 >> 3; h = u2 & 7; kvh = h >> 2; qrow = (size_t)TL + (size_t)b * CTXL; NT = CTXL / 64; }
        abf* Qb = Y2 + qrow * 1024 + 512 + 64 * h;
        abf* Ob = dummy_out ? (abf*)(F.ws + WS_XN) + qrow * 1024 + 512 + 64 * h : Qb;
        attn_body::attn_unit<8>(Qb, KG + (size_t)b * KVLEN * 128 + 64 * kvh, VG + (size_t)b * KVLEN * 128 + 64 * kvh, Ob, NT, lds_generic);
    }
}

__device__ __forceinline__ void p5_headnorm(const Frame& F0, int l, int nrows) {
    PHASE_FRAME(F0);
    const int gw = F.bx * NWAVES + F.wave, NGW = F.G * NWAVES;
    bf16* Y2 = WSP(bf16, Z_Y2); const bf16* OB = WSP(bf16, Z_OB); const bf16* OG = WSP(bf16, Z_OG);
    const float* g = INP(I_HNG) + l * 512 + 8 * F.lane; const f32x4 g0 = *(const GAS f32x4*)g, g1 = *(const GAS f32x4*)(g + 4);
    for (int m = gw; m < nrows; m += NGW) {
        const v4u a = *(const GAS v4u*)(Y2 + (size_t)m * 1024 + 8 * F.lane), bb = *(const GAS v4u*)(OB + (size_t)m * 512 + 8 * F.lane), gg = *(const GAS v4u*)(OG + (size_t)m * 512 + 8 * F.lane);
        f32x4 o0 = unpk4((v2u){a.x, a.y}) + unpk4((v2u){bb.x, bb.y}), o1 = unpk4((v2u){a.z, a.w}) + unpk4((v2u){bb.z, bb.w});
        float ss = (o0[0] * o0[0] + o0[1] * o0[1]) + (o0[2] * o0[2] + o0[3] * o0[3]) + (o1[0] * o1[0] + o1[1] * o1[1]) + (o1[2] * o1[2] + o1[3] * o1[3]);
        ss += shx(ss, 1, F.lane); ss += shx(ss, 2, F.lane); ss += shx(ss, 4, F.lane); ss += shx(ss, 8, F.lane);
        const float rs = rsqrtf(ss * (1.f / 128.f) + EPSN);
        o0 = o0 * rs * g0 * unpk4((v2u){gg.x, gg.y}); o1 = o1 * rs * g1 * unpk4((v2u){gg.z, gg.w});
        const v2u p0 = pk4(o0), p1 = pk4(o1);
        *(GAS v4u*)(Y2 + (size_t)m * 1024 + 8 * F.lane) = (v4u){p0.x, p0.y, p1.x, p1.y};
    }
}

__device__ __forceinline__ void p9_router(const Frame& F0, int l, int nrows) {
    PHASE_FRAME(F0);
    LAS int* lcnt = (LAS int*)(F.lds + LDSCTL_OFF);
    LAS float* lgs = (LAS float*)(F.lds + F.wave * 4096);
    const float* MOD = WSP(float, WS_MOD) + (size_t)l * 17 * 6144; bf16* XN = WSP(bf16, WS_XN);
    const bf16* HB = (l == DEPTH - 1) ? WSP(bf16, Z_SG) : (const bf16*)F.out;
    const float* WP = WSP(float, WS_WR); const float* CV = WSP(float, WS_WR + WR_CVEC);
    int* INFO = (int*)(F.ws + WS_RT + RT_INFO); float* WTS = (float*)(F.ws + WS_RT + RT_W); int* CNT = (int*)(F.ws + WS_RT + RT_CNT);
    if (F.tid < 32) lcnt[F.tid] = 0;
    __syncthreads();
    const int lane = F.lane, i16 = lane & 15, kg = lane >> 4;
    for (int gamma = F.bx; gamma < TL / 128; gamma += F.G) {
        const int row0 = gamma * 128 + F.wave * 16; const int brow = row0 >> 12;
        const bf16* hbase = HB + (size_t)row0 * 1024;
        const bf16* hp = hbase + (size_t)i16 * 1024 + 8 * kg;
        const unsigned wvo = (unsigned)((8 * kg * 48 + i16) * 4);
        f32x4 a0 = (f32x4){0.f, 0.f, 0.f, 0.f}, a1 = a0, a2 = a0; float ss = 0.f;
#pragma unroll 1
        for (int c8 = 0; c8 < 8; ++c8) {
            v4u hv[4];
#pragma unroll
            for (int jj = 0; jj < 4; ++jj) hv[jj] = *(const GAS v4u*)(hp + 32 * (4 * c8 + jj));
#pragma unroll
            for (int jq = 0; jq < 2; ++jq) {
                float wv[2][8][3];
#pragma unroll
                for (int j2 = 0; j2 < 2; ++j2)
#pragma unroll
                    for (int c = 0; c < 8; ++c) { const GAS float* wr_ = (const GAS float*)((const GAS char*)(WP + ((size_t)brow * 1024 + 32 * (4 * c8 + 2 * jq + j2)) * 48) + wvo) + c * 48; wv[j2][c][0] = wr_[0]; wv[j2][c][1] = wr_[16]; wv[j2][c][2] = wr_[32]; }
#pragma unroll
                for (int j2 = 0; j2 < 2; ++j2) { const f32x4 xl = pg8::unlo4(hv[2 * jq + j2]), xh = pg8::unhi4(hv[2 * jq + j2]);
                    ss += ((xl[0] * xl[0] + xl[1] * xl[1]) + (xl[2] * xl[2] + xl[3] * xl[3])) + ((xh[0] * xh[0] + xh[1] * xh[1]) + (xh[2] * xh[2] + xh[3] * xh[3]));
#pragma unroll
                    for (int c = 0; c < 8; ++c) { const float hc_ = c < 4 ? xl[c & 3] : xh[c & 3];
                        a0 = __builtin_amdgcn_mfma_f32_16x16x4f32(hc_, wv[j2][c][0], a0, 0, 0, 0);
                        a1 = __builtin_amdgcn_mfma_f32_16x16x4f32(hc_, wv[j2][c][1], a1, 0, 0, 0);
                        a2 = __builtin_amdgcn_mfma_f32_16x16x4f32(hc_, wv[j2][c][2], a2, 0, 0, 0); } }
            }
        }
        ss += shx(ss, 16, lane); ss += shx(ss, 32, lane);
        const float rs = rsqrtf(ss * (1.f / 1024.f) + EPSN);
#pragma unroll
        for (int rg = 0; rg < 4; ++rg) { lgs[(4 * kg + rg) * 49 + i16] = a0[rg]; lgs[(4 * kg + rg) * 49 + 16 + i16] = a1[rg]; lgs[(4 * kg + rg) * 49 + 32 + i16] = a2[rg]; }
        LDS_WAIT(); asm volatile("" ::: "memory");
        if (lane < 16) {
            const int row = row0 + lane; const float* cv = CV + brow * 48; const LAS float* lg = lgs + lane * 49;
            float gl[4]; int gsel = 0; float gm = -3.0e38f;
#pragma unroll
            for (int j = 0; j < 4; ++j) { gl[j] = lg[j] * rs + cv[j]; if (gl[j] > gm) { gm = gl[j]; gsel = j; } }
            float den = 0.f;
#pragma unroll
            for (int j = 0; j < 4; ++j) den += __expf(gl[j] - gm);
            const float pg = 1.f / den;
            float el[8];
#pragma unroll
            for (int j = 0; j < 8; ++j) {
                float v = lg[4 + j] * rs + cv[4 + j];
                const float v1 = lg[12 + j] * rs + cv[12 + j], v2 = lg[20 + j] * rs + cv[20 + j], v3 = lg[28 + j] * rs + cv[28 + j];
                v = gsel == 1 ? v1 : v; v = gsel == 2 ? v2 : v; v = gsel == 3 ? v3 : v; el[j] = v; }
            int t1 = 0; float m1 = -3.0e38f;
#pragma unroll
            for (int j = 0; j < 8; ++j) if (el[j] > m1) { m1 = el[j]; t1 = j; }
            int t2 = 0; float m2 = -3.0e38f;
#pragma unroll
            for (int j = 0; j < 8; ++j) if (j != t1 && el[j] > m2) { m2 = el[j]; t2 = j; }
            const float e2 = __expf(m2 - m1); const float w1 = pg / (1.f + e2), w2 = pg * e2 / (1.f + e2);
            const int e0 = gsel * 8 + t1, e1 = gsel * 8 + t2;
            const int lr0 = __hip_atomic_fetch_add(&lcnt[e0], 1, __ATOMIC_RELAXED, __HIP_MEMORY_SCOPE_WORKGROUP), lr1 = __hip_atomic_fetch_add(&lcnt[e1], 1, __ATOMIC_RELAXED, __HIP_MEMORY_SCOPE_WORKGROUP);
            *(GAS i32x4*)(INFO + 4 * (size_t)row) = (i32x4){e0, e1, lr0, lr1};
            *(GAS f32x2*)(WTS + 2 * (size_t)row) = (f32x2){w1, w2};
        }
        const float* n2g = INP(I_N2G) + l * 1024; const float* mod = MOD + (size_t)brow * 6144;
        f32x4 gsc[4], shv[4];
#pragma unroll
        for (int j = 0; j < 4; ++j) { const int e = 2 * lane + 128 * (j >> 1) + (j & 1); const f32x4 g = *((const GAS f32x4*)n2g + e), sc = *((const GAS f32x4*)(mod + 4096) + e); gsc[j] = g * (sc + 1.f); shv[j] = *((const GAS f32x4*)(mod + 3072) + e); }
#pragma unroll 1
        for (int r4 = 0; r4 < 16; r4 += 4) {
            v4u v[4][2];
#pragma unroll
            for (int q = 0; q < 4; ++q)
#pragma unroll
                for (int j = 0; j < 2; ++j) v[q][j] = *((const GAS v4u*)(hbase + (size_t)(r4 + q) * 1024) + lane + 64 * j);
#pragma unroll
            for (int q = 0; q < 4; ++q) { const float rsr = shl(rs, r4 + q);
#pragma unroll
                for (int j = 0; j < 2; ++j) { const f32x4 y0 = pg8::unlo4(v[q][j]) * rsr * gsc[2 * j] + shv[2 * j], y1 = pg8::unhi4(v[q][j]) * rsr * gsc[2 * j + 1] + shv[2 * j + 1];
                    *((GAS v2u*)((unsigned char*)XN + (size_t)(row0 + r4 + q) * 1024) + lane + 64 * j) = (v2u){pk4_f8(y0[0], y0[1], y0[2], y0[3]), pk4_f8(y1[0], y1[1], y1[2], y1[3])}; } }
        }
    }
    if (nrows > TL) {
        LAS float* red = (LAS float*)(F.lds + 32768);
        LAS float* ssp = red + 8 * 16 * 49;
        const int wave = F.wave, koff = 128 * wave + 8 * kg;
#pragma unroll 1
        for (int tj = F.bx; tj < TC / 16; tj += F.G) {
            const int row0 = TL + tj * 16;
            const bf16* hq = HB + (size_t)(row0 + i16) * 1024 + koff;
            v4u hw8[4];
#pragma unroll
            for (int jp = 0; jp < 4; ++jp) hw8[jp] = *(const GAS v4u*)(hq + 32 * jp);
            const unsigned wvo = (unsigned)((koff * 48 + i16) * 4);
            f32x4 a0 = (f32x4){0.f, 0.f, 0.f, 0.f}, a1 = a0, a2 = a0; float ss = 0.f;
#pragma unroll
            for (int jp = 0; jp < 4; ++jp) {
                float wv[2][4][3];
#pragma unroll
                for (int hf = 0; hf < 2; ++hf)
#pragma unroll
                    for (int c = 0; c < 4; ++c) { const GAS float* wr_ = (const GAS float*)((const GAS char*)(WP + ((size_t)16 * 1024 + 32 * jp) * 48) + wvo) + (4 * hf + c) * 48; wv[hf][c][0] = wr_[0]; wv[hf][c][1] = wr_[16]; wv[hf][c][2] = wr_[32]; }
#pragma unroll
                for (int hf = 0; hf < 2; ++hf) { const f32x4 x = hf ? pg8::unhi4(hw8[jp]) : pg8::unlo4(hw8[jp]); ss += (x[0] * x[0] + x[1] * x[1]) + (x[2] * x[2] + x[3] * x[3]);
#pragma unroll
                    for (int c = 0; c < 4; ++c) {
                        a0 = __builtin_amdgcn_mfma_f32_16x16x4f32(x[c], wv[hf][c][0], a0, 0, 0, 0);
                        a1 = __builtin_amdgcn_mfma_f32_16x16x4f32(x[c], wv[hf][c][1], a1, 0, 0, 0);
                        a2 = __builtin_amdgcn_mfma_f32_16x16x4f32(x[c], wv[hf][c][2], a2, 0, 0, 0); } }
            }
            ss += shx(ss, 16, lane); ss += shx(ss, 32, lane);
            { LAS float* rw = red + wave * (16 * 49);
#pragma unroll
              for (int rg = 0; rg < 4; ++rg) { rw[(4 * kg + rg) * 49 + i16] = a0[rg]; rw[(4 * kg + rg) * 49 + 16 + i16] = a1[rg]; rw[(4 * kg + rg) * 49 + 32 + i16] = a2[rg]; }
              if (kg == 0) ssp[wave * 16 + i16] = ss; }
            __syncthreads();
            float rs;
            { float sst = 0.f;
#pragma unroll
              for (int w = 0; w < 8; ++w) sst += ssp[w * 16 + i16];
              rs = rsqrtf(sst * (1.f / 1024.f) + EPSN); }
            if (F.tid < 16) {
                const int row = row0 + lane; const float* cv = CV + 16 * 48;
                float gl[4]; int gsel = 0; float gm = -3.0e38f;
#pragma unroll
                for (int j = 0; j < 4; ++j) { float s = 0.f;
#pragma unroll
                    for (int w = 0; w < 8; ++w) s += red[(w * 16 + lane) * 49 + j];
                    gl[j] = s * rs + cv[j]; if (gl[j] > gm) { gm = gl[j]; gsel = j; } }
                float den = 0.f;
#pragma unroll
                for (int j = 0; j < 4; ++j) den += __expf(gl[j] - gm);
                const float pg = 1.f / den;
                float el[8];
#pragma unroll
                for (int j = 0; j < 8; ++j) { float s = 0.f; const int col = 4 + 8 * gsel + j;
#pragma unroll
                    for (int w = 0; w < 8; ++w) s += red[(w * 16 + lane) * 49 + col];
                    el[j] = s * rs + cv[col]; }
                int t1 = 0; float m1 = -3.0e38f;
#pragma unroll
                for (int j = 0; j < 8; ++j) if (el[j] > m1) { m1 = el[j]; t1 = j; }
                int t2 = 0; float m2 = -3.0e38f;
#pragma unroll
                for (int j = 0; j < 8; ++j) if (j != t1 && el[j] > m2) { m2 = el[j]; t2 = j; }
                const float e2 = __expf(m2 - m1); const float w1 = pg / (1.f + e2), w2 = pg * e2 / (1.f + e2);
                const int e0 = gsel * 8 + t1, e1 = gsel * 8 + t2;
                const int lr0 = __hip_atomic_fetch_add(&lcnt[e0], 1, __ATOMIC_RELAXED, __HIP_MEMORY_SCOPE_WORKGROUP), lr1 = __hip_atomic_fetch_add(&lcnt[e1], 1, __ATOMIC_RELAXED, __HIP_MEMORY_SCOPE_WORKGROUP);
                *(GAS i32x4*)(INFO + 4 * (size_t)row) = (i32x4){e0, e1, lr0, lr1};
                *(GAS f32x2*)(WTS + 2 * (size_t)row) = (f32x2){w1, w2};
            }
            {
                const float* n2g = INP(I_N2G) + l * 1024; const float* mod = MOD + (size_t)16 * 6144;
                unsigned char* xr = (unsigned char*)XN + (size_t)(row0 + i16) * 1024 + koff;
#pragma unroll
                for (int jp = 0; jp < 4; ++jp) { v2u o;
#pragma unroll
                    for (int hf = 0; hf < 2; ++hf) { const int k = koff + 32 * jp + 4 * hf;
                        const f32x4 g = *(const GAS f32x4*)(n2g + k), sh = *(const GAS f32x4*)(mod + 3072 + k), sc = *(const GAS f32x4*)(mod + 4096 + k);
                        const f32x4 y = (hf ? pg8::unhi4(hw8[jp]) : pg8::unlo4(hw8[jp])) * rs * g * (sc + 1.f) + sh; const unsigned w4 = pk4_f8(y[0], y[1], y[2], y[3]); if (hf == 0) o.x = w4; else o.y = w4; }
                    *(GAS v2u*)(xr + 32 * jp) = o; }
            }
            __syncthreads();
        }
    }
    __syncthreads();
    if (F.tid < 32) CNT[F.bx * 32 + F.tid] = lcnt[F.tid];
}

__device__ __forceinline__ void p10_dispatch(const Frame& F0, int nrows) {
    PHASE_FRAME(F0);
    LAS int* cnts = (LAS int*)F.lds; LAS int* tot = (LAS int*)(F.lds + 32768); LAS int* base = tot + 32; LAS int* offs = base + 32;
    const int* CNT = (const int*)(F.ws + WS_RT + RT_CNT); const int* INFO = (const int*)(F.ws + WS_RT + RT_INFO); const float* WTS = (const float*)(F.ws + WS_RT + RT_W);
    int* DEST = (int*)(F.ws + WS_RT + RT_DEST); int* OFFT = (int*)(F.ws + WS_RT + RT_OFF); int* ROWTOK = (int*)(F.ws + WS_RT + RT_ROWTOK); float* ROWW = (float*)(F.ws + WS_RT + RT_ROWW);
    for (int i = F.tid; i < F.G * 32; i += NWAVES * 64) cnts[i] = CNT[i];
    __syncthreads();
    if (F.tid < 32) { int t = 0, bsum = 0; for (int blk = 0; blk < F.G; ++blk) { const int c = cnts[blk * 32 + F.tid]; if (blk < F.bx) bsum += c; t += c; } tot[F.tid] = t; base[F.tid] = bsum; }
    __syncthreads();
    if (F.tid == 0) { int o = 0; for (int e = 0; e < 32; ++e) { offs[e] = o; o += (tot[e] + 255) & ~255; } offs[32] = o; }
    __syncthreads();
    if (F.bx == 0 && F.tid < 33) OFFT[F.tid] = offs[F.tid] >> 8;
    const int nlat = (TL / 128 - F.bx + F.G - 1) / F.G, nctx = (nrows > TL && F.bx < TC / 16) ? (TC / 16 - F.bx + F.G - 1) / F.G : 0;
    for (int idx = F.tid; idx < nlat * 128 + nctx * 16; idx += NWAVES * 64) {
        int row; if (idx < nlat * 128) row = (F.bx + (idx >> 7) * F.G) * 128 + (idx & 127); else { const int i2 = idx - nlat * 128; row = TL + (F.bx + (i2 >> 4) * F.G) * 16 + (i2 & 15); }
        { const i32x4 inf = *(const GAS i32x4*)(INFO + 4 * (size_t)row); const f32x2 w = *(const GAS f32x2*)(WTS + 2 * (size_t)row);
            const int d0 = offs[inf.x] + base[inf.x] + inf.z, d1 = offs[inf.y] + base[inf.y] + inf.w;
            ROWTOK[d0] = row; ROWW[d0] = w.x; ROWTOK[d1] = row; ROWW[d1] = w.y; DEST[2 * row] = d0; DEST[2 * row + 1] = d1; }
    }
    for (int e = F.bx; e < 32; e += F.G) for (int r = offs[e] + tot[e] + F.tid; r < offs[e + 1]; r += NWAVES * 64) { ROWTOK[r] = 0; ROWW[r] = 0.f; }
}

__device__ __forceinline__ LAS int* load_toff(const Frame& F0) {
    PHASE_FRAME(F0);
    LAS int* toff = (LAS int*)(F.lds + LDSCTL_OFF);
    if (F.tid < 33) toff[F.tid] = ((const int*)(F.ws + WS_RT + RT_OFF))[F.tid];
    __syncthreads();
    return toff;
}
constexpr int NPH_LAYER = 10, NPHASE = 1 + DEPTH * NPH_LAYER + 1;
struct Args { const float* in[24]; float* out; unsigned char* ws; int ph_lo, ph_hi; };
__global__ void __launch_bounds__(NWAVES * 64, 2) fwd_kernel(Args args) {
    extern __shared__ __attribute__((aligned(16))) unsigned char lds[];
    Frame F;
    F.lds = (LAS unsigned char*)lds;
    F.MISC = (volatile LAS unsigned*)(F.lds + MISC_OFF);
    F.tid = threadIdx.x; F.lane = F.tid & 63; F.wave = __builtin_amdgcn_readfirstlane(F.tid >> 6);
    F.G = gridDim.x; F.bx = blockIdx.x;
    F.ws = args.ws; F.out = args.out; F.ctl = (gu32*)(args.ws + WS_CTL);
    if (F.tid < 24) { const unsigned long long pv = (unsigned long long)args.in[F.tid]; ((LAS unsigned*)(F.lds + PTRS_OFF))[2 * F.tid] = (unsigned)pv; ((LAS unsigned*)(F.lds + PTRS_OFF))[2 * F.tid + 1] = (unsigned)(pv >> 32); }
    for (int u = F.tid + (MISC_OFF - LDSCTL_OFF) / 4; u < (LDS_BYTES - LDSCTL_OFF) / 4; u += NWAVES * 64) ((LAS unsigned*)(F.lds + LDSCTL_OFF))[u] = 0u;
    __syncthreads();
    XcdBarrier bar; bar.bar = (unsigned*)(F.ctl + CW_BAR); bar.x = 0; bar.st = nullptr;
    if (!MK_PER_PHASE) bar = xcd_barrier_post((unsigned*)(F.ctl + CW_BAR), F.MISC + 8);
    const int lo = args.ph_lo, hi = args.ph_hi;
#ifndef PHASE_MASK
#define PHASE_MASK 0xFFFFu
#endif
#define PH_ON(j) (((PHASE_MASK) >> (j)) & 1u)
#ifndef WGM_IN
#define WGM_IN 17
#endif
#ifndef WGM_G8
#define WGM_G8 8
#endif
#ifndef WGM_N1
#define WGM_N1 8
#endif
#ifndef PROBE_KDIV
#define PROBE_KDIV 1
#endif
#ifndef REP_MASK
#define REP_MASK 0u
#endif
#define NREP(j) (1 + (int)(((REP_MASK) >> (j)) & 1u))
#define IN(k) (lo <= (k) && (k) < hi)
#define SEAM(k) do { if (IN(k) && IN((k) + 1)) { if (MK_PER_PHASE) { if (F.tid == 0) __hip_atomic_store(F.ctl + CW_TMO, 0xBADBA0u, RLX_AGENT); } else { xcd_barrier(bar); if (NREP(14) > 1) { xcd_barrier(bar); xcd_barrier(bar); } } } } while (0)

#ifdef POISON_WS
    if (IN(0)) {
#define POISON_RANGE(bit, lo, hi) if ((POISON_WS >> (bit)) & 1) { v4u* p = (v4u*)(F.ws + (lo)); const size_t n = ((hi) - (lo)) / 16; \
            for (size_t i = (size_t)F.bx * 512 + F.tid; i < n; i += (size_t)F.G * 512) p[i] = (v4u){0xFFFFFFFFu, 0xFFFFFFFFu, 0xFFFFFFFFu, 0xFFFFFFFFu}; }
        POISON_RANGE(0, WS_MOD, WS_W)
        POISON_RANGE(1, WS_W, WS_XN)
        POISON_RANGE(2, WS_XN, WS_Z)
        POISON_RANGE(3, Z_QF, Z_Y2)
        POISON_RANGE(4, Z_Y2, Z_KG)
        POISON_RANGE(5, Z_KG, Z_SG)
        POISON_RANGE(6, Z_SG, Z_DEC)
        POISON_RANGE(7, Z_DEC, WS_END)
        POISON_RANGE(8, W_DN1, WS_NEED)
        xcd_barrier(bar);
    }
#endif
    if (PH_ON(12) && IN(0)) { for (int rep_ = 0; rep_ < 1 + 3 * (NREP(12) - 1); ++rep_) p0_prologue(F); }
    SEAM(0);

#pragma unroll 1
    for (int l = 0; l < DEPTH; ++l) {
        const int pb = 1 + l * NPH_LAYER;
        const bool need_ctx = l < DEPTH - 1;
        const int nrows = need_ctx ? TT : TL;
        unsigned char* W = F.ws + WS_W + (size_t)(l & 1) * W_PSTRIDE; unsigned char* WDN = F.ws + ((l & 1) ? W_DN1 : W_DN0);
        const int cv_rem = (nrows / 256 * 4) % F.G, cv_nw = (cv_rem ? F.G - cv_rem : F.G) * NWAVES, cv_id = cv_rem ? ((int)F.bx - cv_rem) * NWAVES + F.wave : (int)F.bx * NWAVES + F.wave;
        if (PH_ON(0) && IN(pb + 0)) { row_pass(F, l, l == 0 ? 0 : 1); for (int rep_ = 0; rep_ < NREP(0); ++rep_) { if (l == 0) convert_items(F, 0, 0, 1, F.bx * NWAVES + F.wave, F.G * NWAVES); convert_layer(F, l); } } SEAM(pb + 0);
        if (PH_ON(1) && IN(pb + 1)) { for (int rep_ = 0; rep_ < NREP(1); ++rep_) {
            pg8::Gemm g{WSP(bf16, WS_XN), (const bf16*)(W + W_IN), 1024, 1024, 1024, 0, nullptr}; pg8::StaticOrder S; S.init(TT, 3328, F.G, F.bx, WGM_IN);
            pg8::EpiZ E{F.ws, l, INP(I_QNG) + l * 64, INP(I_KNG) + l * 64};
            pg8::gemm_phase<pg8::EpiZ, pg8::StaticOrder, true, false>(F.lds + RING_OFF, g, S, E);
            {
                pg8::Gemm g8{WSP(bf16, Z_OB), (const bf16*)(W + W_IN8), 512, 512, 512, 0, (const int*)(F.ws + WS_TAB + 65536)}; pg8::StaticOrder S8; S8.init(TT, 2048, F.G, F.bx, WGM_G8);
                pg8::EpiGates E8{WSP(bf16, Z_SG)};
                pg8::gemm_phase<pg8::EpiGates, pg8::StaticOrder, true, true, true, 0x7A7A7A7A, true>(F.lds + RING_OFF, g8, S8, E8);
            }
        } } SEAM(pb + 1);
        if (PH_ON(2) && IN(pb + 2)) { for (int rep_ = 0; rep_ < NREP(2); ++rep_) { p3_scan(F); } } SEAM(pb + 2);
        if (PH_ON(3) && IN(pb + 3)) { if (NREP(3) > 1) p4_attention(F, need_ctx, (char*)lds + RING_OFF, true); p4_attention(F, need_ctx, (char*)lds + RING_OFF, false); p5_headnorm(F, l, nrows); } SEAM(pb + 3);
        if (PH_ON(5) && IN(pb + 4)) { for (int rep_ = 0; rep_ < NREP(5); ++rep_) {
            pg8::Gemm g{WSP(bf16, Z_Y2), (const bf16*)(W + W_UP), 1024, 1024, 1024, 0, nullptr}; pg8::StaticOrder S; S.init(nrows, 1024, F.G, F.bx, need_ctx ? WGM_N1 : 8);
            pg8::EpiMergeF E{WSP(bf16, WS_XN), WSP(bf16, Z_SG)};
            pg8::gemm_phase<pg8::EpiMergeF, pg8::StaticOrder, true, false>(F.lds + RING_OFF, g, S, E);
            if (need_ctx && cv_id >= 0) convert_items(F, l + 1, 0, 2, cv_id, cv_nw);
        } } SEAM(pb + 4);
        if (PH_ON(7) && IN(pb + 5)) {
            pg8::Gemm g{WSP(bf16, WS_XN), (const bf16*)(W + W_OUT), 1024, 1024, 1024, 0, nullptr}; pg8::StaticOrder S; S.init(nrows, 1024, F.G, F.bx, need_ctx ? WGM_N1 : 8);
            pg8::EpiOut E{l == DEPTH - 1 ? WSP(bf16, Z_SG) : (bf16*)F.out, (const bf16*)F.out, WSP(float, WS_MOD) + (size_t)l * 17 * 6144, INP(I_X), INP(I_CTX), l == 0};
            pg8::gemm_phase<pg8::EpiOut, pg8::StaticOrder, true, false>(F.lds + RING_OFF, g, S, E);
            if (need_ctx && cv_id >= 0) convert_items(F, l + 1, 1, 2, cv_id, cv_nw);
        } SEAM(pb + 5);
        if (PH_ON(8) && IN(pb + 6)) { for (int rep_ = 0; rep_ < NREP(8); ++rep_) { p9_router(F, l, nrows); } } SEAM(pb + 6);
        if (PH_ON(9) && IN(pb + 7)) { for (int rep_ = 0; rep_ < NREP(9); ++rep_) { p10_dispatch(F, nrows); } } SEAM(pb + 7);
        if (PH_ON(10) && IN(pb + 8)) { for (int rep_ = 0; rep_ < NREP(10); ++rep_) {
            LAS int* toff = load_toff(F);
            pg8::Gemm g{WSP(bf16, WS_XN), (const bf16*)(W + W_GU), (NREP(10) > 1 && rep_ == 0) ? 512 / PROBE_KDIV : 512, 512, 512, (size_t)1024 * 512, (const int*)(F.ws + WS_RT + RT_ROWTOK)}; pg8::MoeOrder S{toff, F.G, F.bx};
            pg8::EpiSwiGLU E{F.ws + Z_H};
            pg8::gemm_phase<pg8::EpiSwiGLU, pg8::MoeOrder, true, true, true>(F.lds + RING_OFF, g, S, E);
        } } SEAM(pb + 8);
        if (PH_ON(11) && IN(pb + 9)) { for (int rep_ = 0; rep_ < NREP(11); ++rep_) {
            LAS int* toff = load_toff(F);
            pg8::Gemm g{WSP(bf16, Z_H), (const bf16*)(WDN), 256, 256, 256, (size_t)1024 * 256, (const int*)(F.ws + WS_TAB + 65536)}; pg8::MoeOrder S{toff, F.G, F.bx};
            pg8::EpiDown E{F.ws + Z_YB, (const float*)(F.ws + WS_RT + RT_ROWW)};
            pg8::gemm_phase<pg8::EpiDown, pg8::MoeOrder, true, true, true, 0x7B7B7B7B, true>(F.lds + RING_OFF, g, S, E);
        } } SEAM(pb + 9);
    }
    if (PH_ON(13) && IN(NPHASE - 1)) { row_pass(F, DEPTH, 2); }
#undef IN
#undef SEAM
}

extern "C" void kernel_launch(void* const* d_in, const int* in_sizes, int n_in, void* d_out, int out_size, void* d_ws, size_t ws_size, hipStream_t stream) {
    static int grid = 0;
    if (grid == 0) {
        if (n_in != 24 || in_sizes[0] != TL * D || out_size != TL * D || ws_size < WS_NEED) { fprintf(stderr, "kernel_launch: unexpected problem shape / workspace (%d inputs, ws %zu, need %zu); nothing launched\n", n_in, ws_size, (size_t)WS_NEED); grid = -1; return; }
        int dev = 0, cus = 0, per_cu = 0;
        if (hipGetDevice(&dev) != hipSuccess || hipDeviceGetAttribute(&cus, hipDeviceAttributeMultiprocessorCount, dev) != hipSuccess) { grid = -1; return; }
        if (hipFuncSetAttribute((const void*)fwd_kernel, hipFuncAttributeMaxDynamicSharedMemorySize, LDS_BYTES) != hipSuccess) { fprintf(stderr, "kernel_launch: hipFuncSetAttribute failed\n"); grid = -1; return; }
        if (hipOccupancyMaxActiveBlocksPerMultiprocessor(&per_cu, (const void*)fwd_kernel, NWAVES * 64, LDS_BYTES) != hipSuccess || per_cu < 1) { fprintf(stderr, "kernel_launch: occupancy query reports %d blocks per CU\n", per_cu); }
        (void)hipGetLastError();
        grid = cus;
        if (grid > 256) grid = 256;
    }
    if (grid < 0) return;
    if (hipMemsetAsync((char*)d_ws + WS_CTL, 0, CTL_ZERO_BYTES, stream) != hipSuccess) return;
    Args a{};
    for (int i = 0; i < 24; ++i) a.in[i] = (const float*)d_in[i];
    a.out = (float*)d_out; a.ws = (unsigned char*)d_ws;
#if MK_PER_PHASE
    for (int p = 0; p < NPHASE; ++p) { a.ph_lo = p; a.ph_hi = p + 1; hipLaunchKernelGGL(fwd_kernel, dim3(grid), dim3(NWAVES * 64), LDS_BYTES, stream, a); }
#else
    a.ph_lo = 0; a.ph_hi = NPHASE;
    hipLaunchKernelGGL(fwd_kernel, dim3(grid), dim3(NWAVES * 64), LDS_BYTES, stream, a);
#endif
    const hipError_t le = hipPeekAtLastError();
    if (le != hipSuccess) fprintf(stderr, "kernel_launch: launch failed: %s\n", hipGetErrorName(le));
}
```

```cpp
#include <hip/hip_runtime.h>
#include <hip/hip_bf16.h>
#include <cstdio>
#include <cstdint>
#include <cmath>

#ifndef MK_PER_PHASE
#define MK_PER_PHASE 0
#endif

constexpr int D = 1024, NBATCH = 16, SEQ = 4096, CTXL = 256, DEPTH = 4;
constexpr int TL = NBATCH * SEQ, TC = NBATCH * CTXL, TT = TL + TC;
constexpr int NZ = 5376, KVLEN = CTXL + SEQ;
constexpr int NEXP = 32, DEXP = 512, RCAP = 2 * TT + NEXP * 256;
constexpr int NCHUNK = TT / 64;
constexpr float EPSN = 1e-6f;
constexpr float QC2 = 0.125f * 1.4426950408889634f;

constexpr size_t MiB = 1u << 20;
constexpr size_t WS_CTL = 0, CTL_ZERO_BYTES = 1 * MiB;
constexpr size_t WS_MOD = 1 * MiB;
constexpr size_t WS_TAB = 3 * MiB;
constexpr size_t WS_WR = 4 * MiB;
constexpr size_t WR_CVEC = (size_t)17 * 1024 * 48 * 4;
constexpr size_t WS_RT = 8 * MiB;
constexpr size_t RT_INFO = 0;
constexpr size_t RT_W = RT_INFO + (size_t)TT * 16;
constexpr size_t RT_DEST = RT_W + (size_t)TT * 8;
constexpr size_t RT_CNT = RT_DEST + (size_t)TT * 8;
constexpr size_t RT_OFF = RT_CNT + 256 * 32 * 4;
constexpr size_t RT_ROWTOK = RT_OFF + 256;
constexpr size_t RT_ROWW = RT_ROWTOK + (size_t)RCAP * 4;
static_assert(RT_ROWW + (size_t)RCAP * 4 <= 4 * MiB, "routing arrays");
constexpr size_t WS_HC = 12 * MiB;
constexpr size_t WS_W = 28 * MiB;
constexpr size_t W_IN = 0;
constexpr size_t W_IN8 = W_IN + (size_t)3328 * 1024 * 2;
constexpr size_t W_UP = W_IN + (size_t)NZ * 1024 * 2;
constexpr size_t W_OUT = W_UP + (size_t)1024 * 1024 * 2;
constexpr size_t W_GU = W_OUT + (size_t)1024 * 1024 * 2;
constexpr size_t W_PSTRIDE = 47 * MiB;
constexpr size_t W_DN0 = WS_W + 94 * MiB, W_DN1 = 1206 * MiB;
static_assert(W_GU + (size_t)32 * 1024 * 1024 <= W_PSTRIDE && W_DN0 + 16 * MiB <= 139 * MiB, "weights");
constexpr size_t WS_XN = 139 * MiB;
constexpr size_t WS_Z = 275 * MiB;
constexpr size_t SZ512 = (size_t)TT * 512 * 2;
constexpr size_t Z_QF = WS_Z, Z_KF = Z_QF + SZ512, Z_QB = Z_KF + SZ512, Z_KB = Z_QB + SZ512, Z_VA = Z_KB + SZ512, Z_OG = Z_VA + SZ512;
constexpr size_t Z_Y2 = Z_OG + SZ512;
constexpr size_t Z_OB = Z_Y2 + 2 * SZ512;
constexpr size_t Z_KG = Z_OB + SZ512;
constexpr size_t Z_VG = Z_KG + (size_t)NBATCH * KVLEN * 128 * 2;
constexpr size_t Z_SG = Z_VG + (size_t)NBATCH * KVLEN * 128 * 2;
constexpr size_t Z_DEC = Z_SG + (size_t)TT * 2048 * 2;
constexpr size_t WS_END = Z_DEC + (size_t)NCHUNK * 2 * 3 * 512 * 4;
constexpr size_t Z_H = WS_Z;
constexpr size_t Z_YB = Z_H + (size_t)RCAP * 512 * 2;
static_assert(Z_YB + (size_t)RCAP * 1024 * 2 <= Z_SG, "MoE overlay");
constexpr size_t WS_NEED = W_DN1 + 16 * MiB;
static_assert(WS_END <= W_DN1 && WS_NEED <= (size_t)1252 * MiB, "d_ws budget");
constexpr int CW_TMO = 0, CW_BAR = 4096;

constexpr int RING_OFF = 0, RING_BYTES = 131072;
constexpr int LDSCTL_OFF = RING_BYTES, PTRS_OFF = LDSCTL_OFF + 512, MISC_OFF = LDSCTL_OFF + 1024;
constexpr int LDS_BYTES = 147456;
constexpr int NWAVES = 8;

#define GAS __attribute__((address_space(1)))
#define LAS __attribute__((address_space(3)))
typedef unsigned short bf16;
typedef unsigned v4u __attribute__((ext_vector_type(4)));
typedef unsigned v2u __attribute__((ext_vector_type(2)));
typedef float f32x4 __attribute__((ext_vector_type(4)));
typedef float f32x2 __attribute__((ext_vector_type(2)));
typedef int i32x4 __attribute__((ext_vector_type(4)));
typedef short bf16x8 __attribute__((ext_vector_type(8)));
typedef GAS unsigned gu32;
#define RLX_AGENT __ATOMIC_RELAXED, __HIP_MEMORY_SCOPE_AGENT
#define LDS_WAIT() asm volatile("s_waitcnt lgkmcnt(0)" ::: "memory")
#define VM_WAIT() asm volatile("s_waitcnt vmcnt(0)" ::: "memory")
__device__ __forceinline__ unsigned f2bf(float f) { unsigned u = __builtin_bit_cast(unsigned, f); return (u + 0x7fffu + ((u >> 16) & 1u)) >> 16; }
typedef __bf16 bf16x2_t __attribute__((ext_vector_type(2)));
__device__ __forceinline__ unsigned pk2(float lo, float hi) { const f32x2 v = {lo, hi}; const bf16x2_t b = __builtin_convertvector(v, bf16x2_t); return __builtin_bit_cast(unsigned, b); }
__device__ __forceinline__ float bf2f(unsigned short b) { return __builtin_bit_cast(float, (unsigned)b << 16); }
__device__ __forceinline__ float bflo(unsigned w) { return __builtin_bit_cast(float, w << 16); }
__device__ __forceinline__ float bfhi(unsigned w) { return __builtin_bit_cast(float, w & 0xffff0000u); }
__device__ __forceinline__ v2u pk4(f32x4 v) { v2u r; r.x = pk2(v[0], v[1]); r.y = pk2(v[2], v[3]); return r; }
__device__ __forceinline__ f32x4 unpk4(v2u w) { return (f32x4){bflo(w.x), bfhi(w.x), bflo(w.y), bfhi(w.y)}; }
__device__ __forceinline__ float sigmoidf_(float z) { const float e = __expf(-fabsf(z)); const float r = __builtin_amdgcn_rcpf(1.f + e); return z >= 0.f ? r : e * r; }
__device__ __forceinline__ float siluf_(float z) { return z * __builtin_amdgcn_rcpf(1.f + __builtin_amdgcn_exp2f(-1.4426950408889634f * z)); }
__device__ __forceinline__ float shx(float v, int mask, int lane) { return __builtin_bit_cast(float, __builtin_amdgcn_ds_bpermute((lane ^ mask) << 2, __builtin_bit_cast(int, v))); }
__device__ __forceinline__ float shl(float v, int src) { return __builtin_bit_cast(float, __builtin_amdgcn_ds_bpermute(src << 2, __builtin_bit_cast(int, v))); }
__device__ __forceinline__ float wave_sum(float v, int lane) {
#pragma unroll
    for (int o = 1; o < 64; o <<= 1) v += shx(v, o, lane);
    return v;
}
namespace pg8 {
constexpr int BM = 256, BK = 64, HALF = 128, HTB = HALF * BK * 2, STAGE_BYTES = 8 * HTB, NXCD = 8, WGM = 8;
__host__ __device__ __forceinline__ int lds_byte(int r, int c) { const int st = (r >> 4) * 2 + (c >> 5), rr = r & 15, cc = c & 31, ob = rr * 64 + cc * 2; return st * 1024 + (ob ^ (((ob >> 9) & 1) << 5)); }
__host__ __device__ __forceinline__ void stage_rc(int b, int& R, int& C) { const int st = b / 1024, sb = b % 1024, swz = sb ^ (((sb >> 9) & 1) << 5); R = (st >> 1) * 16 + swz / 64; C = (st & 1) * 32 + (swz % 64) / 2; }

typedef int v4i_t __attribute__((ext_vector_type(4)));
struct Unit { int pm, pn, be; };
struct Gemm { const bf16* A; const bf16* Bt; int K, lda, ldb; size_t bstride; const int* rowidx; int delay = 0; };

struct StaticOrder {
    int nM, nN, nwg, G, c, wgm;
    __device__ void init(int M, int N, int G_, int c_, int wgm_ = WGM) { nM = M / BM; nN = N / BM; nwg = nM * nN; G = G_; c = c_; wgm = wgm_; }
    int nfull = 1 << 30, nheavy = 0;
    __device__ bool next(int i, Unit& u) const {
        long L = (long)i * G + c;
        if (i >= nfull) { if (c < nheavy) return false; L = (long)nfull * G + (long)(i - nfull) * (G - nheavy) + (c - nheavy); }
        if (L >= nwg) return false;
        int wgid = (int)L; { const int q = nwg / NXCD, r = nwg % NXCD, xcd = wgid % NXCD, off = wgid / NXCD; wgid = (xcd < r ? xcd * (q + 1) : r * (q + 1) + (xcd - r) * q) + off; }
        const int nig = wgm * nN, gid = wgid / nig, fm = gid * wgm, gsz = (nM - fm) < wgm ? (nM - fm) : wgm;
        u.pm = fm + ((wgid % nig) % gsz); u.pn = (wgid % nig) / gsz; u.be = 0; return true;
    }
};
struct SimpleOrder {
    int nM, nN, G, c;
    __device__ bool next(int i, Unit& u) const { const int L = i * G + c; if (L >= nM * nN) return false; u.pm = L / nN; u.pn = L % nN; u.be = 0; return true; }
};
struct MoeOrder {
    const LAS int* toff; int G, c;
    __device__ bool next(int i, Unit& u) const {
        int L = i * G + c; const int nt = toff[32];
        if ((G & 31) == 0) { const int xcd = c & 7, j = c >> 3; L = ((i * (G >> 2) + xcd * (G >> 5) + (j >> 2)) << 2) | (j & 3); }
        if (L >= nt * 4) return false;
        u.pm = L >> 2; u.pn = L & 3;
        const int ln = (int)__builtin_amdgcn_mbcnt_lo(~0u, 0u);
        const unsigned long long bal = __builtin_amdgcn_ballot_w64(ln >= 1 && toff[ln] <= u.pm);
        u.be = __builtin_popcount((unsigned)bal); return true;
    }
};
__device__ __forceinline__ unsigned cvt_pk_bf16(float lo, float hi) { unsigned r; asm volatile("v_cvt_pk_bf16_f32 %0, %1, %2" : "=v"(r) : "v"(lo), "v"(hi)); return r; }
__device__ __forceinline__ v2u cpk4(f32x4 v) { v2u r; r.x = cvt_pk_bf16(v[0], v[1]); r.y = cvt_pk_bf16(v[2], v[3]); return r; }
__device__ __forceinline__ v4u cpk8(f32x4 a, f32x4 b) { v4u r; r.x = cvt_pk_bf16(a[0], a[1]); r.y = cvt_pk_bf16(a[2], a[3]); r.z = cvt_pk_bf16(b[0], b[1]); r.w = cvt_pk_bf16(b[2], b[3]); return r; }
__device__ __forceinline__ f32x4 unlo4(v4u w) { return (f32x4){bflo(w.x), bfhi(w.x), bflo(w.y), bfhi(w.y)}; }
__device__ __forceinline__ f32x4 unhi4(v4u w) { return (f32x4){bflo(w.z), bfhi(w.z), bflo(w.w), bfhi(w.w)}; }

template <class Epi, class Sched, bool ALIGN_EPI, bool GATHER, bool F8 = false, int WSCALE = 0x7A7A7A7A, bool IDENT = false>
__device__ __forceinline__ void gemm_phase(LAS unsigned char* lds, const Gemm g, const Sched& S, const Epi& E) {
    int tid_ = threadIdx.x; asm volatile("" : "+v"(tid_));
    const int tid = tid_, wid = __builtin_amdgcn_readfirstlane(tid >> 6), lane = tid & 63, wr = wid >> 2, wc = wid & 3, fr = lane & 15, fq = lane >> 4;
    const int K = g.K, nt = K / BK;
    int RA[2], CA[2];
    unsigned voA[2][2], voAn[2][2], voffB[2];
#pragma unroll
    for (int i = 0; i < 2; ++i) { stage_rc(tid * 16 + i * 8192, RA[i], CA[i]); voffB[i] = (unsigned)(RA[i] * g.ldb + CA[i]) * 2u;
#pragma unroll
        for (int h = 0; h < 2; ++h) { voA[h][i] = (unsigned)((h * HALF + RA[i]) * g.lda + CA[i]) * 2u; voAn[h][i] = voA[h][i]; } }
    const size_t kstep = (size_t)(BK * 2);
    const size_t hstepB = (size_t)HALF * g.ldb * 2, tstepB = 2 * hstepB, tstepA = (size_t)BM * g.lda * 2;
    const unsigned ldsw = (unsigned)wid * 1024u;
    const int aoff = lds_byte(wr * 64 + fr, fq * 8), boff = lds_byte(wc * 32 + fr, fq * 8);
#define PG8_SA(b, h) (((b) * 2 + (h)) * HTB)
#define PG8_SB(b, h) ((4 + (b) * 2 + (h)) * HTB)
#define PG8_STGA(bufoff, kptr, vo, h) do { _Pragma("unroll") for (int _i = 0; _i < 2; ++_i) \
        __builtin_amdgcn_global_load_lds((const unsigned*)((const char*)(kptr) + (vo)[h][_i]), (LAS unsigned*)(lds + (bufoff) + ldsw + _i * 8192), 16, 0, 0); } while (0)
#define PG8_STGB(bufoff, gbase) do { _Pragma("unroll") for (int _i = 0; _i < 2; ++_i) \
        __builtin_amdgcn_global_load_lds((const unsigned*)((const char*)(gbase) + voffB[_i]), (LAS unsigned*)(lds + (bufoff) + ldsw + _i * 8192), 16, 0, 0); } while (0)
#define PG8_LDA(dst, b, h) do { _Pragma("unroll") for (int m = 0; m < 4; ++m) _Pragma("unroll") for (int k = 0; k < 2; ++k) dst[m][k] = *(const LAS bf16x8*)(lds + PG8_SA(b, h) + aoff + m * 2048 + k * 1024); } while (0)
#define PG8_LDB(dst, b, h) do { _Pragma("unroll") for (int n = 0; n < 2; ++n) _Pragma("unroll") for (int k = 0; k < 2; ++k) dst[n][k] = *(const LAS bf16x8*)(lds + PG8_SB(b, h) + boff + n * 2048 + k * 1024); } while (0)
#define PG8_CAT8(x0, x1) __builtin_shufflevector(__builtin_bit_cast(v4i_t, x0), __builtin_bit_cast(v4i_t, x1), 0, 1, 2, 3, 4, 5, 6, 7)
#define PG8_MMA(ai, bj, At, Bt) do { __builtin_amdgcn_s_setprio(1); \
        if constexpr (F8) { _Pragma("unroll") for (int m = 0; m < 4; ++m) _Pragma("unroll") for (int n = 0; n < 2; ++n) \
            acc[ai][bj][m][n] = __builtin_amdgcn_mfma_scale_f32_16x16x128_f8f6f4(PG8_CAT8(Bt[n][0], Bt[n][1]), PG8_CAT8(At[m][0], At[m][1]), acc[ai][bj][m][n], 0, 0, 0, WSCALE, 0, 0x7F7F7F7F); } \
        else { _Pragma("unroll") for (int m = 0; m < 4; ++m) _Pragma("unroll") for (int n = 0; n < 2; ++n) _Pragma("unroll") for (int k = 0; k < 2; ++k) \
            acc[ai][bj][m][n] = __builtin_amdgcn_mfma_f32_16x16x32_bf16(Bt[n][k], At[m][k], acc[ai][bj][m][n], 0, 0, 0); } \
        __builtin_amdgcn_s_setprio(0); } while (0)
#define PG8_WAIT_V(n) asm volatile("s_waitcnt vmcnt(" #n ")" ::: "memory")
#define PG8_WAIT_L(n) asm volatile("s_waitcnt lgkmcnt(" #n ")" ::: "memory")
#define PG8_BAR __builtin_amdgcn_s_barrier()
#define PG8_SCHED __builtin_amdgcn_sched_barrier(0)
    Unit cur, nxt; int ui = 0;
    if (!S.next(0, cur)) return;
    if (g.delay > 0) { const unsigned long long t0_ = __builtin_amdgcn_s_memrealtime(); while ((long long)(__builtin_amdgcn_s_memrealtime() - t0_) < (long long)g.delay) __builtin_amdgcn_s_sleep(32); }
    f32x4 acc[2][2][4][2];
#pragma unroll
    for (int a = 0; a < 2; ++a)
#pragma unroll
        for (int b = 0; b < 2; ++b)
#pragma unroll
            for (int m = 0; m < 4; ++m)
#pragma unroll
                for (int n = 0; n < 2; ++n) acc[a][b][m][n] = (f32x4){0.f, 0.f, 0.f, 0.f};
    bf16x8 At[4][2], B0[2][2], B1[2][2];
    if constexpr (GATHER) {
#pragma unroll
        for (int h = 0; h < 2; ++h)
#pragma unroll
            for (int i = 0; i < 2; ++i) voA[h][i] = (unsigned)((IDENT ? cur.pm * BM + h * HALF + RA[i] : g.rowidx[cur.pm * BM + h * HALF + RA[i]]) * g.lda + CA[i]) * 2u;
    }
    const char* cA = GATHER ? (const char*)g.A : (const char*)g.A + (size_t)cur.pm * tstepA;
    const char* cB = (const char*)(g.Bt + (size_t)cur.be * g.bstride) + (size_t)cur.pn * tstepB;
    PG8_STGB(PG8_SB(0, 0), cB); PG8_STGB(PG8_SB(0, 1), cB + hstepB); PG8_STGA(PG8_SA(0, 0), cA, voA, 0); PG8_STGA(PG8_SA(0, 1), cA, voA, 1);
    if (wr == 1) PG8_BAR;
    PG8_WAIT_V(2); PG8_BAR;
    PG8_STGB(PG8_SB(1, 0), cB + kstep); PG8_STGA(PG8_SA(1, 0), cA + kstep, voA, 0); PG8_STGB(PG8_SB(1, 1), cB + hstepB + kstep);
    PG8_WAIT_V(6); PG8_BAR;
    for (;;) {
        const bool has_next = S.next(ui + 1, nxt);
        const char* nA = cA; const char* nB = cB;
        if (has_next) {
            nA = GATHER ? (const char*)g.A : (const char*)g.A + (size_t)nxt.pm * tstepA;
            nB = (const char*)(g.Bt + (size_t)nxt.be * g.bstride) + (size_t)nxt.pn * tstepB;
            if constexpr (GATHER) {
#pragma unroll
                for (int h = 0; h < 2; ++h)
#pragma unroll
                    for (int i = 0; i < 2; ++i) voAn[h][i] = (unsigned)((IDENT ? nxt.pm * BM + h * HALF + RA[i] : g.rowidx[nxt.pm * BM + h * HALF + RA[i]]) * g.lda + CA[i]) * 2u;
            }
        } else if constexpr (GATHER) {
#pragma unroll
            for (int h = 0; h < 2; ++h)
#pragma unroll
                for (int i = 0; i < 2; ++i) voAn[h][i] = voA[h][i];
        }
#pragma unroll 1
        for (int t = 0; t < nt; t += 2) {
            if constexpr (Epi::MIDK > 0) { if (t == Epi::MIDK) E.mid(acc, cur, wr, wc, fr, fq); }
            const bool last = (t == nt - 2);
            const char* a1 = cA + (size_t)(t + 1) * kstep;
            const char* a2 = last ? nA : cA + (size_t)(t + 2) * kstep; const char* b2 = last ? nB : cB + (size_t)(t + 2) * kstep;
            const char* a3 = a2 + kstep; const char* b3 = b2 + kstep;
            PG8_LDB(B0, 0, 0); PG8_LDB(B1, 0, 1); PG8_SCHED; PG8_LDA(At, 0, 0); PG8_STGA(PG8_SA(1, 1), a1, voA, 1);
            if constexpr (GATHER) { if (last) {
#pragma unroll
                for (int h = 0; h < 2; ++h)
#pragma unroll
                    for (int i = 0; i < 2; ++i) voA[h][i] = voAn[h][i]; } }
            PG8_WAIT_V(8); PG8_WAIT_L(0); PG8_BAR; PG8_MMA(0, 0, At, B0); PG8_MMA(0, 1, At, B1); PG8_BAR; PG8_SCHED;
            PG8_LDA(At, 0, 1); PG8_STGB(PG8_SB(0, 0), b2); PG8_STGB(PG8_SB(0, 1), b2 + hstepB); PG8_STGA(PG8_SA(0, 0), a2, voA, 0);
            PG8_WAIT_V(8); PG8_WAIT_L(0); PG8_BAR; PG8_MMA(1, 0, At, B0); PG8_MMA(1, 1, At, B1); PG8_BAR; PG8_SCHED;
            PG8_LDB(B0, 1, 0); PG8_LDB(B1, 1, 1); PG8_SCHED; PG8_LDA(At, 1, 0); PG8_STGA(PG8_SA(0, 1), a2, voA, 1);
            PG8_WAIT_V(8); PG8_WAIT_L(0); PG8_BAR; PG8_MMA(0, 0, At, B0); PG8_MMA(0, 1, At, B1); PG8_BAR; PG8_SCHED;
            PG8_LDA(At, 1, 1); PG8_STGB(PG8_SB(1, 0), b3); PG8_STGB(PG8_SB(1, 1), b3 + hstepB); PG8_STGA(PG8_SA(1, 0), a3, voA, 0);
            PG8_WAIT_V(8); PG8_WAIT_L(0); PG8_BAR; PG8_MMA(1, 0, At, B0); PG8_MMA(1, 1, At, B1); PG8_BAR; PG8_SCHED;
        }
        if constexpr (ALIGN_EPI) { if (wr == 0) PG8_BAR; }
        E(acc, cur, wr, wc, fr, fq);
        if (!has_next) break;
#pragma unroll
        for (int a = 0; a < 2; ++a)
#pragma unroll
            for (int b = 0; b < 2; ++b)
#pragma unroll
                for (int m = 0; m < 4; ++m)
#pragma unroll
                    for (int n = 0; n < 2; ++n) acc[a][b][m][n] = (f32x4){0.f, 0.f, 0.f, 0.f};
        cur = nxt; cA = nA; cB = nB; ++ui;
        if constexpr (ALIGN_EPI) { if (wr == 1) PG8_BAR; }
    }
    PG8_WAIT_V(0);
    if constexpr (!ALIGN_EPI) { if (wr == 0) PG8_BAR; }
    PG8_BAR;
#undef PG8_SA
#undef PG8_SB
#undef PG8_STGA
#undef PG8_STGB
#undef PG8_LDA
#undef PG8_LDB
#undef PG8_MMA
#undef PG8_CAT8
#undef PG8_WAIT_V
#undef PG8_WAIT_L
#undef PG8_BAR
#undef PG8_SCHED
}

__device__ __forceinline__ float expc(float x) { return __expf(fminf(x, 80.f)); }
template <int N> __device__ __forceinline__ float row_shr(float x) { return __builtin_bit_cast(float, __builtin_amdgcn_update_dpp(0, __builtin_bit_cast(int, x), 0x110 + N, 0xF, 0xF, true)); }
__device__ __forceinline__ float row_last(float x) { return __builtin_bit_cast(float, __builtin_amdgcn_update_dpp(0, __builtin_bit_cast(int, x), 0x15F, 0xF, 0xF, false)); }
__device__ __forceinline__ float scan16d(float x) { x += row_shr<1>(x); x += row_shr<2>(x); x += row_shr<4>(x); x += row_shr<8>(x); return x; }
__device__ __forceinline__ float exp2c(float x) { return __builtin_amdgcn_exp2f(fminf(x, 115.f)); }

struct EpiZ {
    static constexpr int MIDK = 0;
    unsigned char* ws; int layer;
    const float *qg, *kg;
    __device__ __forceinline__ void operator()(const f32x4 (&acc)[2][2][4][2], const Unit& u, int wr, int wc, int fr_, int fq_) const {
        int fr = fr_, fq = fq_; asm volatile("" : "+v"(fr), "+v"(fq));
        bf16* const QF = (bf16*)(ws + Z_QF); bf16* const KF = (bf16*)(ws + Z_KF); bf16* const QB = (bf16*)(ws + Z_QB); bf16* const KB = (bf16*)(ws + Z_KB); bf16* const VA = (bf16*)(ws + Z_VA);
        bf16* const OG = (bf16*)(ws + Z_OG); bf16* const Y2 = (bf16*)(ws + Z_Y2); bf16* const KG = (bf16*)(ws + Z_KG); bf16* const VG = (bf16*)(ws + Z_VG); bf16* const SG = (bf16*)(ws + Z_SG);
        float* const DEC = (float*)(ws + Z_DEC); const float* const COS = (const float*)(ws + WS_TAB); const float* const SIN = COS + 1024;
        const float* const LBf = COS + 2048 + (0 * 4 + layer) * 512; const float* const LBb = COS + 2048 + (1 * 4 + layer) * 512;
        const int pn = u.pn;
        {
            const int ch0 = 64 * pn + 16 * wc + 4 * fq;
#pragma unroll
            for (int ai = 0; ai < 2; ++ai) { const int cg_ = (u.pm * BM + ai * HALF + wr * 64) >> 6;
                const unsigned rv_ = (unsigned)((((cg_ * 4 + (pn >> 1)) * 2 + (pn & 1)) * 64 + fr) * 64 + 16 * wc + 4 * fq);
#pragma unroll
                for (int m = 0; m < 4; ++m) *(v2u*)(VA + rv_ + m * 16 * 64) = cpk4(acc[ai][1][m][1]); }
            __builtin_amdgcn_sched_barrier(0);
#pragma unroll
            for (int ai = 0; ai < 2; ++ai) {
                const int row0 = u.pm * BM + ai * HALF + wr * 64;
                const int cg = row0 >> 6;
                const int hdA = pn >> 1;
                const unsigned ro0 = (unsigned)(((cg * 4 + hdA) * 64 + fr) * 128 + 64 * (pn & 1) + 16 * wc + 4 * fq);
                const unsigned rv0 = (unsigned)((((cg * 4 + hdA) * 2 + (pn & 1)) * 64 + fr) * 64 + 16 * wc + 4 * fq);
                f32x4 qs[4];
#pragma unroll
                for (int m = 0; m < 4; ++m)
#pragma unroll
                    for (int jj = 0; jj < 4; ++jj) qs[m][jj] = siluf_(acc[ai][0][m][0][jj]) * 0.08838834764831845f;
                {
                    const f32x4 lb = *(const f32x4*)(LBf + ch0);
                    f32x4 pf[4], kf[4]; f32x4 off = (f32x4){0.f, 0.f, 0.f, 0.f}, ref = off;
#pragma unroll
                    for (int m = 0; m < 4; ++m) {
#pragma unroll
                        for (int jj = 0; jj < 4; ++jj) { const float z = acc[ai][0][m][1][jj]; const float e = __builtin_amdgcn_exp2f(-1.4426950408889634f * fabsf(z)); const float r = __builtin_amdgcn_rcpf(1.f + e);
                            const float sp = z >= 0.f ? r : e * r, sm = z >= 0.f ? e * r : r; const float f = lb[jj] + (1.f - lb[jj]) * sp;
                            kf[m][jj] = (1.f - lb[jj]) * sm; const float p = scan16d(__builtin_amdgcn_logf(fmaxf(f, 1e-37f))) + off[jj]; pf[m][jj] = p; off[jj] = row_last(p); }
                        if (m == 1) ref = off;
                    }
                    const f32x4 tot = off;
#pragma unroll
                    for (int m = 0; m < 4; ++m) { f32x4 qo, ko;
#pragma unroll
                        for (int jj = 0; jj < 4; ++jj) { const float q = qs[m][jj]; const float d = pf[m][jj] - ref[jj];
                            qo[jj] = q * exp2c(d); ko[jj] = kf[m][jj] * exp2c(-d); }
                        *(v2u*)(QF + ro0 + m * 16 * 128) = cpk4(qo); *(v2u*)(KF + ro0 + m * 16 * 128) = cpk4(ko); }
                    if (fr == 0) { float* d0 = DEC + ((size_t)(cg * 2 + 0) * 3) * 512 + ch0; f32x4 a, b, c;
#pragma unroll
                        for (int jj = 0; jj < 4; ++jj) { a[jj] = __builtin_amdgcn_exp2f(ref[jj]); b[jj] = __builtin_amdgcn_exp2f(tot[jj]); c[jj] = __builtin_amdgcn_exp2f(tot[jj] - ref[jj]); }
                        *(f32x4*)(d0) = a; *(f32x4*)(d0 + 512) = b; *(f32x4*)(d0 + 1024) = c; }
                }
                __builtin_amdgcn_sched_barrier(0);
                {
                    const f32x4 lb = *(const f32x4*)(LBb + ch0);
                    f32x4 pb[4], kb[4]; f32x4 off = (f32x4){0.f, 0.f, 0.f, 0.f}, half = off;
#pragma unroll
                    for (int m = 0; m < 4; ++m) {
                        if (m == 2) half = off;
#pragma unroll
                        for (int jj = 0; jj < 4; ++jj) { const float z = acc[ai][1][m][0][jj]; const float e = __builtin_amdgcn_exp2f(-1.4426950408889634f * fabsf(z)); const float r = __builtin_amdgcn_rcpf(1.f + e);
                            const float sp = z >= 0.f ? r : e * r, sm = z >= 0.f ? e * r : r; const float f = lb[jj] + (1.f - lb[jj]) * sp;
                            kb[m][jj] = (1.f - lb[jj]) * sm; const float lf = __builtin_amdgcn_logf(fmaxf(f, 1e-37f)); const float p = scan16d(lf) + off[jj]; pb[m][jj] = p - lf; off[jj] = row_last(p); }
                    }
                    const f32x4 tot = off;
                    const f32x4 ref = tot - half;
#pragma unroll
                    for (int m = 0; m < 4; ++m) { f32x4 qo, ko;
#pragma unroll
                        for (int jj = 0; jj < 4; ++jj) { const float q = qs[m][jj]; const float d = (tot[jj] - pb[m][jj]) - ref[jj];
                            qo[jj] = q * exp2c(d); ko[jj] = kb[m][jj] * exp2c(-d); }
                        *(v2u*)(QB + ro0 + m * 16 * 128) = cpk4(qo); *(v2u*)(KB + ro0 + m * 16 * 128) = cpk4(ko); }
                    if (fr == 0) { float* d1 = DEC + ((size_t)(cg * 2 + 1) * 3) * 512 + ch0; f32x4 a, b, c;
#pragma unroll
                        for (int jj = 0; jj < 4; ++jj) { a[jj] = __builtin_amdgcn_exp2f(ref[jj]); b[jj] = __builtin_amdgcn_exp2f(tot[jj]); c[jj] = __builtin_amdgcn_exp2f(tot[jj] - ref[jj]); }
                        *(f32x4*)(d1) = a; *(f32x4*)(d1 + 512) = b; *(f32x4*)(d1 + 1024) = c; }
                }
                __builtin_amdgcn_sched_barrier(0);
            }
        }
    }
    __device__ __forceinline__ void rest(const f32x4 (&acc)[2][2][4][2], const Unit& u, int wr, int wc, int fr_, int fq_) const {
        int fr = fr_, fq = fq_; asm volatile("" : "+v"(fr), "+v"(fq));
        bf16* const OG = (bf16*)(ws + Z_OG); bf16* const Y2 = (bf16*)(ws + Z_Y2); bf16* const KG = (bf16*)(ws + Z_KG); bf16* const VG = (bf16*)(ws + Z_VG);
        const float* const COS = (const float*)(ws + WS_TAB); const float* const SIN = COS + 1024;
        const int pn = u.pn;
        if (pn < 10) {
            const int c0 = (pn - 8) * BM + 32 * wc + 8 * fq;
#pragma unroll
            for (int ai = 0; ai < 2; ++ai)
#pragma unroll
                for (int m = 0; m < 4; ++m) {
                    bf16* rowp = OG + (size_t)(u.pm * BM + ai * HALF + wr * 64 + 16 * m + fr) * 512 + c0;
#pragma unroll
                    for (int bj = 0; bj < 2; ++bj) { f32x4 o[2];
#pragma unroll
                        for (int n = 0; n < 2; ++n) { const f32x4 v = acc[ai][bj][m][n];
#pragma unroll
                            for (int jj = 0; jj < 4; ++jj) o[n][jj] = siluf_(v[jj]); }
                        *(v4u*)(rowp + bj * HALF) = cpk8(o[0], o[1]); }
                }
        } else {
            const bool isq = pn < 12, isv = (!isq) && wc >= 2; const int kvh = wc & 1;
            const float* gv = isq ? qg : kg; const float osc = isq ? QC2 : 1.f;
            f32x4 gg[2][2];
#pragma unroll
            for (int bj = 0; bj < 2; ++bj)
#pragma unroll
                for (int n = 0; n < 2; ++n) gg[bj][n] = *(const f32x4*)(gv + 32 * bj + 16 * n + 4 * fq);
            const bool latent = u.pm < (TL / BM);
#pragma unroll
            for (int ai = 0; ai < 2; ++ai)
#pragma unroll
                for (int m = 0; m < 4; ++m) {
                    const int r = u.pm * BM + ai * HALF + wr * 64 + 16 * m + fr;
                    f32x4 y[2][2];
#pragma unroll
                    for (int bj = 0; bj < 2; ++bj)
#pragma unroll
                        for (int n = 0; n < 2; ++n) y[bj][n] = acc[ai][bj][m][n];
                    bf16* dst;
                    if (isq) dst = Y2 + (size_t)r * 1024 + 512 + 64 * (4 * (pn - 10) + wc) + 4 * fq;
                    else { int b, pos; if (latent) { b = r >> 12; pos = CTXL + (r & 4095); } else { const int rc = r - TL; b = rc >> 8; pos = rc & 255; }
                           dst = (isv ? VG : KG) + ((size_t)b * KVLEN + pos) * 128 + 64 * kvh + 4 * fq; }
                    if (!isv) {
                        float ss = 0.f;
#pragma unroll
                        for (int bj = 0; bj < 2; ++bj)
#pragma unroll
                            for (int n = 0; n < 2; ++n) { const f32x4 v = y[bj][n]; ss += (v[0] * v[0] + v[1] * v[1]) + (v[2] * v[2] + v[3] * v[3]); }
                        ss += shx(ss, 16, fr + 16 * fq); ss += shx(ss, 32, fr + 16 * fq);
                        const float rs = rsqrtf(ss * (1.f / 64.f) + EPSN);
#pragma unroll
                        for (int bj = 0; bj < 2; ++bj)
#pragma unroll
                            for (int n = 0; n < 2; ++n) y[bj][n] = y[bj][n] * rs * gg[bj][n];
                        if (latent) {
                            const int t = r & 4095;
#pragma unroll
                            for (int bj = 0; bj < 2; ++bj) { const int pos = bj ? (t & 63) : (t >> 6);
                                const f32x4 cs = *(const f32x4*)(COS + pos * 16 + 4 * fq), sn = *(const f32x4*)(SIN + pos * 16 + 4 * fq);
                                const f32x4 x1 = y[bj][0], x2 = y[bj][1]; y[bj][0] = x1 * cs - x2 * sn; y[bj][1] = x2 * cs + x1 * sn; }
                        }
                    }
#pragma unroll
                    for (int bj = 0; bj < 2; ++bj)
#pragma unroll
                        for (int n = 0; n < 2; ++n) *(v2u*)(dst + 32 * bj + 16 * n) = cpk4(y[bj][n] * osc);
                }
        }
    }
};
template <bool ADD> struct EpiMerge {
    static constexpr int MIDK = 0;
    bf16* MB; const bf16* SG; int goff;
    __device__ __forceinline__ void operator()(const f32x4 (&acc)[2][2][4][2], const Unit& u, int wr, int wc, int fr_, int fq_) const {
        int fr = fr_, fq = fq_; asm volatile("" : "+v"(fr), "+v"(fq));
#pragma unroll
        for (int ai = 0; ai < 2; ++ai)
#pragma unroll
            for (int m = 0; m < 4; ++m) { const size_t r = (size_t)(u.pm * BM + ai * HALF + wr * 64 + 16 * m + fr); const int c0 = u.pn * BM + 32 * wc + 4 * fq;
#pragma unroll
                for (int bj = 0; bj < 2; ++bj)
#pragma unroll
                    for (int n = 0; n < 2; ++n) { const int c = c0 + bj * HALF + 16 * n;
                        const f32x4 gte = unpk4(*(const v2u*)(SG + r * 2048 + goff + c)); f32x4 o = gte * acc[ai][bj][m][n];
                        if (ADD) o += unpk4(*(const v2u*)(MB + r * 1024 + c));
                        *(v2u*)(MB + r * 1024 + c) = cpk4(o); } }
    }
};
struct EpiGates {
    static constexpr int MIDK = 0;
    unsigned char* SG8;
    static __device__ __forceinline__ unsigned q4(f32x4 v) { unsigned r = 0; r = __builtin_amdgcn_cvt_pk_u8_f32(v[0], 0, r); r = __builtin_amdgcn_cvt_pk_u8_f32(v[1], 1, r); r = __builtin_amdgcn_cvt_pk_u8_f32(v[2], 2, r); r = __builtin_amdgcn_cvt_pk_u8_f32(v[3], 3, r); return r; }
    __device__ __forceinline__ void operator()(const f32x4 (&acc)[2][2][4][2], const Unit& u, int wr, int wc, int fr_, int fq_) const {
        int fr = fr_, fq = fq_; asm volatile("" : "+v"(fr), "+v"(fq));
        const int c0 = u.pn * HALF + 32 * wc + 8 * fq;
#pragma unroll
        for (int ai = 0; ai < 2; ++ai)
#pragma unroll
            for (int m = 0; m < 4; ++m) {
                unsigned char* rowp = SG8 + (size_t)(u.pm * BM + ai * HALF + wr * 64 + 16 * m + fr) * 2048 + c0;
                v2u oa, ob;
#pragma unroll
                for (int n = 0; n < 2; ++n) { const f32x4 za = acc[ai][0][m][n], zb = acc[ai][1][m][n]; f32x4 qa, qb;
#pragma unroll
                    for (int jj = 0; jj < 4; ++jj) {
                        qa[jj] = 255.f * __builtin_amdgcn_rcpf(1.f + __builtin_amdgcn_exp2f(-1.4426950408889634f * za[jj]));
                        qb[jj] = fmaxf(255.f * __builtin_amdgcn_rcpf(1.f + __builtin_amdgcn_exp2f(-1.4426950408889634f * zb[jj])), 1.f); }
                    if (n == 0) { oa.x = q4(qa); ob.x = q4(qb); } else { oa.y = q4(qa); ob.y = q4(qb); } }
                *(v2u*)(rowp) = oa; *(v2u*)(rowp + 1024) = ob;
            }
    }
};
struct EpiF8 {
    static constexpr int MIDK = 0;
    EpiGates g; EpiZ z;
    __device__ __forceinline__ void operator()(const f32x4 (&acc)[2][2][4][2], const Unit& u, int wr, int wc, int fr, int fq) const { if (u.pn < 8) g(acc, u, wr, wc, fr, fq); else z.rest(acc, u, wr, wc, fr, fq); }
};
struct EpiMergeF {
    static constexpr int MIDK = 8;
    bf16* MB; const unsigned char* SG8;
    static __device__ __forceinline__ f32x4 dec4(unsigned w) { return (f32x4){(float)(w & 0xffu), (float)((w >> 8) & 0xffu), (float)((w >> 16) & 0xffu), (float)(w >> 24)}; }
    __device__ __forceinline__ void mid(f32x4 (&acc)[2][2][4][2], const Unit& u, int wr, int wc, int fr_, int fq_) const {
        int fr = fr_, fq = fq_; asm volatile("" : "+v"(fr), "+v"(fq));
        v2u ra[2][4][2], rb[2][4][2];
#pragma unroll
        for (int ai = 0; ai < 2; ++ai)
#pragma unroll
            for (int m = 0; m < 4; ++m) { const size_t r = (size_t)(u.pm * BM + ai * HALF + wr * 64 + 16 * m + fr); const int c0 = u.pn * BM + 32 * wc + 8 * fq;
#pragma unroll
                for (int bj = 0; bj < 2; ++bj) { ra[ai][m][bj] = *(const v2u*)(SG8 + r * 2048 + c0 + bj * HALF); rb[ai][m][bj] = *(const v2u*)(SG8 + r * 2048 + 1024 + c0 + bj * HALF); } }
#pragma unroll
        for (int ai = 0; ai < 2; ++ai) {
#pragma unroll
            for (int m = 0; m < 4; ++m)
#pragma unroll
                for (int bj = 0; bj < 2; ++bj)
#pragma unroll
                    for (int n = 0; n < 2; ++n) { const f32x4 a8 = dec4(n ? ra[ai][m][bj].y : ra[ai][m][bj].x), b8 = dec4(n ? rb[ai][m][bj].y : rb[ai][m][bj].x);
#pragma unroll
                        for (int jj = 0; jj < 4; ++jj) acc[ai][bj][m][n][jj] *= a8[jj] * __builtin_amdgcn_rcpf(b8[jj]); }
            __builtin_amdgcn_sched_barrier(0);
        }
    }
    __device__ __forceinline__ void operator()(const f32x4 (&acc)[2][2][4][2], const Unit& u, int wr, int wc, int fr_, int fq_) const {
        int fr = fr_, fq = fq_; asm volatile("" : "+v"(fr), "+v"(fq));
#pragma unroll
        for (int ai = 0; ai < 2; ++ai)
#pragma unroll
            for (int m = 0; m < 4; ++m) { const size_t r = (size_t)(u.pm * BM + ai * HALF + wr * 64 + 16 * m + fr); const int c0 = u.pn * BM + 32 * wc + 8 * fq;
#pragma unroll
                for (int bj = 0; bj < 2; ++bj) { const int c = c0 + bj * HALF;
                    const v2u zw = *(const v2u*)(SG8 + r * 2048 + 1024 + c);
                    *(v4u*)(MB + r * 1024 + c) = cpk8(dec4(zw.x) * (1.f / 255.f) * acc[ai][bj][m][0], dec4(zw.y) * (1.f / 255.f) * acc[ai][bj][m][1]); } }
    }
};
struct EpiOut {
    static constexpr int MIDK = 0;
    bf16* hw; const bf16* hr; const float* modl;
    const float* sl; const float* sc;
    bool first;
    __device__ __forceinline__ void operator()(const f32x4 (&acc)[2][2][4][2], const Unit& u, int wr, int wc, int fr_, int fq_) const {
        int fr = fr_, fq = fq_; asm volatile("" : "+v"(fr), "+v"(fq));
        const bool latent = u.pm < (TL / BM); const int brow = latent ? (u.pm >> 4) : 16;
        const float* g1 = modl + (size_t)brow * 6144 + 2048;
        const int c0 = u.pn * BM + 32 * wc + 8 * fq;
        const size_t r0 = (size_t)u.pm * BM + wr * 64 + fr;
        if (first) {
            const float* sb_ = latent ? sl + (size_t)u.pm * BM * 1024 : sc + (size_t)(u.pm - TL / BM) * BM * 1024;
#pragma unroll
            for (int ai = 0; ai < 2; ++ai)
#pragma unroll
                for (int m = 0; m < 4; ++m) { const float* rows = sb_ + (size_t)(ai * HALF + wr * 64 + 16 * m + fr) * 1024; bf16* rowp = hw + (r0 + ai * HALF + 16 * m) * 1024;
#pragma unroll
                    for (int bj = 0; bj < 2; ++bj) { const int c = c0 + bj * HALF;
                        const f32x4 h0 = *(const f32x4*)(rows + c) + *(const f32x4*)(g1 + c) * acc[ai][bj][m][0], h1 = *(const f32x4*)(rows + c + 4) + *(const f32x4*)(g1 + c + 4) * acc[ai][bj][m][1];
                        *(v4u*)(rowp + c) = cpk8(h0, h1); } }
        } else {
#pragma unroll
            for (int ai = 0; ai < 2; ++ai)
#pragma unroll
                for (int m = 0; m < 4; ++m) { const size_t ro = (r0 + ai * HALF + 16 * m) * 1024;
#pragma unroll
                    for (int bj = 0; bj < 2; ++bj) { const int c = c0 + bj * HALF; const v4u hv = *(const v4u*)(hr + ro + c);
                        const f32x4 h0 = unlo4(hv) + *(const f32x4*)(g1 + c) * acc[ai][bj][m][0], h1 = unhi4(hv) + *(const f32x4*)(g1 + c + 4) * acc[ai][bj][m][1];
                        *(v4u*)(hw + ro + c) = cpk8(h0, h1); } }
        }
    }
};
struct EpiSwiGLU {
    static constexpr int MIDK = 0;
    unsigned char* H;
    __device__ __forceinline__ void operator()(const f32x4 (&acc)[2][2][4][2], const Unit& u, int wr, int wc, int fr_, int fq_) const {
        int fr = fr_, fq = fq_; asm volatile("" : "+v"(fr), "+v"(fq));
#pragma unroll
        for (int ai = 0; ai < 2; ++ai)
#pragma unroll
            for (int m = 0; m < 4; ++m) { unsigned char* rowp = H + (size_t)(u.pm * BM + ai * HALF + wr * 64 + 16 * m + fr) * 512 + 128 * u.pn + 32 * wc + 8 * fq;
                v2u w8;
#pragma unroll
                for (int n = 0; n < 2; ++n) { const f32x4 gt = acc[ai][0][m][n], up = acc[ai][1][m][n]; f32x4 o;
#pragma unroll
                    for (int jj = 0; jj < 4; ++jj) o[jj] = siluf_(gt[jj]) * up[jj];
                    int r = 0; r = __builtin_amdgcn_cvt_pk_fp8_f32(o[0], o[1], r, false); r = __builtin_amdgcn_cvt_pk_fp8_f32(o[2], o[3], r, true);
                    if (n == 0) w8.x = (unsigned)r; else w8.y = (unsigned)r; }
                *(v2u*)(rowp) = w8; }
    }
};
struct EpiDown {
    static constexpr int MIDK = 0;
    unsigned char* YB; const float* roww;
    __device__ __forceinline__ void operator()(const f32x4 (&acc)[2][2][4][2], const Unit& u, int wr, int wc, int fr_, int fq_) const {
        int fr = fr_, fq = fq_; asm volatile("" : "+v"(fr), "+v"(fq));
#pragma unroll
        for (int ai = 0; ai < 2; ++ai)
#pragma unroll
            for (int m = 0; m < 4; ++m) { const size_t r = (size_t)(u.pm * BM + ai * HALF + wr * 64 + 16 * m + fr); const float w = 16.f;
                unsigned char* rowp = YB + r * 1024 + u.pn * BM + 32 * wc + 8 * fq;
#pragma unroll
                for (int bj = 0; bj < 2; ++bj) { const f32x4 a = acc[ai][bj][m][0] * w, b = acc[ai][bj][m][1] * w; v2u o;
                    int r0 = 0; r0 = __builtin_amdgcn_cvt_pk_fp8_f32(a[0], a[1], r0, false); r0 = __builtin_amdgcn_cvt_pk_fp8_f32(a[2], a[3], r0, true);
                    int r1 = 0; r1 = __builtin_amdgcn_cvt_pk_fp8_f32(b[0], b[1], r1, false); r1 = __builtin_amdgcn_cvt_pk_fp8_f32(b[2], b[3], r1, true);
                    o.x = (unsigned)r0; o.y = (unsigned)r1; *(v2u*)(rowp + bj * HALF) = o; } }
    }
};
}
#include <hip/hip_bf16.h>
#include <cmath>
namespace attn_body {
using bf16=__hip_bfloat16;
using bf16x8=__attribute__((ext_vector_type(8)))short;
using s16x4=__attribute__((ext_vector_type(4)))short;
using f32x16=__attribute__((ext_vector_type(16)))float;
using u32x4=__attribute__((ext_vector_type(4)))unsigned;
constexpr int D=64,QP=1024,KP=128;
constexpr int NW=8,QBLK=32,QB=QBLK*NW,KVBLK=64;
constexpr int ATTN_UNIT_ROWS=QB;
__device__ __forceinline__ int crow(int r,int hi){return (r&3)+8*(r>>2)+4*hi;}
#define SBAR() __builtin_amdgcn_sched_barrier(0)

constexpr int NSLOT=3, SLOTB=8192;
constexpr int LDS_K=0, LDS_V=NSLOT*SLOTB, LDS_WS=2*NSLOT*SLOTB, LDS_OST=LDS_WS+NW*64*4, LDS_BYTES=LDS_OST+NW*4096;
constexpr float C2=0.125f*1.4426950408889634f;
__device__ __forceinline__ void glds16(const void*gsrc,unsigned lds_dst){unsigned keep;
  asm volatile("s_mov_b32 %0, m0\n\ts_mov_b32 m0, %2\n\ts_nop 0\n\tglobal_load_lds_dwordx4 %1, off\n\ts_mov_b32 m0, %0":"=&s"(keep):"v"(gsrc),"s"(lds_dst):"memory");}
__device__ __forceinline__ float max3f(float a,float b,float c){float r;asm("v_max3_f32 %0, %1, %2, %3":"=v"(r):"v"(a),"v"(b),"v"(c));return r;}
__device__ __forceinline__ float max2f(float a,float b){float r;asm("v_max_f32_e32 %0, %1, %2":"=v"(r):"v"(a),"v"(b));return r;}
__device__ __forceinline__ float fadd_s(float a,float b){float r;asm("v_add_f32_e32 %0, %1, %2":"=v"(r):"v"(a),"v"(b));return r;}
__device__ __forceinline__ float fsub_s(float a,float b){float r;asm("v_sub_f32_e32 %0, %1, %2":"=v"(r):"v"(a),"v"(b));return r;}
typedef float f32x2_t __attribute__((ext_vector_type(2))); typedef __bf16 bf16x2_t __attribute__((ext_vector_type(2)));
__device__ __forceinline__ unsigned cvtpk_s(float lo,float hi){f32x2_t v={lo,hi};bf16x2_t b=__builtin_convertvector(v,bf16x2_t);return __builtin_bit_cast(unsigned,b);}
#define WAIT_BAR(N) asm volatile("s_waitcnt vmcnt(" #N ") lgkmcnt(0)\n\ts_barrier":::"memory")

__device__ __forceinline__ void qkt(f32x16&p0,f32x16&p1,const char*Kslot,const bf16x8*qr,const f32x16&negm,int r32,int hi){
  const char*kb=Kslot+hi*1024+r32*16;
  #pragma unroll
  for(int d0=0;d0<4;++d0){
    const bf16x8 b0=*reinterpret_cast<const bf16x8*>(kb+d0*2048);
    const bf16x8 b1=*reinterpret_cast<const bf16x8*>(kb+d0*2048+512);
    if(d0==0){p0=__builtin_amdgcn_mfma_f32_32x32x16_bf16(b0,qr[0],negm,0,0,0);p1=__builtin_amdgcn_mfma_f32_32x32x16_bf16(b1,qr[0],negm,0,0,0);}
    else{p0=__builtin_amdgcn_mfma_f32_32x32x16_bf16(b0,qr[d0],p0,0,0,0);p1=__builtin_amdgcn_mfma_f32_32x32x16_bf16(b1,qr[d0],p1,0,0,0);}}
}
typedef __attribute__((address_space(3))) const char* lds_cptr;
typedef short v4i16_t __attribute__((ext_vector_type(4)));
__device__ __forceinline__ void kload8(bf16x8*kf,lds_cptr kp){
  kf[0]=*(const __attribute__((address_space(3))) bf16x8*)(kp);      kf[1]=*(const __attribute__((address_space(3))) bf16x8*)(kp+512);
  kf[2]=*(const __attribute__((address_space(3))) bf16x8*)(kp+2048); kf[3]=*(const __attribute__((address_space(3))) bf16x8*)(kp+2560);
  kf[4]=*(const __attribute__((address_space(3))) bf16x8*)(kp+4096); kf[5]=*(const __attribute__((address_space(3))) bf16x8*)(kp+4608);
  kf[6]=*(const __attribute__((address_space(3))) bf16x8*)(kp+6144); kf[7]=*(const __attribute__((address_space(3))) bf16x8*)(kp+6656);
}
__device__ __forceinline__ void kload2(bf16x8*kf,lds_cptr kp,int j){ kf[2*j]=*(const __attribute__((address_space(3))) bf16x8*)(kp+j*2048); kf[2*j+1]=*(const __attribute__((address_space(3))) bf16x8*)(kp+j*2048+512); }
__device__ __forceinline__ s16x4 vtr(lds_cptr p){ return __builtin_bit_cast(s16x4,__builtin_amdgcn_ds_read_tr16_b64_v4i16((__attribute__((address_space(3))) v4i16_t*)p)); }
__device__ __forceinline__ float rowmax(const f32x16&p0,const f32x16&p1){
  float a=max3f(p0[0],p0[1],p1[0]),b=max3f(p0[2],p0[3],p1[1]);a=max3f(a,p1[2],p1[3]);
  #pragma unroll
  for(int r=4;r<16;r+=4){a=max3f(a,p0[r],p0[r+1]);b=max3f(b,p0[r+2],p0[r+3]);a=max3f(a,p1[r],p1[r+1]);b=max3f(b,p1[r+2],p1[r+3]);}
  const float m=max2f(a,b);
  auto rr=__builtin_amdgcn_permlane32_swap(__float_as_uint(m),__float_as_uint(m),false,false);
  return max2f(__uint_as_float(rr[0]),__uint_as_float(rr[1]));
}
__device__ __forceinline__ void pv(f32x16*o,int vb,bf16x8 pa0,bf16x8 pa1,bf16x8 pa2,bf16x8 pa3){
  #pragma unroll
  for(int d0=0;d0<2;++d0){s16x4 lo[4],hi[4];
    #pragma unroll
    for(int ks=0;ks<4;++ks){
      asm volatile("ds_read_b64_tr_b16 %0,%1 offset:%c2":"=&v"(lo[ks]):"v"(vb),"i"(d0*4096+ks*1024):"memory");
      asm volatile("ds_read_b64_tr_b16 %0,%1 offset:%c2":"=&v"(hi[ks]):"v"(vb),"i"(d0*4096+ks*1024+512):"memory");}
    asm volatile("s_waitcnt lgkmcnt(0)":::"memory");SBAR();
    #define PK(k) (bf16x8){lo[k][0],lo[k][1],lo[k][2],lo[k][3],hi[k][0],hi[k][1],hi[k][2],hi[k][3]}
    o[d0]=__builtin_amdgcn_mfma_f32_32x32x16_bf16(pa0,PK(0),o[d0],0,0,0);
    o[d0]=__builtin_amdgcn_mfma_f32_32x32x16_bf16(pa1,PK(1),o[d0],0,0,0);
    o[d0]=__builtin_amdgcn_mfma_f32_32x32x16_bf16(pa2,PK(2),o[d0],0,0,0);
    o[d0]=__builtin_amdgcn_mfma_f32_32x32x16_bf16(pa3,PK(3),o[d0],0,0,0);
    #undef PK
  }
}

#ifndef ATTN_STORE16
#define ATTN_STORE16(p,v) (*(u32x4*)(p)=(v))
#endif
template<int THRL,bool NOMAX> __device__ __forceinline__ void attn_unit(const bf16*Qb,const bf16*__restrict__ Kh,const bf16*__restrict__ Vh,bf16*Ob,const int NT,char*shm){
  int tid_=threadIdx.x; asm volatile("":"+v"(tid_));
  const int tid=tid_,lane=tid&63,r32=lane&31,hi=lane>>5; const int wid=__builtin_amdgcn_readfirstlane(tid>>6);
  const bf16*Qw=Qb+(long)(wid*QBLK)*QP;
  const unsigned lds0=(unsigned)(uintptr_t)shm;
  float*wsf=(float*)(shm+LDS_WS)+wid*64;
  const bf16*ksrc=Kh+(long)lane*KP+wid*8;
  const bf16*vsrc=Vh+(long)(16*(wid&3)+(lane>>2))*KP+(wid>>2)*32+(lane&3)*8;
  const unsigned kdst=lds0+LDS_K+wid*1024, vdst=lds0+LDS_V+wid*1024;
  #define DMA_K(t,slot) glds16(ksrc+(long)(t)*KVBLK*KP,(unsigned)__builtin_amdgcn_readfirstlane(kdst+(slot)))
  #define DMA_V(t,slot) glds16(vsrc+(long)(t)*KVBLK*KP,(unsigned)__builtin_amdgcn_readfirstlane(vdst+(slot)))
  const int vb0=(int)(lds0+LDS_V)+((lane>>4)&1)*32+(lane&3)*8+(4*hi+((lane&15)>>2))*64;
  const char*Kbase=shm+LDS_K; bf16x8 kf[8];
  const lds_cptr shm3=(lds_cptr)shm; const lds_cptr kp0=shm3+LDS_K+hi*1024+r32*16; const lds_cptr vp0=shm3+LDS_V+((lane>>4)&1)*32+(lane&3)*8+(4*hi+((lane&15)>>2))*64;
  DMA_K(0,0);DMA_V(0,0);DMA_K(1,SLOTB);
  bf16x8 qr[4];
  #pragma unroll
  for(int d0=0;d0<4;++d0)qr[d0]=*reinterpret_cast<const bf16x8*>(&Qw[(long)r32*QP+d0*16+hi*8]);
  float mhat=0.f,l_reg=0.f;f32x16 o[2];o[0]=f32x16{};o[1]=f32x16{};f32x16 negm=f32x16{};asm volatile("":"+v"(negm));
  #define CMASK(P0,P1,t) do{}while(0)
  bool resc=false;
  #define START(P0,P1) do{ resc=false; \
    if constexpr(!NOMAX){ const float rm=rowmax(P0,P1); const float dl=rm; mhat=fadd_s(mhat,dl); \
      _Pragma("unroll") for(int r=0;r<16;++r){P0[r]=fsub_s(P0[r],dl);P1[r]=fsub_s(P1[r],dl);} \
      _Pragma("unroll") for(int r=0;r<16;++r)negm[r]=-mhat; asm volatile("":"+v"(negm)); } \
    _Pragma("unroll") for(int r=0;r<16;++r)P0[r]=__builtin_amdgcn_exp2f(P0[r]); }while(0)
  #define RESC() do{ if(resc){ asm volatile("s_waitcnt lgkmcnt(0)":::"memory"); \
      _Pragma("unroll") for(int d_=0;d_<2;++d_) _Pragma("unroll") for(int r=0;r<16;++r)o[d_][r]*=wsf[crow(r,hi)]; } }while(0)
  f32x16 pA0,pA1,pB0,pB1;
  int sl_prev=0,sl_cur=0,sl_next=SLOTB;
  #define ROT() do{sl_prev=sl_cur;sl_cur=sl_next;sl_next=(sl_next==(NSLOT-1)*SLOTB)?0:sl_next+SLOTB;}while(0)
  DMA_K(2,2*SLOTB);
  WAIT_BAR(3);
  qkt(pA0,pA1,Kbase,qr,negm,r32,hi);asm volatile("s_nop 15\n\ts_nop 7":"+v"(pA0),"+v"(pA1));CMASK(pA0,pA1,0);
  START(pA0,pA1);
  _Pragma("unroll") for(int r=0;r<16;++r)pA1[r]=__builtin_amdgcn_exp2f(pA1[r]);
  WAIT_BAR(0);
  DMA_K(3,0);DMA_V(1,SLOTB);
  ROT();
  kload8(kf,kp0+sl_cur);
  WAIT_BAR(2);
  s16x4 vlo[8],vhi[8]; u32x4 pw0,pw1,pw2,pw3;
  #define PKW(P,B) cvtpk_s(P[B],P[B+1])
  #define PAF(k) __builtin_bit_cast(bf16x8,pw##k)
  #define VFR(i) (bf16x8){vlo[i][0],vlo[i][1],vlo[i][2],vlo[i][3],vhi[i][0],vhi[i][1],vhi[i][2],vhi[i][3]}
  #define PIN(x) asm volatile("":"+v"(x))
  #define MX3(a,b,c) __builtin_fmaxf(__builtin_fmaxf((a),(b)),(c))
  #define GAPA(MF,A0,A1,A2,A3,W0,W1,PW) do{ MF; sacc+=A0; sacc+=A1; sacc+=A2; sacc+=A3; PIN(sacc); W0; W1; PIN(PW); SBAR(); }while(0)
  #define EX(v) __builtin_amdgcn_exp2f(v)
  #define GAPB(MF,X,B) do{ MF; X[B]=EX(X[B]); X[B+1]=EX(X[B+1]); X[B+2]=EX(X[B+2]); X[B+3]=EX(X[B+3]); PIN(X); SBAR(); }while(0)
  #define VRD(i) do{ vlo[i]=vtr(vp_+(((i)>>2)*4096+((i)&3)*1024)); vhi[i]=vtr(vp_+(((i)>>2)*4096+((i)&3)*1024+512)); }while(0)
  #define KRD(G,j) do{ if(G){ kload2(kf,kp0+sl_next,j); SBAR(); } }while(0)
  #define STEP(C0,C1,P0,P1,t,GK,GV,GL) do{ SBAR(); \
    const lds_cptr vp_=vp0+sl_prev; \
    VRD(0); SBAR(); float sacc=(P0[0]+P0[1]); \
    GAPA(C0=__builtin_amdgcn_mfma_f32_32x32x16_bf16(kf[0],qr[0],negm,0,0,0), P0[2],P0[3],P0[4],P0[5],     pw0[0]=PKW(P0,0), pw0[1]=PKW(P0,2), pw0); \
    VRD(4); SBAR(); GAPA(C1=__builtin_amdgcn_mfma_f32_32x32x16_bf16(kf[1],qr[0],negm,0,0,0), P0[6],P0[7],P0[8],P0[9],     pw0[2]=PKW(P0,4), pw0[3]=PKW(P0,6), pw0); \
    VRD(1); SBAR(); GAPA(C0=__builtin_amdgcn_mfma_f32_32x32x16_bf16(kf[2],qr[1],C0,0,0,0),   P0[10],P0[11],P0[12],P0[13], pw1[0]=PKW(P0,8), pw1[1]=PKW(P0,10), pw1); \
    VRD(5); SBAR(); GAPA(C1=__builtin_amdgcn_mfma_f32_32x32x16_bf16(kf[3],qr[1],C1,0,0,0),   P0[14],P0[15],P1[0],P1[1],   pw1[2]=PKW(P0,12),pw1[3]=PKW(P0,14), pw1); \
    VRD(2); SBAR(); GAPA(C0=__builtin_amdgcn_mfma_f32_32x32x16_bf16(kf[4],qr[2],C0,0,0,0),   P1[2],P1[3],P1[4],P1[5],     pw2[0]=PKW(P1,0), pw2[1]=PKW(P1,2), pw2); \
    VRD(6); SBAR(); GAPA(C1=__builtin_amdgcn_mfma_f32_32x32x16_bf16(kf[5],qr[2],C1,0,0,0),   P1[6],P1[7],P1[8],P1[9],     pw2[2]=PKW(P1,4), pw2[3]=PKW(P1,6), pw2); \
    VRD(3); SBAR(); GAPA(C0=__builtin_amdgcn_mfma_f32_32x32x16_bf16(kf[6],qr[3],C0,0,0,0),   P1[10],P1[11],P1[12],P1[13], pw3[0]=PKW(P1,8), pw3[1]=PKW(P1,10), pw3); \
    VRD(7); SBAR(); GAPA(C1=__builtin_amdgcn_mfma_f32_32x32x16_bf16(kf[7],qr[3],C1,0,0,0),   P1[14],P1[15],0.f,0.f,       pw3[2]=PKW(P1,12),pw3[3]=PKW(P1,14), pw3); \
    l_reg+=sacc; \
    if(GK){DMA_K((t)+3,sl_cur);} if(GV){DMA_V((t)+1,sl_next);} \
    CMASK(C0,C1,t); \
    resc=false; \
    if constexpr(!NOMAX){ float a=MX3(C0[0],C0[1],C1[0]),b=MX3(C0[2],C0[3],C1[1]); a=MX3(a,C1[2],C1[3]); \
      _Pragma("unroll") for(int r=4;r<16;r+=4){a=MX3(a,C0[r],C0[r+1]);b=MX3(b,C0[r+2],C0[r+3]);a=MX3(a,C1[r],C1[r+1]);b=MX3(b,C1[r+2],C1[r+3]);} \
      float rm=__builtin_fmaxf(a,b); { auto rr=__builtin_amdgcn_permlane32_swap(__float_as_uint(rm),__float_as_uint(rm),false,false); rm=__builtin_fmaxf(__uint_as_float(rr[0]),__uint_as_float(rr[1])); } \
      if(__builtin_expect(__any(rm>(float)THRL),0)){ const float dl=__builtin_fmaxf(rm,0.f); mhat+=dl; \
        _Pragma("unroll") for(int r=0;r<16;++r){C0[r]-=dl;C1[r]-=dl;} \
        _Pragma("unroll") for(int r=0;r<16;++r)negm[r]=-mhat; asm volatile("":"+v"(negm)); \
        const float f=__builtin_amdgcn_exp2f(-dl); l_reg*=f; if(hi==0)wsf[r32]=f; resc=true; } } \
    SBAR(); \
    GAPB(o[0]=__builtin_amdgcn_mfma_f32_32x32x16_bf16(PAF(0),VFR(0),o[0],0,0,0), C0,0); \
    GAPB(o[1]=__builtin_amdgcn_mfma_f32_32x32x16_bf16(PAF(0),VFR(4),o[1],0,0,0), C0,4); \
    KRD(GL,0); GAPB(o[0]=__builtin_amdgcn_mfma_f32_32x32x16_bf16(PAF(1),VFR(1),o[0],0,0,0), C0,8); \
    KRD(GL,1); GAPB(o[1]=__builtin_amdgcn_mfma_f32_32x32x16_bf16(PAF(1),VFR(5),o[1],0,0,0), C0,12); \
    KRD(GL,2); GAPB(o[0]=__builtin_amdgcn_mfma_f32_32x32x16_bf16(PAF(2),VFR(2),o[0],0,0,0), C1,0); \
    KRD(GL,3); GAPB(o[1]=__builtin_amdgcn_mfma_f32_32x32x16_bf16(PAF(2),VFR(6),o[1],0,0,0), C1,4); \
    GAPB(o[0]=__builtin_amdgcn_mfma_f32_32x32x16_bf16(PAF(3),VFR(3),o[0],0,0,0), C1,8); \
    GAPB(o[1]=__builtin_amdgcn_mfma_f32_32x32x16_bf16(PAF(3),VFR(7),o[1],0,0,0), C1,12); \
    }while(0)
  int t=1;
  #undef CMASK
  #define CMASK(P0,P1,t) do{}while(0)
  for(;t+5<NT;t+=2){
    STEP(pB0,pB1,pA0,pA1,t,true,true,true);     WAIT_BAR(2); RESC(); ROT();
    STEP(pA0,pA1,pB0,pB1,t+1,true,true,true);   WAIT_BAR(2); RESC(); ROT();
  }
  #undef CMASK
  #define CMASK(P0,P1,t) do{}while(0)
  #define ENDW(tt) do{ if((tt)+3<NT){WAIT_BAR(2);} else if((tt)+2<NT){WAIT_BAR(1);} else {WAIT_BAR(0);} }while(0)
  for(;t+1<NT;t+=2){
    STEP(pB0,pB1,pA0,pA1,t,(t+3<NT),(t+1<NT),(t+1<NT));       ENDW(t);   RESC(); ROT();
    STEP(pA0,pA1,pB0,pB1,t+1,(t+4<NT),(t+2<NT),(t+2<NT));     ENDW(t+1); RESC(); ROT();
  }
  STEP(pB0,pB1,pA0,pA1,NT-1,false,false,false); RESC();
  { float sacc=pB0[0]+pB0[1]; _Pragma("unroll") for(int r=2;r<16;++r)sacc+=pB0[r]; _Pragma("unroll") for(int r=0;r<16;++r)sacc+=pB1[r]; l_reg+=sacc;
    pw0=(u32x4){PKW(pB0,0),PKW(pB0,2),PKW(pB0,4),PKW(pB0,6)};pw1=(u32x4){PKW(pB0,8),PKW(pB0,10),PKW(pB0,12),PKW(pB0,14)};pw2=(u32x4){PKW(pB1,0),PKW(pB1,2),PKW(pB1,4),PKW(pB1,6)};pw3=(u32x4){PKW(pB1,8),PKW(pB1,10),PKW(pB1,12),PKW(pB1,14)};
    SBAR(); pv(o,vb0+sl_cur,PAF(0),PAF(1),PAF(2),PAF(3)); }
  #undef PKW
  #undef PAF
  #undef VFR
  #undef PIN
  #undef MX3
  #undef GAPA
  #undef GAPB
  #undef EX
  #undef VRD
  #undef KRD
  #undef STEP
  #undef ENDW
  {auto rr=__builtin_amdgcn_permlane32_swap(__float_as_uint(l_reg),__float_as_uint(l_reg),false,false);l_reg=__uint_as_float(rr[0])+__uint_as_float(rr[1]);}
  if(hi==0)wsf[32+r32]=l_reg;asm volatile("s_waitcnt lgkmcnt(0)":::"memory");
  float rli[16];
  #pragma unroll
  for(int r=0;r<16;++r)rli[r]=__builtin_amdgcn_rcpf(wsf[32+crow(r,hi)]);
  bf16*Ow=Ob+(long)(wid*QBLK)*QP;
  { bf16*stg=(bf16*)(shm+LDS_OST)+wid*2048;
    #pragma unroll
    for(int r=0;r<16;++r){const int orow=crow(r,hi);
      #pragma unroll
      for(int d0=0;d0<2;++d0)stg[orow*64+d0*32+r32]=__float2bfloat16(o[d0][r]*rli[r]);}
    asm volatile("s_waitcnt lgkmcnt(0)":::"memory");
    #pragma unroll
    for(int i=0;i<4;++i){const int row=i*8+(lane>>3),ch=lane&7; const u32x4 v=*(const u32x4*)(stg+row*64+ch*8); ATTN_STORE16(Ow+(long)row*QP+ch*8,v);} }
  asm volatile("s_waitcnt lgkmcnt(0)\n\ts_barrier":::"memory");
  #undef DMA_K
  #undef DMA_V
  #undef CMASK
  #undef START
  #undef RESC
  #undef ROT
}
constexpr int ATTN_LDS_BYTES=LDS_BYTES;
#undef SBAR
#undef WAIT_BAR
}
#define XB_TMO      128
#define XB_XCNT(j)  (256  + 64 * (j))
#define XB_XSUB(j)  (1280 + 64 * (j))
#define XB_XGEN(j)  (2304 + 64 * (j))
#define XB_TOP      3328
#define XB_TOPGEN   3392
#define XCD_BAR_WORDS 3456
#define XB_SPIN_CAP (1u << 18)

__device__ __forceinline__ unsigned xb_ld(unsigned* p)              { return __hip_atomic_load(p, __ATOMIC_RELAXED, __HIP_MEMORY_SCOPE_AGENT); }
__device__ __forceinline__ unsigned xb_add(unsigned* p, unsigned v) { return __hip_atomic_fetch_add(p, v, __ATOMIC_RELAXED, __HIP_MEMORY_SCOPE_AGENT); }
__device__ __forceinline__ unsigned xb_xcc_id() { return (unsigned)__builtin_amdgcn_s_getreg((3 << 11) | 20) & 0xFu; }
#define XB_SPIN(cond, bar) do { unsigned _sp = 0; while (cond) { __builtin_amdgcn_s_sleep(1); \
    if ((++_sp & 255u) == 0u) { if (xb_ld(&(bar)[XB_TMO])) break; if (_sp > XB_SPIN_CAP) { atomicAdd(&(bar)[XB_TMO], 1u); break; } } } } while (0)

struct XcdBarrier {
    unsigned* bar; unsigned x;
    volatile LAS unsigned* st;
};

__device__ __forceinline__ XcdBarrier xcd_barrier_post(unsigned* bar, volatile LAS unsigned* st) {
    XcdBarrier b; b.bar = bar; b.x = xb_xcc_id(); b.st = st;
    if (threadIdx.x == 0) (void)xb_add(&bar[XB_XCNT(b.x)], 1u);
    return b;
}
__device__ __forceinline__ void xcd_barrier_complete(unsigned* bar, unsigned x, unsigned& nloc, unsigned& nx) {
    const unsigned G = gridDim.x * gridDim.y * gridDim.z;
    unsigned sum, cnt, mine, sp = 0u;
    for (;;) {
        sum = 0u; cnt = 0u; mine = 0u;
#pragma unroll
        for (unsigned j = 0; j < 16; ++j) { const unsigned c = xb_ld(&bar[XB_XCNT(j)]); sum += c; cnt += (c > 0u) ? 1u : 0u; mine = (j == x) ? c : mine; }
        if (sum == G) break;
        __builtin_amdgcn_s_sleep(1);
        if ((++sp & 255u) == 0u) { if (xb_ld(&bar[XB_TMO])) break; if (sp > XB_SPIN_CAP) { atomicAdd(&bar[XB_TMO], 1u); break; } }
    }
    nloc = mine > 0u ? mine : 1u; nx = cnt > 0u ? cnt : 1u;
}

__device__ __forceinline__ void xcd_barrier(const XcdBarrier& b) {
    asm volatile("s_waitcnt vmcnt(0)" ::: "memory");
    __syncthreads();
    if (threadIdx.x == 0) {
        unsigned* bar = b.bar;
        __builtin_amdgcn_s_waitcnt(0);
        unsigned nloc = b.st[0], nx = b.st[1];
        if (nloc == 0u) { xcd_barrier_complete(bar, b.x, nloc, nx); b.st[0] = nloc; b.st[1] = nx; }
        const unsigned old = xb_add(&bar[XB_XSUB(b.x)], 1u);
        const unsigned gen = old / nloc;
        if (old + 1u == (gen + 1u) * nloc) {
            __builtin_amdgcn_fence(__ATOMIC_RELEASE, "agent");
            asm volatile("s_waitcnt vmcnt(0)" ::: "memory");
            const unsigned og = xb_add(&bar[XB_TOP], 1u);
            const unsigned tg = og / nx;
            if (og + 1u == (tg + 1u) * nx) xb_add(&bar[XB_TOPGEN], 1u);
            else XB_SPIN(xb_ld(&bar[XB_TOPGEN]) == tg, bar);
            __builtin_amdgcn_fence(__ATOMIC_ACQUIRE, "agent");
            xb_add(&bar[XB_XGEN(b.x)], 1u);
            asm volatile("s_waitcnt vmcnt(0)" ::: "memory");
        } else {
            XB_SPIN(xb_ld(&bar[XB_XGEN(b.x)]) == gen, bar);
            __builtin_amdgcn_fence(__ATOMIC_ACQUIRE, "agent");
            asm volatile("s_waitcnt vmcnt(0)" ::: "memory");
        }
    }
    __syncthreads();
}


struct Frame {
    LAS unsigned char* lds;
    volatile LAS unsigned* MISC;
    gu32* ctl;
    int tid, lane, wave, G, bx;
    float* out; unsigned char* ws;
};
__device__ __forceinline__ const float* inptr(const Frame& F, int i) {
    const LAS unsigned* t = (const LAS unsigned*)(F.lds + PTRS_OFF) + 2 * i;
    const unsigned lo = __builtin_amdgcn_readfirstlane(t[0]), hi = __builtin_amdgcn_readfirstlane(t[1]);
    return (const float*)(((unsigned long long)hi << 32) | lo);
}
#define INP(i) inptr(F, (i))
#define PHASE_FRAME(F0) Frame F = (F0); { int t_ = F.tid; asm volatile("" : "+v"(t_)); F.tid = t_; F.lane = t_ & 63; F.wave = __builtin_amdgcn_readfirstlane(t_ >> 6); }
enum { I_X = 0, I_C, I_CTX, I_CCTX, I_WADA, I_BADA, I_N1G, I_N2G, I_WIN, I_LBL, I_HNG, I_QNG, I_KNG, I_WUA, I_WUB, I_WOUT, I_WRG, I_BRG, I_WRE, I_BRE, I_WG, I_WU, I_WD, I_FNG };

template <class RowMap> __device__ __forceinline__ void transpose_item(const float* W, int N, bf16* WT, int ldk, int koff, LAS float* scr, int kb, int nb, int lane, RowMap rm) {
    const int k0 = 64 * kb, n0 = 32 * nb;
    float tv[32];
#pragma unroll
    for (int i = 0; i < 32; ++i) tv[i] = W[(size_t)(k0 + 2 * i + (lane >> 5)) * N + n0 + (lane & 31)];
#pragma unroll
    for (int i = 0; i < 32; ++i) scr[(2 * i + (lane >> 5)) * 33 + (lane & 31)] = tv[i];
    LDS_WAIT(); asm volatile("" ::: "memory");
    const int c = lane & 7;
#pragma unroll
    for (int j = 0; j < 4; ++j) { const int n = (lane >> 3) + 8 * j; const LAS float* s = scr + (8 * c) * 33 + n;
        v4u o; o.x = pk2(s[0 * 33], s[1 * 33]); o.y = pk2(s[2 * 33], s[3 * 33]); o.z = pk2(s[4 * 33], s[5 * 33]); o.w = pk2(s[6 * 33], s[7 * 33]);
        *(GAS v4u*)(WT + (size_t)rm(n0 + n) * ldk + koff + k0 + 8 * c) = o; }
    LDS_WAIT(); asm volatile("" ::: "memory");
}
__device__ __forceinline__ unsigned pk4_f8(float a, float b, float c, float d) { int r = 0; r = __builtin_amdgcn_cvt_pk_fp8_f32(a, b, r, false); r = __builtin_amdgcn_cvt_pk_fp8_f32(c, d, r, true); return (unsigned)r; }
template <class RowMap> __device__ __forceinline__ void transpose_item_f8(const float* W, int N, unsigned char* WT8, int ldk, int koff, LAS float* scr, int kb, int nb, int lane, RowMap rm, float mul) {
    const int k0 = 64 * kb, n0 = 32 * nb;
    float tv[32];
#pragma unroll
    for (int i = 0; i < 32; ++i) tv[i] = W[(size_t)(k0 + 2 * i + (lane >> 5)) * N + n0 + (lane & 31)];
#pragma unroll
    for (int i = 0; i < 32; ++i) scr[(2 * i + (lane >> 5)) * 33 + (lane & 31)] = tv[i] * mul;
    LDS_WAIT(); asm volatile("" ::: "memory");
    const int c = lane & 7;
#pragma unroll
    for (int j = 0; j < 4; ++j) { const int n = (lane >> 3) + 8 * j; const LAS float* s = scr + (8 * c) * 33 + n;
        v2u o; o.x = pk4_f8(s[0 * 33], s[1 * 33], s[2 * 33], s[3 * 33]); o.y = pk4_f8(s[4 * 33], s[5 * 33], s[6 * 33], s[7 * 33]);
        *(GAS v2u*)(WT8 + (size_t)rm(n0 + n) * ldk + koff + k0 + 8 * c) = o; }
    LDS_WAIT(); asm volatile("" ::: "memory");
}
__device__ __forceinline__ int pperm(int c) { return (c & ~31) | (((c >> 2) & 1) << 4) | (((c >> 3) & 3) << 2) | (c & 3); }
struct RmId { __device__ __forceinline__ int operator()(int n) const { return n; } };
struct RmPerm { __device__ __forceinline__ int operator()(int n) const { return pperm(n); } };
struct RmGate { int up; __device__ __forceinline__ int operator()(int n) const { return 256 * (n >> 7) + 128 * up + pperm(n & 127); } };
struct RmWin { __device__ __forceinline__ int operator()(int n) const {
    if (n < 2048) { const int s = n >> 9, ch = n & 511, tile = ch >> 6, cw = ch & 63; return tile * 256 + 128 * (s >> 1) + 32 * (cw >> 4) + 16 * (s & 1) + (cw & 15); }
    if (n < 2560) return pperm(n);
    if (n < 3072) { const int hq = (n - 2560) >> 6, d = n & 63; return 2560 + (hq >> 2) * 256 + 128 * (d >> 5) + 32 * (hq & 3) + 16 * ((d >> 4) & 1) + (d & 15); }
    if (n < 3328) { const int hh = (n - 3072) >> 6, d = n & 63; return 3072 + 128 * (d >> 5) + 32 * hh + 16 * ((d >> 4) & 1) + (d & 15); }
    { const int q = n - 3328, gb = q >> 10, col = q & 1023; return 3328 + 256 * (col >> 7) + 128 * gb + pperm(col & 127); } } };
#define WSP(T, off) ((T*)(F.ws + (off)))

__device__ __forceinline__ void p0_prologue(const Frame& F0) {
    PHASE_FRAME(F0);
    LAS float* cact = (LAS float*)(F.lds);
    LAS float* red = (LAS float*)(F.lds + 69632);
    float* MOD = WSP(float, WS_MOD);
    for (int i = F.tid; i < 17 * 1024; i += NWAVES * 64) { const int r = i >> 10, k = i & 1023; const float v = r < 16 ? INP(I_C)[r * 1024 + k] : INP(I_CCTX)[k]; cact[i] = siluf_(v); }
    __syncthreads();
    for (int it = F.bx; it < 4 * 96; it += F.G) {
        const int l = it / 96, cgp = it % 96, col = cgp * 64 + F.lane;
        const float* w = INP(I_WADA) + (size_t)l * 1024 * 6144 + col;
        float acc[17];
#pragma unroll
        for (int r = 0; r < 17; ++r) acc[r] = 0.f;
        const int k0 = F.wave * 128;
#pragma unroll 4
        for (int k = k0; k < k0 + 128; ++k) { const float wv = w[(size_t)k * 6144];
#pragma unroll
            for (int r = 0; r < 17; ++r) acc[r] += cact[r * 1024 + k] * wv; }
#pragma unroll
        for (int r = 0; r < 17; ++r) red[(F.wave * 17 + r) * 64 + F.lane] = acc[r];
        __syncthreads();
        for (int i = F.tid; i < 17 * 64; i += NWAVES * 64) { const int r = i >> 6, ln = i & 63; float s = 0.f;
#pragma unroll
            for (int w8 = 0; w8 < 8; ++w8) s += red[(w8 * 17 + r) * 64 + ln];
            MOD[((size_t)l * 17 + r) * 6144 + cgp * 64 + ln] = s + INP(I_BADA)[l * 6144 + cgp * 64 + ln]; }
        __syncthreads();
    }
    { int* ident = (int*)(F.ws + WS_TAB + 65536); for (int i = F.bx * (NWAVES * 64) + F.tid; i < RCAP; i += F.G * NWAVES * 64) ident[i] = i; }
    if (F.bx == F.G - 1) {
        float* COS = WSP(float, WS_TAB); float* SIN = COS + 1024; float* LB = WSP(float, WS_TAB + 8192);
        for (int i = F.tid; i < 1024; i += NWAVES * 64) { const int pos = i >> 4, fi = i & 15;
            const float inv = (float)pow(10000.0, -(double)fi / 16.0); const float ang = (float)pos * inv;
            COS[i] = (float)cos((double)ang); SIN[i] = (float)sin((double)ang); }
        for (int i = F.tid; i < 1024; i += NWAVES * 64) { const int dir = i >> 9, ch = i & 511;
            float lg[4], mx = -1e30f;
#pragma unroll
            for (int l = 0; l < 4; ++l) { lg[l] = INP(I_LBL)[(dir * 4 + l) * 512 + ch]; mx = fmaxf(mx, lg[l]); }
            float den = 0.f;
#pragma unroll
            for (int l = 0; l < 4; ++l) { lg[l] = expf(lg[l] - mx); den += lg[l]; }
            float cum = 0.f;
#pragma unroll
            for (int l = 0; l < 4; ++l) { LB[(dir * 4 + l) * 512 + ch] = cum; if (l < 3) cum += lg[l + 1] / den; } }
    }
}

__device__ __forceinline__ void row_pass(const Frame& F0, int l, int mode) {
    PHASE_FRAME(F0);
    const int gw = F.bx * NWAVES + F.wave, NGW = F.G * NWAVES;
    const float* MOD = WSP(float, WS_MOD); bf16* XN = WSP(bf16, WS_XN);
    const bf16* HR = (mode == 2) ? WSP(bf16, Z_SG) : (const bf16*)F.out; bf16* HW = (bf16*)F.out;
    const unsigned char* YB = F.ws + Z_YB; const int* DEST = (const int*)(F.ws + WS_RT + RT_DEST); const float* WTS = (const float*)(F.ws + WS_RT + RT_W);
    const int nrows = (mode == 2) ? TL : TT;
    constexpr int NR = 4;
    int d0n[NR], d1n[NR]; float w0n[NR], w1n[NR];
#define RP_DEST(mb) do { _Pragma("unroll") for (int q = 0; q < NR; ++q) { const int m = (mb) + q * NGW; d0n[q] = 0; d1n[q] = 0; w0n[q] = 0.f; w1n[q] = 0.f; \
        if (m < nrows) { d0n[q] = DEST[2 * m]; d1n[q] = DEST[2 * m + 1]; w0n[q] = 0.0625f * WTS[2 * m]; w1n[q] = 0.0625f * WTS[2 * m + 1]; } } } while (0)
    if (mode != 0) RP_DEST(gw);
    for (int m0 = gw; m0 < nrows; m0 += NR * NGW) {
        int d0[NR], d1[NR]; float w0[NR], w1[NR];
#pragma unroll
        for (int q = 0; q < NR; ++q) { d0[q] = d0n[q]; d1[q] = d1n[q]; w0[q] = w0n[q]; w1[q] = w1n[q]; }
        f32x4 v[NR][4]; unsigned y0[NR][4], y1[NR][4];
#pragma unroll
        for (int q = 0; q < NR; ++q) { const int m = m0 + q * NGW; if (m < nrows) {
            if (mode == 0) { const float* src = (m < TL) ? INP(I_X) + (size_t)m * 1024 : INP(I_CTX) + (size_t)(m - TL) * 1024;
#pragma unroll
                for (int j = 0; j < 4; ++j) v[q][j] = *((const GAS f32x4*)src + F.lane + 64 * j);
            } else {
#pragma unroll
                for (int j = 0; j < 4; ++j) v[q][j] = unpk4(*((const GAS v2u*)(HR + (size_t)m * 1024) + F.lane + 64 * j));
#pragma unroll
                for (int j = 0; j < 4; ++j) { y0[q][j] = *((const GAS unsigned*)(YB + (size_t)d0[q] * 1024) + F.lane + 64 * j); y1[q][j] = *((const GAS unsigned*)(YB + (size_t)d1[q] * 1024) + F.lane + 64 * j); }
            } } }
        if (mode != 0) RP_DEST(m0 + NR * NGW);
#pragma unroll
        for (int q = 0; q < NR; ++q) { const int m = m0 + q * NGW; if (m < nrows) {
            const bool latent = m < TL; const int brow = latent ? (m >> 12) : 16;
            if (mode != 0) {
                const float* g2 = MOD + ((size_t)(l - 1) * 17 + brow) * 6144 + 5120;
#pragma unroll
                for (int j = 0; j < 4; ++j) { const f32x4 gg = *((const GAS f32x4*)g2 + F.lane + 64 * j);
                    const f32x2 a0 = __builtin_amdgcn_cvt_pk_f32_fp8((int)y0[q][j], false), a1 = __builtin_amdgcn_cvt_pk_f32_fp8((int)y0[q][j], true);
                    const f32x2 b0 = __builtin_amdgcn_cvt_pk_f32_fp8((int)y1[q][j], false), b1 = __builtin_amdgcn_cvt_pk_f32_fp8((int)y1[q][j], true);
                    v[q][j] += gg * ((f32x4){a0[0], a0[1], a1[0], a1[1]} * w0[q] + (f32x4){b0[0], b0[1], b1[0], b1[1]} * w1[q]); }
            }
            float ss = 0.f;
#pragma unroll
            for (int j = 0; j < 4; ++j) ss += (v[q][j][0] * v[q][j][0] + v[q][j][1] * v[q][j][1]) + (v[q][j][2] * v[q][j][2] + v[q][j][3] * v[q][j][3]);
            const float rs = rsqrtf(wave_sum(ss, F.lane) * (1.f / 1024.f) + EPSN);
            if (mode == 2) {
#pragma unroll
                for (int j = 0; j < 4; ++j) { const f32x4 g = *((const GAS f32x4*)INP(I_FNG) + F.lane + 64 * j); *((GAS f32x4*)(F.out + (size_t)m * 1024) + F.lane + 64 * j) = v[q][j] * rs * g; }
            } else {
                const float* mod = MOD + ((size_t)l * 17 + brow) * 6144; const float* ng = INP(I_N1G) + l * 1024;
#pragma unroll
                for (int j = 0; j < 4; ++j) {
                    if (mode != 0) *((GAS v2u*)(HW + (size_t)m * 1024) + F.lane + 64 * j) = pk4(v[q][j]);
                    const f32x4 g = *((const GAS f32x4*)ng + F.lane + 64 * j), sh = *((const GAS f32x4*)mod + F.lane + 64 * j), sc = *((const GAS f32x4*)(mod + 1024) + F.lane + 64 * j);
                    const f32x4 y = v[q][j] * rs * g * (sc + 1.f) + sh;
                    *((GAS v2u*)(XN + (size_t)m * 1024) + F.lane + 64 * j) = pk4(y);
                    *((GAS unsigned*)(F.ws + Z_OB + (size_t)m * 1024) + F.lane + 64 * j) = pk4_f8(y[0], y[1], y[2], y[3]); }
            }
        } }
    }
}

__device__ __forceinline__ void convert_items(const Frame& F0, int l, int part, int nparts, int worker, int nworkers) {
    PHASE_FRAME(F0);
    LAS float* scr = (LAS float*)(F.lds + F.wave * 16384);
    unsigned char* W = F.ws + WS_W + (size_t)(l & 1) * W_PSTRIDE; unsigned char* WDN = F.ws + ((l & 1) ? W_DN1 : W_DN0);
    constexpr int N_IN = 16 * 168, N_UA = 8 * 32, N_OUT = 16 * 32, N_G = 32 * 256;
    constexpr int NITEMS = N_IN + 2 * N_UA + N_OUT + 3 * N_G;
    const int it_lo = (int)((long)NITEMS * part / nparts), it_hi = (int)((long)NITEMS * (part + 1) / nparts);
    for (int it = it_lo + worker; it < it_hi; it += nworkers) {
        int r = it;
        if (r < N_IN) { const int nb = r % 168;
            if (nb < 64) transpose_item(INP(I_WIN) + (size_t)l * 1024 * NZ, NZ, (bf16*)(W + W_IN), 1024, 0, scr, r / 168, nb, F.lane, RmWin{});
            else if (nb < 104) transpose_item_f8(INP(I_WIN) + (size_t)l * 1024 * NZ, NZ, W + W_IN8, 1024, 0, scr, r / 168, nb, F.lane, RmWin{}, 32.f);
            else transpose_item_f8(INP(I_WIN) + (size_t)l * 1024 * NZ, NZ, W + W_IN8 - (size_t)3328 * 1024, 1024, 0, scr, r / 168, nb, F.lane, RmWin{}, 32.f);
            continue; } r -= N_IN;
        if (r < N_UA) { transpose_item(INP(I_WUA) + (size_t)l * 512 * 1024, 1024, (bf16*)(W + W_UP), 1024, 0, scr, r / 32, r % 32, F.lane, RmPerm{}); continue; } r -= N_UA;
        if (r < N_UA) { transpose_item(INP(I_WUB) + (size_t)l * 512 * 1024, 1024, (bf16*)(W + W_UP), 1024, 512, scr, r / 32, r % 32, F.lane, RmPerm{}); continue; } r -= N_UA;
        if (r < N_OUT) { transpose_item(INP(I_WOUT) + (size_t)l * 1024 * 1024, 1024, (bf16*)(W + W_OUT), 1024, 0, scr, r / 32, r % 32, F.lane, RmPerm{}); continue; } r -= N_OUT;
        if (r < N_G) { const int e = r >> 8, r2 = r & 255; transpose_item_f8(INP(I_WG) + ((size_t)l * 32 + e) * 1024 * 512, 512, W + W_GU + (size_t)e * 1024 * 1024, 1024, 0, scr, r2 / 16, r2 % 16, F.lane, RmGate{0}, 32.f); continue; } r -= N_G;
        if (r < N_G) { const int e = r >> 8, r2 = r & 255; transpose_item_f8(INP(I_WU) + ((size_t)l * 32 + e) * 1024 * 512, 512, W + W_GU + (size_t)e * 1024 * 1024, 1024, 0, scr, r2 / 16, r2 % 16, F.lane, RmGate{1}, 32.f); continue; } r -= N_G;
        { const int e = r >> 8, r2 = r & 255; transpose_item_f8(INP(I_WD) + ((size_t)l * 32 + e) * 512 * 1024, 1024, WDN + (size_t)e * 1024 * 512, 512, 0, scr, r2 / 32, r2 % 32, F.lane, RmPerm{}, 16.f); }
    }
}

__device__ __forceinline__ void convert_layer(const Frame& F0, int l) {
    PHASE_FRAME(F0);
    const int gw = F.bx * NWAVES + F.wave, NGW = F.G * NWAVES;
    const float* MOD = WSP(float, WS_MOD) + (size_t)l * 17 * 6144; float* WP = WSP(float, WS_WR); float* CV = WSP(float, WS_WR + WR_CVEC);
    const float* wrg = INP(I_WRG) + (size_t)l * 1024 * 4; const float* wre = INP(I_WRE) + (size_t)l * 1024 * 32; const float* n2g = INP(I_N2G) + l * 1024;
    const int gt = F.bx * NWAVES * 64 + F.tid, NGT = F.G * NWAVES * 64;
    for (int i = gt; i < 17 * 1024 * 48; i += NGT) { const int b = i / (1024 * 48), k = (i / 48) & 1023, j = i % 48;
        const float w = j < 4 ? wrg[k * 4 + j] : (j < 36 ? wre[k * 32 + (j - 4)] : 0.f);
        const float wp = n2g[k] * (1.f + MOD[(size_t)b * 6144 + 4096 + k]) * w; WP[i] = wp;
        const unsigned hi = f2bf(wp); const unsigned lo = f2bf(wp - bf2f((unsigned short)hi));
        bf16* q_ = WSP(bf16, WS_HC) + (size_t)b * 98304 + (k >> 5) * 3072 + ((k >> 3) & 3) * 768 + (j >> 4) * 128 + (j & 15) * 8 + (k & 7);
        q_[0] = (bf16)hi; q_[384] = (bf16)lo; }
    for (int it = gw; it < 17 * 48; it += NGW) { const int b = it / 48, j = it % 48; float s = 0.f;
        if (j < 36) { for (int k = F.lane; k < 1024; k += 64) { const float w = j < 4 ? wrg[k * 4 + j] : wre[k * 32 + (j - 4)]; s += MOD[(size_t)b * 6144 + 3072 + k] * w; }
            s = wave_sum(s, F.lane) + (j < 4 ? INP(I_BRG)[l * 4 + j] : INP(I_BRE)[l * 32 + (j - 4)]); }
        if (F.lane == 0) CV[it] = s; }
}

__device__ __forceinline__ void p3_scan(const Frame& F0) {
    PHASE_FRAME(F0);
    constexpr int PQ = 272, PT = 144;
    constexpr int O_Q = 0, O_V = O_Q + 2 * 64 * PQ, O_K = O_V + 2 * 64 * PT, O_A = O_K + 64 * PQ, O_ST = O_A + 64 * PT, O_DEC = O_ST + 64 * PQ;
    static_assert(O_DEC + 1536 <= RING_BYTES, "scan LDS");
    typedef short v4i16_t __attribute__((ext_vector_type(4)));
    LAS unsigned char* L = F.lds;
    const int tid = F.tid, lane = F.lane, wave = F.wave, fr = lane & 15, fq = lane >> 4;
    const float* DEC = WSP(float, Z_DEC);
    for (int u0 = F.bx; u0 < 256; u0 += F.G) {
        const int unit = (u0 & ~15) | ((u0 & 7) << 1) | ((u0 >> 3) & 1);
        const int dvh = unit & 1, dir = (unit >> 1) & 1, hd = (unit >> 2) & 3, b = unit >> 4;
        const bf16* Qp = dir ? WSP(bf16, Z_QB) : WSP(bf16, Z_QF); const bf16* Kp = dir ? WSP(bf16, Z_KB) : WSP(bf16, Z_KF); const bf16* Vp = WSP(bf16, Z_VA);
        bf16* Op = dir ? WSP(bf16, Z_OB) + hd * 128 + dvh * 64 : WSP(bf16, Z_Y2) + hd * 128 + dvh * 64; const int opitch = dir ? 512 : 1024;
        f32x4 S[4];
#pragma unroll
        for (int vt = 0; vt < 4; ++vt) S[vt] = (f32x4){0.f, 0.f, 0.f, 0.f};
        int prow[2], pc16[2];
#pragma unroll
        for (int i = 0; i < 2; ++i) { const int p = tid + 512 * i; prow[i] = p >> 4; pc16[i] = p & 15; }
        const int vrow = tid >> 3, vc8 = tid & 7;
        v4u gq[2][2], gk[2][2], gv[2]; f32x4 gdec[2];
        gdec[0] = (f32x4){0.f, 0.f, 0.f, 0.f}; gdec[1] = gdec[0];
#define SCAN_CG(s) ((s) < 4 ? (1024 + 4 * b + (dir ? 3 - (s) : (s))) : (64 * b + (dir ? 67 - (s) : (s) - 4)))
#define SCAN_LOAD(s, R) do { const int cg_ = SCAN_CG(s); const size_t r0_ = (size_t)cg_ * 64; \
        const size_t tq_ = ((size_t)cg_ * 4 + hd) * 64 * 128; (void)r0_; \
        _Pragma("unroll") for (int i = 0; i < 2; ++i) { gq[R][i] = *(const GAS v4u*)(Qp + tq_ + prow[i] * 128 + 8 * pc16[i]); gk[R][i] = *(const GAS v4u*)(Kp + tq_ + prow[i] * 128 + 8 * pc16[i]); } \
        gv[R] = *(const GAS v4u*)(Vp + (((size_t)cg_ * 4 + hd) * 2 + dvh) * 64 * 64 + vrow * 64 + 8 * vc8); \
        if (tid < 96) gdec[R] = *(const GAS f32x4*)(DEC + ((size_t)(cg_ * 2 + dir) * 3 + (tid >> 5)) * 512 + hd * 128 + 4 * (tid & 31)); } while (0)
#define SCAN_BAR() asm volatile("s_waitcnt lgkmcnt(0)\n\ts_barrier" ::: "memory")
#define SCAN_TRF(dst, base, pitch, c0, kk) do { const LAS unsigned char* p_ = (base) + (32 * (kk) + 8 * fq + ((lane & 15) >> 2)) * (pitch) + 2 * ((c0) + 4 * (lane & 3)); \
            const v4i16_t r0_ = __builtin_amdgcn_ds_read_tr16_b64_v4i16((LAS v4i16_t*)p_), r1_ = __builtin_amdgcn_ds_read_tr16_b64_v4i16((LAS v4i16_t*)(p_ + 4 * (pitch))); \
            dst = (bf16x8){r0_[0], r0_[1], r0_[2], r0_[3], r1_[0], r1_[1], r1_[2], r1_[3]}; } while (0)
#define SCAN_STEP(s, R) do { \
            const int cg = SCAN_CG(s); const int oq = O_Q + (R) * 64 * PQ, ov = O_V + (R) * 64 * PT; \
            _Pragma("unroll") for (int i = 0; i < 2; ++i) { \
                *(LAS v4u*)(L + oq + prow[i] * PQ + 16 * pc16[i]) = gq[R][i]; \
                *(LAS v4u*)(L + O_K + prow[i] * PQ + 16 * pc16[i]) = gk[R][i]; } \
            *(LAS v4u*)(L + ov + vrow * PT + 16 * vc8) = gv[R]; \
            if (tid < 96) *(LAS f32x4*)(L + O_DEC + (tid >> 5) * 512 + 16 * (tid & 31)) = gdec[R]; \
            SCAN_BAR(); \
            if ((s) + 2 < 68) SCAN_LOAD((s) + 2, R); \
            { const f32x4 dm4 = *(const LAS f32x4*)(L + O_DEC + 4 * (16 * wave + 4 * fq)); \
              _Pragma("unroll") for (int vt = 0; vt < 4; ++vt) *(LAS v2u*)(L + O_ST + (16 * vt + fr) * PQ + 2 * (16 * wave + 4 * fq)) = pk4(S[vt] * dm4); } \
            bf16x8 bqk[2][4], va[2];                        \
            { const int st_ = wave >> 1; bf16x8 af[4]; \
              _Pragma("unroll") for (int kk = 0; kk < 4; ++kk) af[kk] = *(const LAS bf16x8*)(L + O_K + (16 * st_ + fr) * PQ + 2 * (32 * kk + 8 * fq)); \
              _Pragma("unroll") for (int tl = 0; tl < 2; ++tl) _Pragma("unroll") for (int kk = 0; kk < 4; ++kk) bqk[tl][kk] = *(const LAS bf16x8*)(L + oq + (16 * (2 * (wave & 1) + tl) + fr) * PQ + 2 * (32 * kk + 8 * fq)); \
              _Pragma("unroll") for (int tl = 0; tl < 2; ++tl) { const int tt = 2 * (wave & 1) + tl; const int tq = 16 * tt + fr; f32x4 o = (f32x4){0.f, 0.f, 0.f, 0.f}; \
                  const bool dead = dir ? (st_ < tt) : (st_ > tt); \
                  if (!dead) { f32x4 a = (f32x4){0.f, 0.f, 0.f, 0.f}; \
                      _Pragma("unroll") for (int kk = 0; kk < 4; ++kk) a = __builtin_amdgcn_mfma_f32_16x16x32_bf16(af[kk], bqk[tl][kk], a, 0, 0, 0); \
                      _Pragma("unroll") for (int rg = 0; rg < 4; ++rg) { const int sk = 16 * st_ + 4 * fq + rg; const bool keep = dir ? (sk >= tq) : (sk <= tq); o[rg] = keep ? a[rg] : 0.f; } } \
                  *(LAS v2u*)(L + O_A + tq * PT + 2 * (16 * st_ + 4 * fq)) = pk4(o); } } \
            { const f32x4 dl4 = *(const LAS f32x4*)(L + O_DEC + 512 + 4 * (16 * wave + 4 * fq)), dlm4 = *(const LAS f32x4*)(L + O_DEC + 1024 + 4 * (16 * wave + 4 * fq)); \
              bf16x8 af[2]; \
              _Pragma("unroll") for (int kk = 0; kk < 2; ++kk) SCAN_TRF(af[kk], L + O_K, PQ, 16 * wave, kk); \
              _Pragma("unroll") for (int vt = 0; vt < 4; ++vt) { f32x4 g = (f32x4){0.f, 0.f, 0.f, 0.f}; \
                  _Pragma("unroll") for (int kk = 0; kk < 2; ++kk) { bf16x8 bv; SCAN_TRF(bv, L + ov, PT, 16 * vt, kk); g = __builtin_amdgcn_mfma_f32_16x16x32_bf16(af[kk], bv, g, 0, 0, 0); if (vt == (wave >> 1)) va[kk] = bv; } \
                  S[vt] = dl4 * S[vt] + dlm4 * g; } } \
            SCAN_BAR(); \
            { const int vt = wave >> 1; const size_t r0 = (size_t)cg * 64; \
              bf16x8 sa[4]; \
              _Pragma("unroll") for (int kk = 0; kk < 4; ++kk) sa[kk] = *(const LAS bf16x8*)(L + O_ST + (16 * vt + fr) * PQ + 2 * (32 * kk + 8 * fq)); \
              _Pragma("unroll") for (int tl = 0; tl < 2; ++tl) { const int tt = 2 * (wave & 1) + tl; f32x4 o = (f32x4){0.f, 0.f, 0.f, 0.f}; \
                  _Pragma("unroll") for (int kk = 0; kk < 4; ++kk) o = __builtin_amdgcn_mfma_f32_16x16x32_bf16(sa[kk], bqk[tl][kk], o, 0, 0, 0); \
                  _Pragma("unroll") for (int kk = 0; kk < 2; ++kk) { const bf16x8 ba = *(const LAS bf16x8*)(L + O_A + (16 * tt + fr) * PT + 2 * (32 * kk + 8 * fq)); o = __builtin_amdgcn_mfma_f32_16x16x32_bf16(va[kk], ba, o, 0, 0, 0); } \
                  *(GAS v2u*)(Op + (r0 + 16 * tt + fr) * opitch + 16 * vt + 4 * fq) = pk4(o); } } \
        } while (0)
        SCAN_LOAD(0, 0); SCAN_LOAD(1, 1);
#pragma unroll 1
        for (int s = 0; s < 68; s += 2) { SCAN_STEP(s, 0); SCAN_STEP(s + 1, 1); }
        SCAN_BAR();
#undef SCAN_CG
#undef SCAN_LOAD
#undef SCAN_BAR
#undef SCAN_TRF
#undef SCAN_STEP
    }
}

__device__ __forceinline__ void p4_attention(const Frame& F0, int l, bool need_ctx, char* lds_generic, bool dummy_out) {
    PHASE_FRAME(F0);
    bool nomax;
    { const float gq = fabsf(INP(I_QNG)[l * 64 + F.lane]), gk = fabsf(INP(I_KNG)[l * 64 + F.lane]); float mq = gq, mk = gk;
#pragma unroll
      for (int o = 1; o < 64; o <<= 1) { mq = fmaxf(mq, shx(mq, o, F.lane)); mk = fmaxf(mk, shx(mk, o, F.lane)); }
      const float bound = 64.f * QC2 * mq * mk; nomax = __builtin_amdgcn_readfirstlane(__builtin_bit_cast(int, bound)) < __builtin_bit_cast(int, 64.f) && bound == bound; }
    typedef attn_body::bf16 abf;
    abf* Y2 = (abf*)(F.ws + Z_Y2); const abf* KG = (const abf*)(F.ws + Z_KG); const abf* VG = (const abf*)(F.ws + Z_VG);
    const int nunits = 2048 + (need_ctx ? 128 : 0);
    for (int u = F.bx; u < nunits; u += F.G) {
        int b, h, kvh, NT; size_t qrow;
        if (u < 2048) { const int i_ = u >> 8, x_ = u & 7, j32 = (u & 255) >> 3; const int grp = (i_ >> 1) * 8 + x_, j = (i_ & 1) * 32 + j32; b = grp >> 1; kvh = grp & 1; h = 4 * kvh + (j >> 4); qrow = (size_t)b * SEQ + (size_t)(j & 15) * 256; NT = KVLEN / 64; }
        else { const int u2 = u - 2048; b = u2 >> 3; h = u2 & 7; kvh = h >> 2; qrow = (size_t)TL + (size_t)b * CTXL; NT = CTXL / 64; }
        abf* Qb = Y2 + qrow * 1024 + 512 + 64 * h;
        abf* Ob = dummy_out ? (abf*)(F.ws + WS_XN) + qrow * 1024 + 512 + 64 * h : Qb;
        if (nomax) attn_body::attn_unit<8, true>(Qb, KG + (size_t)b * KVLEN * 128 + 64 * kvh, VG + (size_t)b * KVLEN * 128 + 64 * kvh, Ob, NT, lds_generic);
        else attn_body::attn_unit<8, false>(Qb, KG + (size_t)b * KVLEN * 128 + 64 * kvh, VG + (size_t)b * KVLEN * 128 + 64 * kvh, Ob, NT, lds_generic);
    }
}

__device__ __forceinline__ void p5_headnorm(const Frame& F0, int l, int nrows) {
    PHASE_FRAME(F0);
    const int gw = F.bx * NWAVES + F.wave, NGW = F.G * NWAVES;
    bf16* Y2 = WSP(bf16, Z_Y2); const bf16* OB = WSP(bf16, Z_OB); const bf16* OG = WSP(bf16, Z_OG);
    const float* g = INP(I_HNG) + l * 512 + 8 * F.lane; const f32x4 g0 = *(const GAS f32x4*)g, g1 = *(const GAS f32x4*)(g + 4);
    for (int m = gw; m < nrows; m += NGW) {
        const v4u a = *(const GAS v4u*)(Y2 + (size_t)m * 1024 + 8 * F.lane), bb = *(const GAS v4u*)(OB + (size_t)m * 512 + 8 * F.lane), gg = *(const GAS v4u*)(OG + (size_t)m * 512 + 8 * F.lane);
        f32x4 o0 = unpk4((v2u){a.x, a.y}) + unpk4((v2u){bb.x, bb.y}), o1 = unpk4((v2u){a.z, a.w}) + unpk4((v2u){bb.z, bb.w});
        float ss = (o0[0] * o0[0] + o0[1] * o0[1]) + (o0[2] * o0[2] + o0[3] * o0[3]) + (o1[0] * o1[0] + o1[1] * o1[1]) + (o1[2] * o1[2] + o1[3] * o1[3]);
        ss += shx(ss, 1, F.lane); ss += shx(ss, 2, F.lane); ss += shx(ss, 4, F.lane); ss += shx(ss, 8, F.lane);
        const float rs = rsqrtf(ss * (1.f / 128.f) + EPSN);
        o0 = o0 * rs * g0 * unpk4((v2u){gg.x, gg.y}); o1 = o1 * rs * g1 * unpk4((v2u){gg.z, gg.w});
        const v2u p0 = pk4(o0), p1 = pk4(o1);
        *(GAS v4u*)(Y2 + (size_t)m * 1024 + 8 * F.lane) = (v4u){p0.x, p0.y, p1.x, p1.y};
    }
}

__device__ __forceinline__ void p9_router(const Frame& F0, int l, int nrows) {
    PHASE_FRAME(F0);
    LAS int* lcnt = (LAS int*)(F.lds + LDSCTL_OFF);
    LAS float* lgs = (LAS float*)(F.lds + F.wave * 4096);
    const float* MOD = WSP(float, WS_MOD) + (size_t)l * 17 * 6144; bf16* XN = WSP(bf16, WS_XN);
    const bf16* HB = (l == DEPTH - 1) ? WSP(bf16, Z_SG) : (const bf16*)F.out;
    const float* WP = WSP(float, WS_WR); const float* CV = WSP(float, WS_WR + WR_CVEC);
    int* INFO = (int*)(F.ws + WS_RT + RT_INFO); float* WTS = (float*)(F.ws + WS_RT + RT_W); int* CNT = (int*)(F.ws + WS_RT + RT_CNT);
    if (F.tid < 32) lcnt[F.tid] = 0;
    __syncthreads();
    const int lane = F.lane, i16 = lane & 15, kg = lane >> 4;
    for (int gamma = F.bx; gamma < TL / 128; gamma += F.G) {
        const int row0 = gamma * 128 + F.wave * 16; const int brow = row0 >> 12;
        const bf16* hbase = HB + (size_t)row0 * 1024;
        const bf16* hp = hbase + (size_t)i16 * 1024 + 8 * kg;
        const GAS bf16* wl = (const GAS bf16*)(F.ws + WS_HC) + (size_t)brow * 98304 + kg * 768 + i16 * 8;
        f32x4 a0 = (f32x4){0.f, 0.f, 0.f, 0.f}, a1 = a0, a2 = a0; float ss = 0.f;
        v4u hn[4];
#pragma unroll
        for (int jj = 0; jj < 4; ++jj) hn[jj] = *(const GAS v4u*)(hp + 32 * jj);
#pragma unroll 1
        for (int c8 = 0; c8 < 8; ++c8) {
            v4u hv[4]; bf16x8 wf[4][6];
#pragma unroll
            for (int jj = 0; jj < 4; ++jj) hv[jj] = hn[jj];
#pragma unroll
            for (int jj = 0; jj < 4; ++jj)
#pragma unroll
                for (int q = 0; q < 6; ++q) wf[jj][q] = *(const GAS bf16x8*)(wl + (size_t)(4 * c8 + jj) * 3072 + q * 128);
            if (c8 < 7) {
#pragma unroll
                for (int jj = 0; jj < 4; ++jj) hn[jj] = *(const GAS v4u*)(hp + 32 * (4 * (c8 + 1) + jj)); }
#pragma unroll
            for (int jj = 0; jj < 4; ++jj) { const f32x4 xl = pg8::unlo4(hv[jj]), xh = pg8::unhi4(hv[jj]); const bf16x8 ha = __builtin_bit_cast(bf16x8, hv[jj]);
                ss += ((xl[0] * xl[0] + xl[1] * xl[1]) + (xl[2] * xl[2] + xl[3] * xl[3])) + ((xh[0] * xh[0] + xh[1] * xh[1]) + (xh[2] * xh[2] + xh[3] * xh[3]));
                a0 = __builtin_amdgcn_mfma_f32_16x16x32_bf16(ha, wf[jj][0], a0, 0, 0, 0); a1 = __builtin_amdgcn_mfma_f32_16x16x32_bf16(ha, wf[jj][1], a1, 0, 0, 0); a2 = __builtin_amdgcn_mfma_f32_16x16x32_bf16(ha, wf[jj][2], a2, 0, 0, 0);
                a0 = __builtin_amdgcn_mfma_f32_16x16x32_bf16(ha, wf[jj][3], a0, 0, 0, 0); a1 = __builtin_amdgcn_mfma_f32_16x16x32_bf16(ha, wf[jj][4], a1, 0, 0, 0); a2 = __builtin_amdgcn_mfma_f32_16x16x32_bf16(ha, wf[jj][5], a2, 0, 0, 0); }
        }
        ss += shx(ss, 16, lane); ss += shx(ss, 32, lane);
        const float rs = rsqrtf(ss * (1.f / 1024.f) + EPSN);
#pragma unroll
        for (int rg = 0; rg < 4; ++rg) { lgs[(4 * kg + rg) * 49 + i16] = a0[rg]; lgs[(4 * kg + rg) * 49 + 16 + i16] = a1[rg]; lgs[(4 * kg + rg) * 49 + 32 + i16] = a2[rg]; }
        LDS_WAIT(); asm volatile("" ::: "memory");
        if (lane < 16) {
            const int row = row0 + lane; const float* cv = CV + brow * 48; const LAS float* lg = lgs + lane * 49;
            float gl[4]; int gsel = 0; float gm = -3.0e38f;
#pragma unroll
            for (int j = 0; j < 4; ++j) { gl[j] = lg[j] * rs + cv[j]; if (gl[j] > gm) { gm = gl[j]; gsel = j; } }
            float den = 0.f;
#pragma unroll
            for (int j = 0; j < 4; ++j) den += __expf(gl[j] - gm);
            const float pg = 1.f / den;
            float el[8];
#pragma unroll
            for (int j = 0; j < 8; ++j) {
                float v = lg[4 + j] * rs + cv[4 + j];
                const float v1 = lg[12 + j] * rs + cv[12 + j], v2 = lg[20 + j] * rs + cv[20 + j], v3 = lg[28 + j] * rs + cv[28 + j];
                v = gsel == 1 ? v1 : v; v = gsel == 2 ? v2 : v; v = gsel == 3 ? v3 : v; el[j] = v; }
            int t1 = 0; float m1 = -3.0e38f;
#pragma unroll
            for (int j = 0; j < 8; ++j) if (el[j] > m1) { m1 = el[j]; t1 = j; }
            int t2 = 0; float m2 = -3.0e38f;
#pragma unroll
            for (int j = 0; j < 8; ++j) if (j != t1 && el[j] > m2) { m2 = el[j]; t2 = j; }
            const float e2 = __expf(m2 - m1); const float w1 = pg / (1.f + e2), w2 = pg * e2 / (1.f + e2);
            const int e0 = gsel * 8 + t1, e1 = gsel * 8 + t2;
            const int lr0 = __hip_atomic_fetch_add(&lcnt[e0], 1, __ATOMIC_RELAXED, __HIP_MEMORY_SCOPE_WORKGROUP), lr1 = __hip_atomic_fetch_add(&lcnt[e1], 1, __ATOMIC_RELAXED, __HIP_MEMORY_SCOPE_WORKGROUP);
            *(GAS i32x4*)(INFO + 4 * (size_t)row) = (i32x4){e0, e1, lr0, lr1};
            *(GAS f32x2*)(WTS + 2 * (size_t)row) = (f32x2){w1, w2};
        }
        const float* n2g = INP(I_N2G) + l * 1024; const float* mod = MOD + (size_t)brow * 6144;
        f32x4 gsc[4], shv[4];
#pragma unroll
        for (int j = 0; j < 4; ++j) { const int e = 2 * lane + 128 * (j >> 1) + (j & 1); const f32x4 g = *((const GAS f32x4*)n2g + e), sc = *((const GAS f32x4*)(mod + 4096) + e); gsc[j] = g * (sc + 1.f); shv[j] = *((const GAS f32x4*)(mod + 3072) + e); }
#pragma unroll 1
        for (int r4 = 0; r4 < 16; r4 += 4) {
            v4u v[4][2];
#pragma unroll
            for (int q = 0; q < 4; ++q)
#pragma unroll
                for (int j = 0; j < 2; ++j) v[q][j] = *((const GAS v4u*)(hbase + (size_t)(r4 + q) * 1024) + lane + 64 * j);
#pragma unroll
            for (int q = 0; q < 4; ++q) { const float rsr = shl(rs, r4 + q);
#pragma unroll
                for (int j = 0; j < 2; ++j) { const f32x4 y0 = pg8::unlo4(v[q][j]) * rsr * gsc[2 * j] + shv[2 * j], y1 = pg8::unhi4(v[q][j]) * rsr * gsc[2 * j + 1] + shv[2 * j + 1];
                    *((GAS v2u*)((unsigned char*)XN + (size_t)(row0 + r4 + q) * 1024) + lane + 64 * j) = (v2u){pk4_f8(y0[0], y0[1], y0[2], y0[3]), pk4_f8(y1[0], y1[1], y1[2], y1[3])}; } }
        }
    }
    if (nrows > TL) {
        LAS float* red = (LAS float*)(F.lds + 32768);
        LAS float* ssp = red + 8 * 16 * 49;
        const int wave = F.wave, koff = 128 * wave + 8 * kg;
#pragma unroll 1
        for (int tj = F.bx; tj < TC / 16; tj += F.G) {
            const int row0 = TL + tj * 16;
            const bf16* hq = HB + (size_t)(row0 + i16) * 1024 + koff;
            v4u hw8[4];
#pragma unroll
            for (int jp = 0; jp < 4; ++jp) hw8[jp] = *(const GAS v4u*)(hq + 32 * jp);
            const unsigned wvo = (unsigned)((koff * 48 + i16) * 4);
            f32x4 a0 = (f32x4){0.f, 0.f, 0.f, 0.f}, a1 = a0, a2 = a0; float ss = 0.f;
#pragma unroll
            for (int jp = 0; jp < 4; ++jp) {
                float wv[2][4][3];
#pragma unroll
                for (int hf = 0; hf < 2; ++hf)
#pragma unroll
                    for (int c = 0; c < 4; ++c) { const GAS float* wr_ = (const GAS float*)((const GAS char*)(WP + ((size_t)16 * 1024 + 32 * jp) * 48) + wvo) + (4 * hf + c) * 48; wv[hf][c][0] = wr_[0]; wv[hf][c][1] = wr_[16]; wv[hf][c][2] = wr_[32]; }
#pragma unroll
                for (int hf = 0; hf < 2; ++hf) { const f32x4 x = hf ? pg8::unhi4(hw8[jp]) : pg8::unlo4(hw8[jp]); ss += (x[0] * x[0] + x[1] * x[1]) + (x[2] * x[2] + x[3] * x[3]);
#pragma unroll
                    for (int c = 0; c < 4; ++c) {
                        a0 = __builtin_amdgcn_mfma_f32_16x16x4f32(x[c], wv[hf][c][0], a0, 0, 0, 0);
                        a1 = __builtin_amdgcn_mfma_f32_16x16x4f32(x[c], wv[hf][c][1], a1, 0, 0, 0);
                        a2 = __builtin_amdgcn_mfma_f32_16x16x4f32(x[c], wv[hf][c][2], a2, 0, 0, 0); } }
            }
            ss += shx(ss, 16, lane); ss += shx(ss, 32, lane);
            { LAS float* rw = red + wave * (16 * 49);
#pragma unroll
              for (int rg = 0; rg < 4; ++rg) { rw[(4 * kg + rg) * 49 + i16] = a0[rg]; rw[(4 * kg + rg) * 49 + 16 + i16] = a1[rg]; rw[(4 * kg + rg) * 49 + 32 + i16] = a2[rg]; }
              if (kg == 0) ssp[wave * 16 + i16] = ss; }
            __syncthreads();
            float rs;
            { float sst = 0.f;
#pragma unroll
              for (int w = 0; w < 8; ++w) sst += ssp[w * 16 + i16];
              rs = rsqrtf(sst * (1.f / 1024.f) + EPSN); }
            if (F.tid < 16) {
                const int row = row0 + lane; const float* cv = CV + 16 * 48;
                float gl[4]; int gsel = 0; float gm = -3.0e38f;
#pragma unroll
                for (int j = 0; j < 4; ++j) { float s = 0.f;
#pragma unroll
                    for (int w = 0; w < 8; ++w) s += red[(w * 16 + lane) * 49 + j];
                    gl[j] = s * rs + cv[j]; if (gl[j] > gm) { gm = gl[j]; gsel = j; } }
                float den = 0.f;
#pragma unroll
                for (int j = 0; j < 4; ++j) den += __expf(gl[j] - gm);
                const float pg = 1.f / den;
                float el[8];
#pragma unroll
                for (int j = 0; j < 8; ++j) { float s = 0.f; const int col = 4 + 8 * gsel + j;
#pragma unroll
                    for (int w = 0; w < 8; ++w) s += red[(w * 16 + lane) * 49 + col];
                    el[j] = s * rs + cv[col]; }
                int t1 = 0; float m1 = -3.0e38f;
#pragma unroll
                for (int j = 0; j < 8; ++j) if (el[j] > m1) { m1 = el[j]; t1 = j; }
                int t2 = 0; float m2 = -3.0e38f;
#pragma unroll
                for (int j = 0; j < 8; ++j) if (j != t1 && el[j] > m2) { m2 = el[j]; t2 = j; }
                const float e2 = __expf(m2 - m1); const float w1 = pg / (1.f + e2), w2 = pg * e2 / (1.f + e2);
                const int e0 = gsel * 8 + t1, e1 = gsel * 8 + t2;
                const int lr0 = __hip_atomic_fetch_add(&lcnt[e0], 1, __ATOMIC_RELAXED, __HIP_MEMORY_SCOPE_WORKGROUP), lr1 = __hip_atomic_fetch_add(&lcnt[e1], 1, __ATOMIC_RELAXED, __HIP_MEMORY_SCOPE_WORKGROUP);
                *(GAS i32x4*)(INFO + 4 * (size_t)row) = (i32x4){e0, e1, lr0, lr1};
                *(GAS f32x2*)(WTS + 2 * (size_t)row) = (f32x2){w1, w2};
            }
            {
                const float* n2g = INP(I_N2G) + l * 1024; const float* mod = MOD + (size_t)16 * 6144;
                unsigned char* xr = (unsigned char*)XN + (size_t)(row0 + i16) * 1024 + koff;
#pragma unroll
                for (int jp = 0; jp < 4; ++jp) { v2u o;
#pragma unroll
                    for (int hf = 0; hf < 2; ++hf) { const int k = koff + 32 * jp + 4 * hf;
                        const f32x4 g = *(const GAS f32x4*)(n2g + k), sh = *(const GAS f32x4*)(mod + 3072 + k), sc = *(const GAS f32x4*)(mod + 4096 + k);
                        const f32x4 y = (hf ? pg8::unhi4(hw8[jp]) : pg8::unlo4(hw8[jp])) * rs * g * (sc + 1.f) + sh; const unsigned w4 = pk4_f8(y[0], y[1], y[2], y[3]); if (hf == 0) o.x = w4; else o.y = w4; }
                    *(GAS v2u*)(xr + 32 * jp) = o; }
            }
            __syncthreads();
        }
    }
    __syncthreads();
    if (F.tid < 32) CNT[F.bx * 32 + F.tid] = lcnt[F.tid];
}

__device__ __forceinline__ void p10_dispatch(const Frame& F0, int nrows) {
    PHASE_FRAME(F0);
    LAS int* cnts = (LAS int*)F.lds; LAS int* tot = (LAS int*)(F.lds + 32768); LAS int* base = tot + 32; LAS int* offs = base + 32;
    const int* CNT = (const int*)(F.ws + WS_RT + RT_CNT); const int* INFO = (const int*)(F.ws + WS_RT + RT_INFO); const float* WTS = (const float*)(F.ws + WS_RT + RT_W);
    int* DEST = (int*)(F.ws + WS_RT + RT_DEST); int* OFFT = (int*)(F.ws + WS_RT + RT_OFF); int* ROWTOK = (int*)(F.ws + WS_RT + RT_ROWTOK); float* ROWW = (float*)(F.ws + WS_RT + RT_ROWW);
    for (int i = F.tid; i < F.G * 32; i += NWAVES * 64) cnts[i] = CNT[i];
    __syncthreads();
    if (F.tid < 32) { int t = 0, bsum = 0; for (int blk = 0; blk < F.G; ++blk) { const int c = cnts[blk * 32 + F.tid]; if (blk < F.bx) bsum += c; t += c; } tot[F.tid] = t; base[F.tid] = bsum; }
    __syncthreads();
    if (F.tid == 0) { int o = 0; for (int e = 0; e < 32; ++e) { offs[e] = o; o += (tot[e] + 255) & ~255; } offs[32] = o; }
    __syncthreads();
    if (F.bx == 0 && F.tid < 33) OFFT[F.tid] = offs[F.tid] >> 8;
    const int nlat = (TL / 128 - F.bx + F.G - 1) / F.G, nctx = (nrows > TL && F.bx < TC / 16) ? (TC / 16 - F.bx + F.G - 1) / F.G : 0;
    for (int idx = F.tid; idx < nlat * 128 + nctx * 16; idx += NWAVES * 64) {
        int row; if (idx < nlat * 128) row = (F.bx + (idx >> 7) * F.G) * 128 + (idx & 127); else { const int i2 = idx - nlat * 128; row = TL + (F.bx + (i2 >> 4) * F.G) * 16 + (i2 & 15); }
        { const i32x4 inf = *(const GAS i32x4*)(INFO + 4 * (size_t)row); const f32x2 w = *(const GAS f32x2*)(WTS + 2 * (size_t)row);
            const int d0 = offs[inf.x] + base[inf.x] + inf.z, d1 = offs[inf.y] + base[inf.y] + inf.w;
            ROWTOK[d0] = row; ROWW[d0] = w.x; ROWTOK[d1] = row; ROWW[d1] = w.y; DEST[2 * row] = d0; DEST[2 * row + 1] = d1; }
    }
    for (int e = F.bx; e < 32; e += F.G) for (int r = offs[e] + tot[e] + F.tid; r < offs[e + 1]; r += NWAVES * 64) { ROWTOK[r] = 0; ROWW[r] = 0.f; }
}

__device__ __forceinline__ LAS int* load_toff(const Frame& F0) {
    PHASE_FRAME(F0);
    LAS int* toff = (LAS int*)(F.lds + LDSCTL_OFF);
    if (F.tid < 33) toff[F.tid] = ((const int*)(F.ws + WS_RT + RT_OFF))[F.tid];
    __syncthreads();
    return toff;
}
constexpr int NPH_LAYER = 10, NPHASE = 1 + DEPTH * NPH_LAYER + 1;
struct Args { const float* in[24]; float* out; unsigned char* ws; int ph_lo, ph_hi; };
__global__ void __launch_bounds__(NWAVES * 64, 2) fwd_kernel(Args args) {
    extern __shared__ __attribute__((aligned(16))) unsigned char lds[];
    Frame F;
    F.lds = (LAS unsigned char*)lds;
    F.MISC = (volatile LAS unsigned*)(F.lds + MISC_OFF);
    F.tid = threadIdx.x; F.lane = F.tid & 63; F.wave = __builtin_amdgcn_readfirstlane(F.tid >> 6);
    F.G = gridDim.x; F.bx = blockIdx.x;
    F.ws = args.ws; F.out = args.out; F.ctl = (gu32*)(args.ws + WS_CTL);
    if (F.tid < 24) { const unsigned long long pv = (unsigned long long)args.in[F.tid]; ((LAS unsigned*)(F.lds + PTRS_OFF))[2 * F.tid] = (unsigned)pv; ((LAS unsigned*)(F.lds + PTRS_OFF))[2 * F.tid + 1] = (unsigned)(pv >> 32); }
    for (int u = F.tid + (MISC_OFF - LDSCTL_OFF) / 4; u < (LDS_BYTES - LDSCTL_OFF) / 4; u += NWAVES * 64) ((LAS unsigned*)(F.lds + LDSCTL_OFF))[u] = 0u;
    __syncthreads();
    XcdBarrier bar; bar.bar = (unsigned*)(F.ctl + CW_BAR); bar.x = 0; bar.st = nullptr;
    if (!MK_PER_PHASE) bar = xcd_barrier_post((unsigned*)(F.ctl + CW_BAR), F.MISC + 8);
    const int lo = args.ph_lo, hi = args.ph_hi;
#ifndef PHASE_MASK
#define PHASE_MASK 0xFFFFu
#endif
#define PH_ON(j) (((PHASE_MASK) >> (j)) & 1u)
#ifndef WGM_IN
#define WGM_IN 8
#endif
#ifndef R8H
#define R8H 13
#endif
#ifndef WGM_G8
#define WGM_G8 8
#endif
#ifndef WGM_N1
#define WGM_N1 8
#endif
#ifndef SWAP_IN
#define SWAP_IN 0
#endif
#ifndef CV_FIRST
#define CV_FIRST 1
#endif
#ifndef STG_IN
#define STG_IN 0
#define STG_G8 0
#define STG_MG 0
#define STG_OUT 0
#define STG_M1 0
#define STG_M2 0
#endif
#define STGD(x) ((x) >= 0 ? (grpB ? (x) : 0) : (grpB ? 0 : -(x)))
#ifndef PROBE_KDIV
#define PROBE_KDIV 1
#endif
#ifndef REP_MASK
#define REP_MASK 0u
#endif
#define NREP(j) (1 + (int)(((REP_MASK) >> (j)) & 1u))
#define IN(k) (lo <= (k) && (k) < hi)
#define SEAM(k) do { if (IN(k) && IN((k) + 1)) { if (MK_PER_PHASE) { if (F.tid == 0) __hip_atomic_store(F.ctl + CW_TMO, 0xBADBA0u, RLX_AGENT); } else { xcd_barrier(bar); if (NREP(14) > 1) { xcd_barrier(bar); xcd_barrier(bar); } } } } while (0)

#ifdef POISON_WS
    if (IN(0)) {
#define POISON_RANGE(bit, lo, hi) if ((POISON_WS >> (bit)) & 1) { v4u* p = (v4u*)(F.ws + (lo)); const size_t n = ((hi) - (lo)) / 16; \
            for (size_t i = (size_t)F.bx * 512 + F.tid; i < n; i += (size_t)F.G * 512) p[i] = (v4u){0xFFFFFFFFu, 0xFFFFFFFFu, 0xFFFFFFFFu, 0xFFFFFFFFu}; }
        POISON_RANGE(0, WS_MOD, WS_W)
        POISON_RANGE(1, WS_W, WS_XN)
        POISON_RANGE(2, WS_XN, WS_Z)
        POISON_RANGE(3, Z_QF, Z_Y2)
        POISON_RANGE(4, Z_Y2, Z_KG)
        POISON_RANGE(5, Z_KG, Z_SG)
        POISON_RANGE(6, Z_SG, Z_DEC)
        POISON_RANGE(7, Z_DEC, WS_END)
        POISON_RANGE(8, W_DN1, WS_NEED)
        xcd_barrier(bar);
    }
#endif
    if (PH_ON(12) && IN(0)) { for (int rep_ = 0; rep_ < 1 + 3 * (NREP(12) - 1); ++rep_) p0_prologue(F); }
    SEAM(0);

#pragma unroll 1
    for (int l = 0; l < DEPTH; ++l) {
        const int pb = 1 + l * NPH_LAYER;
        const bool need_ctx = l < DEPTH - 1;
        const bool grpB = (F.bx >> 3) & 1;
        const int nrows = need_ctx ? TT : TL;
        unsigned char* W = F.ws + WS_W + (size_t)(l & 1) * W_PSTRIDE; unsigned char* WDN = F.ws + ((l & 1) ? W_DN1 : W_DN0);
        const int cv_rem = (nrows / 256 * 4) % F.G, cv_nw = (cv_rem ? F.G - cv_rem : F.G) * NWAVES, cv_id = cv_rem ? ((int)F.bx - cv_rem) * NWAVES + F.wave : (int)F.bx * NWAVES + F.wave;
        if (PH_ON(0) && IN(pb + 0)) { row_pass(F, l, l == 0 ? 0 : 1); for (int rep_ = 0; rep_ < NREP(0); ++rep_) { if (l == 0) convert_items(F, 0, 0, 1, F.bx * NWAVES + F.wave, F.G * NWAVES); convert_layer(F, l); } } SEAM(pb + 0);
        if (PH_ON(1) && IN(pb + 1)) { for (int rep_ = 0; rep_ < NREP(1); ++rep_) {
            pg8::Gemm g{WSP(bf16, WS_XN), (const bf16*)(W + W_IN), 1024, 1024, 1024, 0, nullptr, STGD(STG_IN)}; pg8::StaticOrder S; S.init(TT, 2048, F.G, F.bx, WGM_IN);
            pg8::EpiZ E{F.ws, l, INP(I_QNG) + l * 64, INP(I_KNG) + l * 64};
#pragma unroll 1
            for (int pass_ = 0; pass_ < 2; ++pass_) {
            if ((pass_ == 0) == !(SWAP_IN && grpB)) pg8::gemm_phase<pg8::EpiZ, pg8::StaticOrder, true, false>(F.lds + RING_OFF, g, S, E);
            else {
                pg8::Gemm g8{WSP(bf16, Z_OB), (const bf16*)(W + W_IN8), 512, 512, 512, 0, (const int*)(F.ws + WS_TAB + 65536), STGD(STG_G8)}; pg8::StaticOrder S8; S8.init(TT, 3328, F.G, F.bx, WGM_G8); { const int nh_ = (TT / 256 * 8) % F.G; if (R8H > 0 && (nh_ & 7) == 0 && ((F.G - nh_) & 7) == 0 && nh_ > 0) { S8.nfull = R8H; S8.nheavy = nh_; } }
                pg8::EpiF8 E8{pg8::EpiGates{F.ws + Z_SG}, E};
                pg8::gemm_phase<pg8::EpiF8, pg8::StaticOrder, true, true, true, 0x7A7A7A7A, true>(F.lds + RING_OFF, g8, S8, E8);
            } }
        } } SEAM(pb + 1);
        if (PH_ON(2) && IN(pb + 2)) { for (int rep_ = 0; rep_ < NREP(2); ++rep_) { p3_scan(F); } } SEAM(pb + 2);
        if (PH_ON(3) && IN(pb + 3)) { if (NREP(3) > 1) p4_attention(F, l, need_ctx, (char*)lds + RING_OFF, true); p4_attention(F, l, need_ctx, (char*)lds + RING_OFF, false); p5_headnorm(F, l, nrows); } SEAM(pb + 3);
        if (PH_ON(5) && IN(pb + 4)) { for (int rep_ = 0; rep_ < NREP(5); ++rep_) {
            pg8::Gemm g{WSP(bf16, Z_Y2), (const bf16*)(W + W_UP), 1024, 1024, 1024, 0, nullptr, STGD(STG_MG)}; pg8::StaticOrder S; S.init(nrows, 1024, F.G, F.bx, need_ctx ? WGM_N1 : 8);
            pg8::EpiMergeF E{WSP(bf16, WS_XN), F.ws + Z_SG};
            const bool cv_first = CV_FIRST && grpB;
            if (need_ctx && cv_id >= 0 && cv_first) { convert_items(F, l + 1, 0, 2, cv_id, cv_nw); __syncthreads(); }
            pg8::gemm_phase<pg8::EpiMergeF, pg8::StaticOrder, true, false>(F.lds + RING_OFF, g, S, E);
            if (need_ctx && cv_id >= 0 && !cv_first) convert_items(F, l + 1, 0, 2, cv_id, cv_nw);
        } } SEAM(pb + 4);
        if (PH_ON(7) && IN(pb + 5)) {
            pg8::Gemm g{WSP(bf16, WS_XN), (const bf16*)(W + W_OUT), 1024, 1024, 1024, 0, nullptr, STGD(STG_OUT)}; pg8::StaticOrder S; S.init(nrows, 1024, F.G, F.bx, need_ctx ? WGM_N1 : 8);
            pg8::EpiOut E{l == DEPTH - 1 ? WSP(bf16, Z_SG) : (bf16*)F.out, (const bf16*)F.out, WSP(float, WS_MOD) + (size_t)l * 17 * 6144, INP(I_X), INP(I_CTX), l == 0};
            const bool cv_first = CV_FIRST && grpB;
            if (need_ctx && cv_id >= 0 && cv_first) { convert_items(F, l + 1, 1, 2, cv_id, cv_nw); __syncthreads(); }
            pg8::gemm_phase<pg8::EpiOut, pg8::StaticOrder, true, false>(F.lds + RING_OFF, g, S, E);
            if (need_ctx && cv_id >= 0 && !cv_first) convert_items(F, l + 1, 1, 2, cv_id, cv_nw);
        } SEAM(pb + 5);
        if (PH_ON(8) && IN(pb + 6)) { for (int rep_ = 0; rep_ < NREP(8); ++rep_) { p9_router(F, l, nrows); } } SEAM(pb + 6);
        if (PH_ON(9) && IN(pb + 7)) { for (int rep_ = 0; rep_ < NREP(9); ++rep_) { p10_dispatch(F, nrows); } } SEAM(pb + 7);
        if (PH_ON(10) && IN(pb + 8)) { for (int rep_ = 0; rep_ < NREP(10); ++rep_) {
            LAS int* toff = load_toff(F);
            pg8::Gemm g{WSP(bf16, WS_XN), (const bf16*)(W + W_GU), (NREP(10) > 1 && rep_ == 0) ? 512 / PROBE_KDIV : 512, 512, 512, (size_t)1024 * 512, (const int*)(F.ws + WS_RT + RT_ROWTOK), STGD(STG_M1)}; pg8::MoeOrder S{toff, F.G, F.bx};
            pg8::EpiSwiGLU E{F.ws + Z_H};
            pg8::gemm_phase<pg8::EpiSwiGLU, pg8::MoeOrder, true, true, true>(F.lds + RING_OFF, g, S, E);
        } } SEAM(pb + 8);
        if (PH_ON(11) && IN(pb + 9)) { for (int rep_ = 0; rep_ < NREP(11); ++rep_) {
            LAS int* toff = load_toff(F);
            pg8::Gemm g{WSP(bf16, Z_H), (const bf16*)(WDN), 256, 256, 256, (size_t)1024 * 256, (const int*)(F.ws + WS_TAB + 65536), STGD(STG_M2)}; pg8::MoeOrder S{toff, F.G, F.bx};
            pg8::EpiDown E{F.ws + Z_YB, (const float*)(F.ws + WS_RT + RT_ROWW)};
            pg8::gemm_phase<pg8::EpiDown, pg8::MoeOrder, true, true, true, 0x7B7B7B7B, true>(F.lds + RING_OFF, g, S, E);
        } } SEAM(pb + 9);
    }
    if (PH_ON(13) && IN(NPHASE - 1)) { row_pass(F, DEPTH, 2); }
#undef IN
#undef SEAM
}

extern "C" void kernel_launch(void* const* d_in, const int* in_sizes, int n_in, void* d_out, int out_size, void* d_ws, size_t ws_size, hipStream_t stream) {
    static int grid = 0;
    if (grid == 0) {
        if (n_in != 24 || in_sizes[0] != TL * D || out_size != TL * D || ws_size < WS_NEED) { fprintf(stderr, "kernel_launch: unexpected problem shape / workspace (%d inputs, ws %zu, need %zu); nothing launched\n", n_in, ws_size, (size_t)WS_NEED); grid = -1; return; }
        int dev = 0, cus = 0, per_cu = 0;
        if (hipGetDevice(&dev) != hipSuccess || hipDeviceGetAttribute(&cus, hipDeviceAttributeMultiprocessorCount, dev) != hipSuccess) { grid = -1; return; }
        if (hipFuncSetAttribute((const void*)fwd_kernel, hipFuncAttributeMaxDynamicSharedMemorySize, LDS_BYTES) != hipSuccess) { fprintf(stderr, "kernel_launch: hipFuncSetAttribute failed\n"); grid = -1; return; }
        if (hipOccupancyMaxActiveBlocksPerMultiprocessor(&per_cu, (const void*)fwd_kernel, NWAVES * 64, LDS_BYTES) != hipSuccess || per_cu < 1) { fprintf(stderr, "kernel_launch: occupancy query reports %d blocks per CU\n", per_cu); }
        (void)hipGetLastError();
        grid = cus;
        if (grid > 256) grid = 256;
    }
    if (grid < 0) return;
    if (hipMemsetAsync((char*)d_ws + WS_CTL, 0, CTL_ZERO_BYTES, stream) != hipSuccess) return;
    Args a{};
    for (int i = 0; i < 24; ++i) a.in[i] = (const float*)d_in[i];
    a.out = (float*)d_out; a.ws = (unsigned char*)d_ws;
#if MK_PER_PHASE
    for (int p = 0; p < NPHASE; ++p) { a.ph_lo = p; a.ph_hi = p + 1; hipLaunchKernelGGL(fwd_kernel, dim3(grid), dim3(NWAVES * 64), LDS_BYTES, stream, a); }
#else
    a.ph_lo = 0; a.ph_hi = NPHASE;
    hipLaunchKernelGGL(fwd_kernel, dim3(grid), dim3(NWAVES * 64), LDS_BYTES, stream, a);
#endif
    const hipError_t le = hipPeekAtLastError();
    if (le != hipSuccess) fprintf(stderr, "kernel_launch: launch failed: %s\n", hipGetErrorName(le));
}
```

```cpp
#include <hip/hip_runtime.h>
#include <hip/hip_bf16.h>
#include <cstdio>
#include <cstdint>
#include <cmath>

#ifndef MK_PER_PHASE
#define MK_PER_PHASE 0
#endif

constexpr int D = 1024, NBATCH = 16, SEQ = 4096, CTXL = 256, DEPTH = 4;
constexpr int TL = NBATCH * SEQ, TC = NBATCH * CTXL, TT = TL + TC;
constexpr int NZ = 5376, KVLEN = CTXL + SEQ;
constexpr int NEXP = 32, DEXP = 512, RCAP = 2 * TT + NEXP * 256;
constexpr int NCHUNK = TT / 64;
constexpr float EPSN = 1e-6f;
constexpr float QC2 = 0.125f * 1.4426950408889634f;

constexpr size_t MiB = 1u << 20;
constexpr size_t WS_CTL = 0, CTL_ZERO_BYTES = 1 * MiB;
constexpr size_t WS_MOD = 1 * MiB;
constexpr size_t WS_TAB = 3 * MiB;
constexpr size_t WS_WR = 4 * MiB;
constexpr size_t WR_CVEC = (size_t)17 * 1024 * 48 * 4;
constexpr size_t WS_RT = 8 * MiB;
constexpr size_t RT_INFO = 0;
constexpr size_t RT_W = RT_INFO + (size_t)TT * 16;
constexpr size_t RT_DEST = RT_W + (size_t)TT * 8;
constexpr size_t RT_CNT = RT_DEST + (size_t)TT * 8;
constexpr size_t RT_OFF = RT_CNT + 256 * 32 * 4;
constexpr size_t RT_ROWTOK = RT_OFF + 256;
constexpr size_t RT_ROWW = RT_ROWTOK + (size_t)RCAP * 4;
static_assert(RT_ROWW + (size_t)RCAP * 4 <= 4 * MiB, "routing arrays");
constexpr size_t WS_HC = 12 * MiB;
constexpr size_t WS_W = 28 * MiB;
constexpr size_t W_IN = 0;
constexpr size_t W_IN8 = W_IN + (size_t)3328 * 1024 * 2;
constexpr size_t W_UP = W_IN + (size_t)NZ * 1024 * 2;
constexpr size_t W_OUT = W_UP + (size_t)1024 * 1024 * 2;
constexpr size_t W_GU = W_OUT + (size_t)1024 * 1024 * 2;
constexpr size_t W_PSTRIDE = 47 * MiB;
constexpr size_t W_DN0 = WS_W + 94 * MiB, W_DN1 = 1206 * MiB;
static_assert(W_GU + (size_t)32 * 1024 * 1024 <= W_PSTRIDE && W_DN0 + 16 * MiB <= 139 * MiB, "weights");
constexpr size_t WS_XN = 139 * MiB;
constexpr size_t WS_Z = 275 * MiB;
constexpr size_t SZ512 = (size_t)TT * 512 * 2;
constexpr size_t Z_QF = WS_Z, Z_KF = Z_QF + SZ512, Z_QB = Z_KF + SZ512, Z_KB = Z_QB + SZ512, Z_VA = Z_KB + SZ512, Z_OG = Z_VA + SZ512;
constexpr size_t Z_Y2 = Z_OG + SZ512;
constexpr size_t Z_OB = Z_Y2 + 2 * SZ512;
constexpr size_t Z_KG = Z_OB + SZ512;
constexpr size_t Z_VG = Z_KG + (size_t)NBATCH * KVLEN * 128 * 2;
constexpr size_t Z_SG = Z_VG + (size_t)NBATCH * KVLEN * 128 * 2;
constexpr size_t Z_DEC = Z_SG + (size_t)TT * 2048 * 2;
constexpr size_t WS_END = Z_DEC + (size_t)NCHUNK * 2 * 3 * 512 * 4;
constexpr size_t Z_H = WS_Z;
constexpr size_t Z_YB = Z_H + (size_t)RCAP * 512 * 2;
static_assert(Z_YB + (size_t)RCAP * 1024 * 2 <= Z_SG, "MoE overlay");
constexpr size_t WS_NEED = W_DN1 + 16 * MiB;
static_assert(WS_END <= W_DN1 && WS_NEED <= (size_t)1252 * MiB, "d_ws budget");
constexpr int CW_TMO = 0, CW_BAR = 4096;

constexpr int RING_OFF = 0, RING_BYTES = 131072;
constexpr int LDSCTL_OFF = RING_BYTES, PTRS_OFF = LDSCTL_OFF + 512, MISC_OFF = LDSCTL_OFF + 1024;
constexpr int LDS_BYTES = 147456;
constexpr int NWAVES = 8;

#define GAS __attribute__((address_space(1)))
#define LAS __attribute__((address_space(3)))
typedef unsigned short bf16;
typedef unsigned v4u __attribute__((ext_vector_type(4)));
typedef unsigned v2u __attribute__((ext_vector_type(2)));
typedef float f32x4 __attribute__((ext_vector_type(4)));
typedef float f32x2 __attribute__((ext_vector_type(2)));
typedef int i32x4 __attribute__((ext_vector_type(4)));
typedef short bf16x8 __attribute__((ext_vector_type(8)));
typedef GAS unsigned gu32;
#define RLX_AGENT __ATOMIC_RELAXED, __HIP_MEMORY_SCOPE_AGENT
#define LDS_WAIT() asm volatile("s_waitcnt lgkmcnt(0)" ::: "memory")
#define VM_WAIT() asm volatile("s_waitcnt vmcnt(0)" ::: "memory")
__device__ __forceinline__ unsigned f2bf(float f) { unsigned u = __builtin_bit_cast(unsigned, f); return (u + 0x7fffu + ((u >> 16) & 1u)) >> 16; }
typedef __bf16 bf16x2_t __attribute__((ext_vector_type(2)));
__device__ __forceinline__ unsigned pk2(float lo, float hi) { const f32x2 v = {lo, hi}; const bf16x2_t b = __builtin_convertvector(v, bf16x2_t); return __builtin_bit_cast(unsigned, b); }
__device__ __forceinline__ float bf2f(unsigned short b) { return __builtin_bit_cast(float, (unsigned)b << 16); }
__device__ __forceinline__ float bflo(unsigned w) { return __builtin_bit_cast(float, w << 16); }
__device__ __forceinline__ float bfhi(unsigned w) { return __builtin_bit_cast(float, w & 0xffff0000u); }
__device__ __forceinline__ v2u pk4(f32x4 v) { v2u r; r.x = pk2(v[0], v[1]); r.y = pk2(v[2], v[3]); return r; }
__device__ __forceinline__ f32x4 unpk4(v2u w) { return (f32x4){bflo(w.x), bfhi(w.x), bflo(w.y), bfhi(w.y)}; }
__device__ __forceinline__ float sigmoidf_(float z) { const float e = __expf(-fabsf(z)); const float r = __builtin_amdgcn_rcpf(1.f + e); return z >= 0.f ? r : e * r; }
__device__ __forceinline__ float siluf_(float z) { return z * __builtin_amdgcn_rcpf(1.f + __builtin_amdgcn_exp2f(-1.4426950408889634f * z)); }
__device__ __forceinline__ float shx(float v, int mask, int lane) { return __builtin_bit_cast(float, __builtin_amdgcn_ds_bpermute((lane ^ mask) << 2, __builtin_bit_cast(int, v))); }
__device__ __forceinline__ float shl(float v, int src) { return __builtin_bit_cast(float, __builtin_amdgcn_ds_bpermute(src << 2, __builtin_bit_cast(int, v))); }
__device__ __forceinline__ float wave_sum(float v, int lane) {
#pragma unroll
    for (int o = 1; o < 64; o <<= 1) v += shx(v, o, lane);
    return v;
}
namespace pg8 {
constexpr int BM = 256, BK = 64, HALF = 128, HTB = HALF * BK * 2, STAGE_BYTES = 8 * HTB, NXCD = 8, WGM = 8;
__host__ __device__ __forceinline__ int lds_byte(int r, int c) { const int st = (r >> 4) * 2 + (c >> 5), rr = r & 15, cc = c & 31, ob = rr * 64 + cc * 2; return st * 1024 + (ob ^ (((ob >> 9) & 1) << 5)); }
__host__ __device__ __forceinline__ void stage_rc(int b, int& R, int& C) { const int st = b / 1024, sb = b % 1024, swz = sb ^ (((sb >> 9) & 1) << 5); R = (st >> 1) * 16 + swz / 64; C = (st & 1) * 32 + (swz % 64) / 2; }

typedef int v4i_t __attribute__((ext_vector_type(4)));
struct Unit { int pm, pn, be; };
struct Gemm { const bf16* A; const bf16* Bt; int K, lda, ldb; size_t bstride; const int* rowidx; int delay = 0; };

struct StaticOrder {
    int nM, nN, nwg, G, c, wgm;
    __device__ void init(int M, int N, int G_, int c_, int wgm_ = WGM) { nM = M / BM; nN = N / BM; nwg = nM * nN; G = G_; c = c_; wgm = wgm_; }
    __device__ bool next(int i, Unit& u) const {
        const long L = (long)i * G + c; if (L >= nwg) return false;
        int wgid = (int)L; { const int q = nwg / NXCD, r = nwg % NXCD, xcd = wgid % NXCD, off = wgid / NXCD; wgid = (xcd < r ? xcd * (q + 1) : r * (q + 1) + (xcd - r) * q) + off; }
        const int nig = wgm * nN, gid = wgid / nig, fm = gid * wgm, gsz = (nM - fm) < wgm ? (nM - fm) : wgm;
        u.pm = fm + ((wgid % nig) % gsz); u.pn = (wgid % nig) / gsz; u.be = 0; return true;
    }
};
struct SimpleOrder {
    int nM, nN, G, c;
    __device__ bool next(int i, Unit& u) const { const int L = i * G + c; if (L >= nM * nN) return false; u.pm = L / nN; u.pn = L % nN; u.be = 0; return true; }
};
struct MoeOrder {
    const LAS int* toff; int G, c;
    __device__ bool next(int i, Unit& u) const {
        int L = i * G + c; const int nt = toff[32];
        if ((G & 31) == 0) { const int xcd = c & 7, j = c >> 3; L = ((i * (G >> 2) + xcd * (G >> 5) + (j >> 2)) << 2) | (j & 3); }
        if (L >= nt * 4) return false;
        u.pm = L >> 2; u.pn = L & 3;
        const int ln = (int)__builtin_amdgcn_mbcnt_lo(~0u, 0u);
        const unsigned long long bal = __builtin_amdgcn_ballot_w64(ln >= 1 && toff[ln] <= u.pm);
        u.be = __builtin_popcount((unsigned)bal); return true;
    }
};
__device__ __forceinline__ unsigned cvt_pk_bf16(float lo, float hi) { unsigned r; asm volatile("v_cvt_pk_bf16_f32 %0, %1, %2" : "=v"(r) : "v"(lo), "v"(hi)); return r; }
__device__ __forceinline__ v2u cpk4(f32x4 v) { v2u r; r.x = cvt_pk_bf16(v[0], v[1]); r.y = cvt_pk_bf16(v[2], v[3]); return r; }
__device__ __forceinline__ v4u cpk8(f32x4 a, f32x4 b) { v4u r; r.x = cvt_pk_bf16(a[0], a[1]); r.y = cvt_pk_bf16(a[2], a[3]); r.z = cvt_pk_bf16(b[0], b[1]); r.w = cvt_pk_bf16(b[2], b[3]); return r; }
__device__ __forceinline__ f32x4 unlo4(v4u w) { return (f32x4){bflo(w.x), bfhi(w.x), bflo(w.y), bfhi(w.y)}; }
__device__ __forceinline__ f32x4 unhi4(v4u w) { return (f32x4){bflo(w.z), bfhi(w.z), bflo(w.w), bfhi(w.w)}; }

template <class Epi, class Sched, bool ALIGN_EPI, bool GATHER, bool F8 = false, int WSCALE = 0x7A7A7A7A, bool IDENT = false>
__device__ __forceinline__ void gemm_phase(LAS unsigned char* lds, const Gemm g, const Sched& S, const Epi& E) {
    int tid_ = threadIdx.x; asm volatile("" : "+v"(tid_));
    const int tid = tid_, wid = __builtin_amdgcn_readfirstlane(tid >> 6), lane = tid & 63, wr = wid >> 2, wc = wid & 3, fr = lane & 15, fq = lane >> 4;
    const int K = g.K, nt = K / BK;
    int RA[2], CA[2];
    unsigned voA[2][2], voAn[2][2], voffB[2];
#pragma unroll
    for (int i = 0; i < 2; ++i) { stage_rc(tid * 16 + i * 8192, RA[i], CA[i]); voffB[i] = (unsigned)(RA[i] * g.ldb + CA[i]) * 2u;
#pragma unroll
        for (int h = 0; h < 2; ++h) { voA[h][i] = (unsigned)((h * HALF + RA[i]) * g.lda + CA[i]) * 2u; voAn[h][i] = voA[h][i]; } }
    const size_t kstep = (size_t)(BK * 2);
    const size_t hstepB = (size_t)HALF * g.ldb * 2, tstepB = 2 * hstepB, tstepA = (size_t)BM * g.lda * 2;
    const unsigned ldsw = (unsigned)wid * 1024u;
    const int aoff = lds_byte(wr * 64 + fr, fq * 8), boff = lds_byte(wc * 32 + fr, fq * 8);
#define PG8_SA(b, h) (((b) * 2 + (h)) * HTB)
#define PG8_SB(b, h) ((4 + (b) * 2 + (h)) * HTB)
#define PG8_STGA(bufoff, kptr, vo, h) do { _Pragma("unroll") for (int _i = 0; _i < 2; ++_i) \
        __builtin_amdgcn_global_load_lds((const unsigned*)((const char*)(kptr) + (vo)[h][_i]), (LAS unsigned*)(lds + (bufoff) + ldsw + _i * 8192), 16, 0, 0); } while (0)
#define PG8_STGB(bufoff, gbase) do { _Pragma("unroll") for (int _i = 0; _i < 2; ++_i) \
        __builtin_amdgcn_global_load_lds((const unsigned*)((const char*)(gbase) + voffB[_i]), (LAS unsigned*)(lds + (bufoff) + ldsw + _i * 8192), 16, 0, 0); } while (0)
#define PG8_LDA(dst, b, h) do { _Pragma("unroll") for (int m = 0; m < 4; ++m) _Pragma("unroll") for (int k = 0; k < 2; ++k) dst[m][k] = *(const LAS bf16x8*)(lds + PG8_SA(b, h) + aoff + m * 2048 + k * 1024); } while (0)
#define PG8_LDB(dst, b, h) do { _Pragma("unroll") for (int n = 0; n < 2; ++n) _Pragma("unroll") for (int k = 0; k < 2; ++k) dst[n][k] = *(const LAS bf16x8*)(lds + PG8_SB(b, h) + boff + n * 2048 + k * 1024); } while (0)
#define PG8_CAT8(x0, x1) __builtin_shufflevector(__builtin_bit_cast(v4i_t, x0), __builtin_bit_cast(v4i_t, x1), 0, 1, 2, 3, 4, 5, 6, 7)
#define PG8_MMA(ai, bj, At, Bt) do { __builtin_amdgcn_s_setprio(1); \
        if constexpr (F8) { _Pragma("unroll") for (int m = 0; m < 4; ++m) _Pragma("unroll") for (int n = 0; n < 2; ++n) \
            acc[ai][bj][m][n] = __builtin_amdgcn_mfma_scale_f32_16x16x128_f8f6f4(PG8_CAT8(Bt[n][0], Bt[n][1]), PG8_CAT8(At[m][0], At[m][1]), acc[ai][bj][m][n], 0, 0, 0, WSCALE, 0, 0x7F7F7F7F); } \
        else { _Pragma("unroll") for (int m = 0; m < 4; ++m) _Pragma("unroll") for (int n = 0; n < 2; ++n) _Pragma("unroll") for (int k = 0; k < 2; ++k) \
            acc[ai][bj][m][n] = __builtin_amdgcn_mfma_f32_16x16x32_bf16(Bt[n][k], At[m][k], acc[ai][bj][m][n], 0, 0, 0); } \
        __builtin_amdgcn_s_setprio(0); } while (0)
#define PG8_WAIT_V(n) asm volatile("s_waitcnt vmcnt(" #n ")" ::: "memory")
#define PG8_WAIT_L(n) asm volatile("s_waitcnt lgkmcnt(" #n ")" ::: "memory")
#define PG8_BAR __builtin_amdgcn_s_barrier()
#define PG8_SCHED __builtin_amdgcn_sched_barrier(0)
    Unit cur, nxt; int ui = 0;
    if (!S.next(0, cur)) return;
    if (g.delay > 0) { const unsigned long long t0_ = __builtin_amdgcn_s_memrealtime(); while ((long long)(__builtin_amdgcn_s_memrealtime() - t0_) < (long long)g.delay) __builtin_amdgcn_s_sleep(32); }
    f32x4 acc[2][2][4][2];
#pragma unroll
    for (int a = 0; a < 2; ++a)
#pragma unroll
        for (int b = 0; b < 2; ++b)
#pragma unroll
            for (int m = 0; m < 4; ++m)
#pragma unroll
                for (int n = 0; n < 2; ++n) acc[a][b][m][n] = (f32x4){0.f, 0.f, 0.f, 0.f};
    bf16x8 At[4][2], B0[2][2], B1[2][2];
    if constexpr (GATHER) {
#pragma unroll
        for (int h = 0; h < 2; ++h)
#pragma unroll
            for (int i = 0; i < 2; ++i) voA[h][i] = (unsigned)((IDENT ? cur.pm * BM + h * HALF + RA[i] : g.rowidx[cur.pm * BM + h * HALF + RA[i]]) * g.lda + CA[i]) * 2u;
    }
    const char* cA = GATHER ? (const char*)g.A : (const char*)g.A + (size_t)cur.pm * tstepA;
    const char* cB = (const char*)(g.Bt + (size_t)cur.be * g.bstride) + (size_t)cur.pn * tstepB;
    PG8_STGB(PG8_SB(0, 0), cB); PG8_STGB(PG8_SB(0, 1), cB + hstepB); PG8_STGA(PG8_SA(0, 0), cA, voA, 0); PG8_STGA(PG8_SA(0, 1), cA, voA, 1);
    if (wr == 1) PG8_BAR;
    PG8_WAIT_V(2); PG8_BAR;
    PG8_STGB(PG8_SB(1, 0), cB + kstep); PG8_STGA(PG8_SA(1, 0), cA + kstep, voA, 0); PG8_STGB(PG8_SB(1, 1), cB + hstepB + kstep);
    PG8_WAIT_V(6); PG8_BAR;
    for (;;) {
        const bool has_next = S.next(ui + 1, nxt);
        const char* nA = cA; const char* nB = cB;
        if (has_next) {
            nA = GATHER ? (const char*)g.A : (const char*)g.A + (size_t)nxt.pm * tstepA;
            nB = (const char*)(g.Bt + (size_t)nxt.be * g.bstride) + (size_t)nxt.pn * tstepB;
            if constexpr (GATHER) {
#pragma unroll
                for (int h = 0; h < 2; ++h)
#pragma unroll
                    for (int i = 0; i < 2; ++i) voAn[h][i] = (unsigned)((IDENT ? nxt.pm * BM + h * HALF + RA[i] : g.rowidx[nxt.pm * BM + h * HALF + RA[i]]) * g.lda + CA[i]) * 2u;
            }
        } else if constexpr (GATHER) {
#pragma unroll
            for (int h = 0; h < 2; ++h)
#pragma unroll
                for (int i = 0; i < 2; ++i) voAn[h][i] = voA[h][i];
        }
#pragma unroll 1
        for (int t = 0; t < nt; t += 2) {
            if constexpr (Epi::MIDK > 0) { if (t == Epi::MIDK) E.mid(acc, cur, wr, wc, fr, fq); }
            const bool last = (t == nt - 2);
            const char* a1 = cA + (size_t)(t + 1) * kstep;
            const char* a2 = last ? nA : cA + (size_t)(t + 2) * kstep; const char* b2 = last ? nB : cB + (size_t)(t + 2) * kstep;
            const char* a3 = a2 + kstep; const char* b3 = b2 + kstep;
            PG8_LDB(B0, 0, 0); PG8_LDB(B1, 0, 1); PG8_SCHED; PG8_LDA(At, 0, 0); PG8_STGA(PG8_SA(1, 1), a1, voA, 1);
            if constexpr (GATHER) { if (last) {
#pragma unroll
                for (int h = 0; h < 2; ++h)
#pragma unroll
                    for (int i = 0; i < 2; ++i) voA[h][i] = voAn[h][i]; } }
            PG8_WAIT_V(8); PG8_WAIT_L(0); PG8_BAR; PG8_MMA(0, 0, At, B0); PG8_MMA(0, 1, At, B1); PG8_BAR; PG8_SCHED;
            PG8_LDA(At, 0, 1); PG8_STGB(PG8_SB(0, 0), b2); PG8_STGB(PG8_SB(0, 1), b2 + hstepB); PG8_STGA(PG8_SA(0, 0), a2, voA, 0);
            PG8_WAIT_V(8); PG8_WAIT_L(0); PG8_BAR; PG8_MMA(1, 0, At, B0); PG8_MMA(1, 1, At, B1); PG8_BAR; PG8_SCHED;
            PG8_LDB(B0, 1, 0); PG8_LDB(B1, 1, 1); PG8_SCHED; PG8_LDA(At, 1, 0); PG8_STGA(PG8_SA(0, 1), a2, voA, 1);
            PG8_WAIT_V(8); PG8_WAIT_L(0); PG8_BAR; PG8_MMA(0, 0, At, B0); PG8_MMA(0, 1, At, B1); PG8_BAR; PG8_SCHED;
            PG8_LDA(At, 1, 1); PG8_STGB(PG8_SB(1, 0), b3); PG8_STGB(PG8_SB(1, 1), b3 + hstepB); PG8_STGA(PG8_SA(1, 0), a3, voA, 0);
            PG8_WAIT_V(8); PG8_WAIT_L(0); PG8_BAR; PG8_MMA(1, 0, At, B0); PG8_MMA(1, 1, At, B1); PG8_BAR; PG8_SCHED;
        }
        if constexpr (ALIGN_EPI) { if (wr == 0) PG8_BAR; }
        E(acc, cur, wr, wc, fr, fq);
        if (!has_next) break;
#pragma unroll
        for (int a = 0; a < 2; ++a)
#pragma unroll
            for (int b = 0; b < 2; ++b)
#pragma unroll
                for (int m = 0; m < 4; ++m)
#pragma unroll
                    for (int n = 0; n < 2; ++n) acc[a][b][m][n] = (f32x4){0.f, 0.f, 0.f, 0.f};
        cur = nxt; cA = nA; cB = nB; ++ui;
        if constexpr (ALIGN_EPI) { if (wr == 1) PG8_BAR; }
    }
    PG8_WAIT_V(0);
    if constexpr (!ALIGN_EPI) { if (wr == 0) PG8_BAR; }
    PG8_BAR;
#undef PG8_SA
#undef PG8_SB
#undef PG8_STGA
#undef PG8_STGB
#undef PG8_LDA
#undef PG8_LDB
#undef PG8_MMA
#undef PG8_CAT8
#undef PG8_WAIT_V
#undef PG8_WAIT_L
#undef PG8_BAR
#undef PG8_SCHED
}

__device__ __forceinline__ float expc(float x) { return __expf(fminf(x, 80.f)); }
template <int N> __device__ __forceinline__ float row_shr(float x) { return __builtin_bit_cast(float, __builtin_amdgcn_update_dpp(0, __builtin_bit_cast(int, x), 0x110 + N, 0xF, 0xF, true)); }
__device__ __forceinline__ float row_last(float x) { return __builtin_bit_cast(float, __builtin_amdgcn_update_dpp(0, __builtin_bit_cast(int, x), 0x15F, 0xF, 0xF, false)); }
__device__ __forceinline__ float scan16d(float x) { x += row_shr<1>(x); x += row_shr<2>(x); x += row_shr<4>(x); x += row_shr<8>(x); return x; }
__device__ __forceinline__ float exp2c(float x) { return __builtin_amdgcn_exp2f(fminf(x, 115.f)); }

struct EpiZ {
    static constexpr int MIDK = 0;
    unsigned char* ws; int layer;
    const float *qg, *kg;
    __device__ __forceinline__ void operator()(const f32x4 (&acc)[2][2][4][2], const Unit& u, int wr, int wc, int fr_, int fq_) const {
        int fr = fr_, fq = fq_; asm volatile("" : "+v"(fr), "+v"(fq));
        bf16* const QF = (bf16*)(ws + Z_QF); bf16* const KF = (bf16*)(ws + Z_KF); bf16* const QB = (bf16*)(ws + Z_QB); bf16* const KB = (bf16*)(ws + Z_KB); bf16* const VA = (bf16*)(ws + Z_VA);
        bf16* const OG = (bf16*)(ws + Z_OG); bf16* const Y2 = (bf16*)(ws + Z_Y2); bf16* const KG = (bf16*)(ws + Z_KG); bf16* const VG = (bf16*)(ws + Z_VG); bf16* const SG = (bf16*)(ws + Z_SG);
        float* const DEC = (float*)(ws + Z_DEC); const float* const COS = (const float*)(ws + WS_TAB); const float* const SIN = COS + 1024;
        const float* const LBf = COS + 2048 + (0 * 4 + layer) * 512; const float* const LBb = COS + 2048 + (1 * 4 + layer) * 512;
        const int pn = u.pn;
        {
            const int ch0 = 64 * pn + 16 * wc + 4 * fq;
#pragma unroll
            for (int ai = 0; ai < 2; ++ai) { const int cg_ = (u.pm * BM + ai * HALF + wr * 64) >> 6;
                const unsigned rv_ = (unsigned)((((cg_ * 4 + (pn >> 1)) * 2 + (pn & 1)) * 64 + fr) * 64 + 16 * wc + 4 * fq);
#pragma unroll
                for (int m = 0; m < 4; ++m) *(v2u*)(VA + rv_ + m * 16 * 64) = cpk4(acc[ai][1][m][1]); }
            __builtin_amdgcn_sched_barrier(0);
#pragma unroll
            for (int ai = 0; ai < 2; ++ai) {
                const int row0 = u.pm * BM + ai * HALF + wr * 64;
                const int cg = row0 >> 6;
                const int hdA = pn >> 1;
                const unsigned ro0 = (unsigned)(((cg * 4 + hdA) * 64 + fr) * 128 + 64 * (pn & 1) + 16 * wc + 4 * fq);
                const unsigned rv0 = (unsigned)((((cg * 4 + hdA) * 2 + (pn & 1)) * 64 + fr) * 64 + 16 * wc + 4 * fq);
                f32x4 qs[4];
#pragma unroll
                for (int m = 0; m < 4; ++m)
#pragma unroll
                    for (int jj = 0; jj < 4; ++jj) qs[m][jj] = siluf_(acc[ai][0][m][0][jj]) * 0.08838834764831845f;
                {
                    const f32x4 lb = *(const f32x4*)(LBf + ch0);
                    f32x4 pf[4], kf[4]; f32x4 off = (f32x4){0.f, 0.f, 0.f, 0.f}, ref = off;
#pragma unroll
                    for (int m = 0; m < 4; ++m) {
#pragma unroll
                        for (int jj = 0; jj < 4; ++jj) { const float z = acc[ai][0][m][1][jj]; const float e = __builtin_amdgcn_exp2f(-1.4426950408889634f * fabsf(z)); const float r = __builtin_amdgcn_rcpf(1.f + e);
                            const float sp = z >= 0.f ? r : e * r, sm = z >= 0.f ? e * r : r; const float f = lb[jj] + (1.f - lb[jj]) * sp;
                            kf[m][jj] = (1.f - lb[jj]) * sm; const float p = scan16d(__builtin_amdgcn_logf(fmaxf(f, 1e-37f))) + off[jj]; pf[m][jj] = p; off[jj] = row_last(p); }
                        if (m == 1) ref = off;
                    }
                    const f32x4 tot = off;
#pragma unroll
                    for (int m = 0; m < 4; ++m) { f32x4 qo, ko;
#pragma unroll
                        for (int jj = 0; jj < 4; ++jj) { const float q = qs[m][jj]; const float d = pf[m][jj] - ref[jj];
                            qo[jj] = q * exp2c(d); ko[jj] = kf[m][jj] * exp2c(-d); }
                        *(v2u*)(QF + ro0 + m * 16 * 128) = cpk4(qo); *(v2u*)(KF + ro0 + m * 16 * 128) = cpk4(ko); }
                    if (fr == 0) { float* d0 = DEC + ((size_t)(cg * 2 + 0) * 3) * 512 + ch0; f32x4 a, b, c;
#pragma unroll
                        for (int jj = 0; jj < 4; ++jj) { a[jj] = __builtin_amdgcn_exp2f(ref[jj]); b[jj] = __builtin_amdgcn_exp2f(tot[jj]); c[jj] = __builtin_amdgcn_exp2f(tot[jj] - ref[jj]); }
                        *(f32x4*)(d0) = a; *(f32x4*)(d0 + 512) = b; *(f32x4*)(d0 + 1024) = c; }
                }
                __builtin_amdgcn_sched_barrier(0);
                {
                    const f32x4 lb = *(const f32x4*)(LBb + ch0);
                    f32x4 pb[4], kb[4]; f32x4 off = (f32x4){0.f, 0.f, 0.f, 0.f}, half = off;
#pragma unroll
                    for (int m = 0; m < 4; ++m) {
                        if (m == 2) half = off;
#pragma unroll
                        for (int jj = 0; jj < 4; ++jj) { const float z = acc[ai][1][m][0][jj]; const float e = __builtin_amdgcn_exp2f(-1.4426950408889634f * fabsf(z)); const float r = __builtin_amdgcn_rcpf(1.f + e);
                            const float sp = z >= 0.f ? r : e * r, sm = z >= 0.f ? e * r : r; const float f = lb[jj] + (1.f - lb[jj]) * sp;
                            kb[m][jj] = (1.f - lb[jj]) * sm; const float lf = __builtin_amdgcn_logf(fmaxf(f, 1e-37f)); const float p = scan16d(lf) + off[jj]; pb[m][jj] = p - lf; off[jj] = row_last(p); }
                    }
                    const f32x4 tot = off;
                    const f32x4 ref = tot - half;
#pragma unroll
                    for (int m = 0; m < 4; ++m) { f32x4 qo, ko;
#pragma unroll
                        for (int jj = 0; jj < 4; ++jj) { const float q = qs[m][jj]; const float d = (tot[jj] - pb[m][jj]) - ref[jj];
                            qo[jj] = q * exp2c(d); ko[jj] = kb[m][jj] * exp2c(-d); }
                        *(v2u*)(QB + ro0 + m * 16 * 128) = cpk4(qo); *(v2u*)(KB + ro0 + m * 16 * 128) = cpk4(ko); }
                    if (fr == 0) { float* d1 = DEC + ((size_t)(cg * 2 + 1) * 3) * 512 + ch0; f32x4 a, b, c;
#pragma unroll
                        for (int jj = 0; jj < 4; ++jj) { a[jj] = __builtin_amdgcn_exp2f(ref[jj]); b[jj] = __builtin_amdgcn_exp2f(tot[jj]); c[jj] = __builtin_amdgcn_exp2f(tot[jj] - ref[jj]); }
                        *(f32x4*)(d1) = a; *(f32x4*)(d1 + 512) = b; *(f32x4*)(d1 + 1024) = c; }
                }
                __builtin_amdgcn_sched_barrier(0);
            }
        }
    }
    __device__ __forceinline__ void rest(const f32x4 (&acc)[2][2][4][2], const Unit& u, int wr, int wc, int fr_, int fq_) const {
        int fr = fr_, fq = fq_; asm volatile("" : "+v"(fr), "+v"(fq));
        bf16* const OG = (bf16*)(ws + Z_OG); bf16* const Y2 = (bf16*)(ws + Z_Y2); bf16* const KG = (bf16*)(ws + Z_KG); bf16* const VG = (bf16*)(ws + Z_VG);
        const float* const COS = (const float*)(ws + WS_TAB); const float* const SIN = COS + 1024;
        const int pn = u.pn;
        if (pn < 10) {
            const int c0 = (pn - 8) * BM + 32 * wc + 8 * fq;
#pragma unroll
            for (int ai = 0; ai < 2; ++ai)
#pragma unroll
                for (int m = 0; m < 4; ++m) {
                    bf16* rowp = OG + (size_t)(u.pm * BM + ai * HALF + wr * 64 + 16 * m + fr) * 512 + c0;
#pragma unroll
                    for (int bj = 0; bj < 2; ++bj) { f32x4 o[2];
#pragma unroll
                        for (int n = 0; n < 2; ++n) { const f32x4 v = acc[ai][bj][m][n];
#pragma unroll
                            for (int jj = 0; jj < 4; ++jj) o[n][jj] = siluf_(v[jj]); }
                        *(v4u*)(rowp + bj * HALF) = cpk8(o[0], o[1]); }
                }
        } else {
            const bool isq = pn < 12, isv = (!isq) && wc >= 2; const int kvh = wc & 1;
            const float* gv = isq ? qg : kg; const float osc = isq ? QC2 : 1.f;
            f32x4 gg[2][2];
#pragma unroll
            for (int bj = 0; bj < 2; ++bj)
#pragma unroll
                for (int n = 0; n < 2; ++n) gg[bj][n] = *(const f32x4*)(gv + 32 * bj + 16 * n + 4 * fq);
            const bool latent = u.pm < (TL / BM);
#pragma unroll
            for (int ai = 0; ai < 2; ++ai)
#pragma unroll
                for (int m = 0; m < 4; ++m) {
                    const int r = u.pm * BM + ai * HALF + wr * 64 + 16 * m + fr;
                    f32x4 y[2][2];
#pragma unroll
                    for (int bj = 0; bj < 2; ++bj)
#pragma unroll
                        for (int n = 0; n < 2; ++n) y[bj][n] = acc[ai][bj][m][n];
                    bf16* dst;
                    if (isq) dst = Y2 + (size_t)r * 1024 + 512 + 64 * (4 * (pn - 10) + wc) + 4 * fq;
                    else { int b, pos; if (latent) { b = r >> 12; pos = CTXL + (r & 4095); } else { const int rc = r - TL; b = rc >> 8; pos = rc & 255; }
                           dst = (isv ? VG : KG) + ((size_t)b * KVLEN + pos) * 128 + 64 * kvh + 4 * fq; }
                    if (!isv) {
                        float ss = 0.f;
#pragma unroll
                        for (int bj = 0; bj < 2; ++bj)
#pragma unroll
                            for (int n = 0; n < 2; ++n) { const f32x4 v = y[bj][n]; ss += (v[0] * v[0] + v[1] * v[1]) + (v[2] * v[2] + v[3] * v[3]); }
                        ss += shx(ss, 16, fr + 16 * fq); ss += shx(ss, 32, fr + 16 * fq);
                        const float rs = rsqrtf(ss * (1.f / 64.f) + EPSN);
#pragma unroll
                        for (int bj = 0; bj < 2; ++bj)
#pragma unroll
                            for (int n = 0; n < 2; ++n) y[bj][n] = y[bj][n] * rs * gg[bj][n];
                        if (latent) {
                            const int t = r & 4095;
#pragma unroll
                            for (int bj = 0; bj < 2; ++bj) { const int pos = bj ? (t & 63) : (t >> 6);
                                const f32x4 cs = *(const f32x4*)(COS + pos * 16 + 4 * fq), sn = *(const f32x4*)(SIN + pos * 16 + 4 * fq);
                                const f32x4 x1 = y[bj][0], x2 = y[bj][1]; y[bj][0] = x1 * cs - x2 * sn; y[bj][1] = x2 * cs + x1 * sn; }
                        }
                    }
#pragma unroll
                    for (int bj = 0; bj < 2; ++bj)
#pragma unroll
                        for (int n = 0; n < 2; ++n) *(v2u*)(dst + 32 * bj + 16 * n) = cpk4(y[bj][n] * osc);
                }
        }
    }
};
template <bool ADD> struct EpiMerge {
    static constexpr int MIDK = 0;
    bf16* MB; const bf16* SG; int goff;
    __device__ __forceinline__ void operator()(const f32x4 (&acc)[2][2][4][2], const Unit& u, int wr, int wc, int fr_, int fq_) const {
        int fr = fr_, fq = fq_; asm volatile("" : "+v"(fr), "+v"(fq));
#pragma unroll
        for (int ai = 0; ai < 2; ++ai)
#pragma unroll
            for (int m = 0; m < 4; ++m) { const size_t r = (size_t)(u.pm * BM + ai * HALF + wr * 64 + 16 * m + fr); const int c0 = u.pn * BM + 32 * wc + 4 * fq;
#pragma unroll
                for (int bj = 0; bj < 2; ++bj)
#pragma unroll
                    for (int n = 0; n < 2; ++n) { const int c = c0 + bj * HALF + 16 * n;
                        const f32x4 gte = unpk4(*(const v2u*)(SG + r * 2048 + goff + c)); f32x4 o = gte * acc[ai][bj][m][n];
                        if (ADD) o += unpk4(*(const v2u*)(MB + r * 1024 + c));
                        *(v2u*)(MB + r * 1024 + c) = cpk4(o); } }
    }
};
struct EpiGates {
    static constexpr int MIDK = 0;
    unsigned char* SG8;
    static __device__ __forceinline__ unsigned q4(f32x4 v) { unsigned r = 0; r = __builtin_amdgcn_cvt_pk_u8_f32(v[0], 0, r); r = __builtin_amdgcn_cvt_pk_u8_f32(v[1], 1, r); r = __builtin_amdgcn_cvt_pk_u8_f32(v[2], 2, r); r = __builtin_amdgcn_cvt_pk_u8_f32(v[3], 3, r); return r; }
    __device__ __forceinline__ void operator()(const f32x4 (&acc)[2][2][4][2], const Unit& u, int wr, int wc, int fr_, int fq_) const {
        int fr = fr_, fq = fq_; asm volatile("" : "+v"(fr), "+v"(fq));
        const int c0 = u.pn * HALF + 32 * wc + 8 * fq;
#pragma unroll
        for (int ai = 0; ai < 2; ++ai)
#pragma unroll
            for (int m = 0; m < 4; ++m) {
                unsigned char* rowp = SG8 + (size_t)(u.pm * BM + ai * HALF + wr * 64 + 16 * m + fr) * 2048 + c0;
                v2u oa, ob;
#pragma unroll
                for (int n = 0; n < 2; ++n) { const f32x4 za = acc[ai][0][m][n], zb = acc[ai][1][m][n]; f32x4 qa, qb;
#pragma unroll
                    for (int jj = 0; jj < 4; ++jj) {
                        qa[jj] = __builtin_amdgcn_rcpf(__builtin_fmaf(__builtin_amdgcn_exp2f(za[jj]), 1.f / 255.f, 1.f / 255.f));
                        qb[jj] = fmaxf(__builtin_amdgcn_rcpf(__builtin_fmaf(__builtin_amdgcn_exp2f(zb[jj]), 1.f / 255.f, 1.f / 255.f)), 1.f); }
                    if (n == 0) { oa.x = q4(qa); ob.x = q4(qb); } else { oa.y = q4(qa); ob.y = q4(qb); } }
                *(v2u*)(rowp) = oa; *(v2u*)(rowp + 1024) = ob;
            }
    }
};
struct EpiF8 {
    static constexpr int MIDK = 0;
    EpiGates g; EpiZ z;
    __device__ __forceinline__ void operator()(const f32x4 (&acc)[2][2][4][2], const Unit& u, int wr, int wc, int fr, int fq) const { if (u.pn < 8) g(acc, u, wr, wc, fr, fq); else z.rest(acc, u, wr, wc, fr, fq); }
};
struct EpiMergeF {
    static constexpr int MIDK = 8;
    bf16* MB; const unsigned char* SG8;
    static __device__ __forceinline__ f32x4 dec4(unsigned w) { return (f32x4){(float)(w & 0xffu), (float)((w >> 8) & 0xffu), (float)((w >> 16) & 0xffu), (float)(w >> 24)}; }
    __device__ __forceinline__ void mid(f32x4 (&acc)[2][2][4][2], const Unit& u, int wr, int wc, int fr_, int fq_) const {
        int fr = fr_, fq = fq_; asm volatile("" : "+v"(fr), "+v"(fq));
        v2u ra[2][4][2], rb[2][4][2];
#pragma unroll
        for (int ai = 0; ai < 2; ++ai)
#pragma unroll
            for (int m = 0; m < 4; ++m) { const size_t r = (size_t)(u.pm * BM + ai * HALF + wr * 64 + 16 * m + fr); const int c0 = u.pn * BM + 32 * wc + 8 * fq;
#pragma unroll
                for (int bj = 0; bj < 2; ++bj) { ra[ai][m][bj] = *(const v2u*)(SG8 + r * 2048 + c0 + bj * HALF); rb[ai][m][bj] = *(const v2u*)(SG8 + r * 2048 + 1024 + c0 + bj * HALF); } }
#pragma unroll
        for (int ai = 0; ai < 2; ++ai) {
#pragma unroll
            for (int m = 0; m < 4; ++m)
#pragma unroll
                for (int bj = 0; bj < 2; ++bj)
#pragma unroll
                    for (int n = 0; n < 2; ++n) { const f32x4 a8 = dec4(n ? ra[ai][m][bj].y : ra[ai][m][bj].x), b8 = dec4(n ? rb[ai][m][bj].y : rb[ai][m][bj].x);
#pragma unroll
                        for (int jj = 0; jj < 4; ++jj) acc[ai][bj][m][n][jj] *= a8[jj] * __builtin_amdgcn_rcpf(b8[jj]); }
            __builtin_amdgcn_sched_barrier(0);
        }
    }
    __device__ __forceinline__ void operator()(const f32x4 (&acc)[2][2][4][2], const Unit& u, int wr, int wc, int fr_, int fq_) const {
        int fr = fr_, fq = fq_; asm volatile("" : "+v"(fr), "+v"(fq));
#pragma unroll
        for (int ai = 0; ai < 2; ++ai)
#pragma unroll
            for (int m = 0; m < 4; ++m) { const size_t r = (size_t)(u.pm * BM + ai * HALF + wr * 64 + 16 * m + fr); const int c0 = u.pn * BM + 32 * wc + 8 * fq;
#pragma unroll
                for (int bj = 0; bj < 2; ++bj) { const int c = c0 + bj * HALF;
                    const v2u zw = *(const v2u*)(SG8 + r * 2048 + 1024 + c);
                    *(v4u*)(MB + r * 1024 + c) = cpk8(dec4(zw.x) * (1.f / 255.f) * acc[ai][bj][m][0], dec4(zw.y) * (1.f / 255.f) * acc[ai][bj][m][1]); } }
    }
};
struct EpiOut {
    static constexpr int MIDK = 0;
    bf16* hw; const bf16* hr; const float* modl;
    const float* sl; const float* sc;
    bool first;
    __device__ __forceinline__ void operator()(const f32x4 (&acc)[2][2][4][2], const Unit& u, int wr, int wc, int fr_, int fq_) const {
        int fr = fr_, fq = fq_; asm volatile("" : "+v"(fr), "+v"(fq));
        const bool latent = u.pm < (TL / BM); const int brow = latent ? (u.pm >> 4) : 16;
        const float* g1 = modl + (size_t)brow * 6144 + 2048;
        const int c0 = u.pn * BM + 32 * wc + 8 * fq;
        const size_t r0 = (size_t)u.pm * BM + wr * 64 + fr;
        if (first) {
            const float* sb_ = latent ? sl + (size_t)u.pm * BM * 1024 : sc + (size_t)(u.pm - TL / BM) * BM * 1024;
#pragma unroll
            for (int ai = 0; ai < 2; ++ai)
#pragma unroll
                for (int m = 0; m < 4; ++m) { const float* rows = sb_ + (size_t)(ai * HALF + wr * 64 + 16 * m + fr) * 1024; bf16* rowp = hw + (r0 + ai * HALF + 16 * m) * 1024;
#pragma unroll
                    for (int bj = 0; bj < 2; ++bj) { const int c = c0 + bj * HALF;
                        const f32x4 h0 = *(const f32x4*)(rows + c) + *(const f32x4*)(g1 + c) * acc[ai][bj][m][0], h1 = *(const f32x4*)(rows + c + 4) + *(const f32x4*)(g1 + c + 4) * acc[ai][bj][m][1];
                        *(v4u*)(rowp + c) = cpk8(h0, h1); } }
        } else {
#pragma unroll
            for (int ai = 0; ai < 2; ++ai)
#pragma unroll
                for (int m = 0; m < 4; ++m) { const size_t ro = (r0 + ai * HALF + 16 * m) * 1024;
#pragma unroll
                    for (int bj = 0; bj < 2; ++bj) { const int c = c0 + bj * HALF; const v4u hv = *(const v4u*)(hr + ro + c);
                        const f32x4 h0 = unlo4(hv) + *(const f32x4*)(g1 + c) * acc[ai][bj][m][0], h1 = unhi4(hv) + *(const f32x4*)(g1 + c + 4) * acc[ai][bj][m][1];
                        *(v4u*)(hw + ro + c) = cpk8(h0, h1); } }
        }
    }
};
struct EpiSwiGLU {
    static constexpr int MIDK = 0;
    unsigned char* H;
    __device__ __forceinline__ void operator()(const f32x4 (&acc)[2][2][4][2], const Unit& u, int wr, int wc, int fr_, int fq_) const {
        int fr = fr_, fq = fq_; asm volatile("" : "+v"(fr), "+v"(fq));
#pragma unroll
        for (int ai = 0; ai < 2; ++ai)
#pragma unroll
            for (int m = 0; m < 4; ++m) { unsigned char* rowp = H + (size_t)(u.pm * BM + ai * HALF + wr * 64 + 16 * m + fr) * 512 + 128 * u.pn + 32 * wc + 8 * fq;
                v2u w8;
#pragma unroll
                for (int n = 0; n < 2; ++n) { const f32x4 gt = acc[ai][0][m][n], up = acc[ai][1][m][n]; f32x4 o;
#pragma unroll
                    for (int jj = 0; jj < 4; ++jj) o[jj] = siluf_(gt[jj]) * up[jj];
                    int r = 0; r = __builtin_amdgcn_cvt_pk_fp8_f32(o[0], o[1], r, false); r = __builtin_amdgcn_cvt_pk_fp8_f32(o[2], o[3], r, true);
                    if (n == 0) w8.x = (unsigned)r; else w8.y = (unsigned)r; }
                *(v2u*)(rowp) = w8; }
    }
};
struct EpiDown {
    static constexpr int MIDK = 0;
    unsigned char* YB; const float* roww;
    __device__ __forceinline__ void operator()(const f32x4 (&acc)[2][2][4][2], const Unit& u, int wr, int wc, int fr_, int fq_) const {
        int fr = fr_, fq = fq_; asm volatile("" : "+v"(fr), "+v"(fq));
#pragma unroll
        for (int ai = 0; ai < 2; ++ai)
#pragma unroll
            for (int m = 0; m < 4; ++m) { const size_t r = (size_t)(u.pm * BM + ai * HALF + wr * 64 + 16 * m + fr); const float w = 16.f;
                unsigned char* rowp = YB + r * 1024 + u.pn * BM + 32 * wc + 8 * fq;
#pragma unroll
                for (int bj = 0; bj < 2; ++bj) { const f32x4 a = acc[ai][bj][m][0] * w, b = acc[ai][bj][m][1] * w; v2u o;
                    int r0 = 0; r0 = __builtin_amdgcn_cvt_pk_fp8_f32(a[0], a[1], r0, false); r0 = __builtin_amdgcn_cvt_pk_fp8_f32(a[2], a[3], r0, true);
                    int r1 = 0; r1 = __builtin_amdgcn_cvt_pk_fp8_f32(b[0], b[1], r1, false); r1 = __builtin_amdgcn_cvt_pk_fp8_f32(b[2], b[3], r1, true);
                    o.x = (unsigned)r0; o.y = (unsigned)r1; *(v2u*)(rowp + bj * HALF) = o; } }
    }
};
}
#include <hip/hip_bf16.h>
#include <cmath>
namespace attn_body {
using bf16=__hip_bfloat16;
using bf16x8=__attribute__((ext_vector_type(8)))short;
using s16x4=__attribute__((ext_vector_type(4)))short;
using f32x16=__attribute__((ext_vector_type(16)))float;
using u32x4=__attribute__((ext_vector_type(4)))unsigned;
constexpr int D=64,QP=1024,KP=128;
constexpr int NW=8,QBLK=32,QB=QBLK*NW,KVBLK=64;
constexpr int ATTN_UNIT_ROWS=QB;
__device__ __forceinline__ int crow(int r,int hi){return (r&3)+8*(r>>2)+4*hi;}
#define SBAR() __builtin_amdgcn_sched_barrier(0)

constexpr int NSLOT=3, SLOTB=8192;
constexpr int LDS_K=0, LDS_V=NSLOT*SLOTB, LDS_WS=2*NSLOT*SLOTB, LDS_OST=LDS_WS+NW*64*4, LDS_BYTES=LDS_OST+NW*4096;
constexpr float C2=0.125f*1.4426950408889634f;
__device__ __forceinline__ void glds16(const void*gsrc,unsigned lds_dst){unsigned keep;
  asm volatile("s_mov_b32 %0, m0\n\ts_mov_b32 m0, %2\n\ts_nop 0\n\tglobal_load_lds_dwordx4 %1, off\n\ts_mov_b32 m0, %0":"=&s"(keep):"v"(gsrc),"s"(lds_dst):"memory");}
__device__ __forceinline__ float max3f(float a,float b,float c){float r;asm("v_max3_f32 %0, %1, %2, %3":"=v"(r):"v"(a),"v"(b),"v"(c));return r;}
__device__ __forceinline__ float max2f(float a,float b){float r;asm("v_max_f32_e32 %0, %1, %2":"=v"(r):"v"(a),"v"(b));return r;}
__device__ __forceinline__ float fadd_s(float a,float b){float r;asm("v_add_f32_e32 %0, %1, %2":"=v"(r):"v"(a),"v"(b));return r;}
__device__ __forceinline__ float fsub_s(float a,float b){float r;asm("v_sub_f32_e32 %0, %1, %2":"=v"(r):"v"(a),"v"(b));return r;}
typedef float f32x2_t __attribute__((ext_vector_type(2))); typedef __bf16 bf16x2_t __attribute__((ext_vector_type(2)));
__device__ __forceinline__ unsigned cvtpk_s(float lo,float hi){f32x2_t v={lo,hi};bf16x2_t b=__builtin_convertvector(v,bf16x2_t);return __builtin_bit_cast(unsigned,b);}
#define WAIT_BAR(N) asm volatile("s_waitcnt vmcnt(" #N ") lgkmcnt(0)\n\ts_barrier":::"memory")

__device__ __forceinline__ void qkt(f32x16&p0,f32x16&p1,const char*Kslot,const bf16x8*qr,const f32x16&negm,int r32,int hi){
  const char*kb=Kslot+hi*1024+r32*16;
  #pragma unroll
  for(int d0=0;d0<4;++d0){
    const bf16x8 b0=*reinterpret_cast<const bf16x8*>(kb+d0*2048);
    const bf16x8 b1=*reinterpret_cast<const bf16x8*>(kb+d0*2048+512);
    if(d0==0){p0=__builtin_amdgcn_mfma_f32_32x32x16_bf16(b0,qr[0],negm,0,0,0);p1=__builtin_amdgcn_mfma_f32_32x32x16_bf16(b1,qr[0],negm,0,0,0);}
    else{p0=__builtin_amdgcn_mfma_f32_32x32x16_bf16(b0,qr[d0],p0,0,0,0);p1=__builtin_amdgcn_mfma_f32_32x32x16_bf16(b1,qr[d0],p1,0,0,0);}}
}
typedef __attribute__((address_space(3))) const char* lds_cptr;
typedef short v4i16_t __attribute__((ext_vector_type(4)));
__device__ __forceinline__ void kload8(bf16x8*kf,lds_cptr kp){
  kf[0]=*(const __attribute__((address_space(3))) bf16x8*)(kp);      kf[1]=*(const __attribute__((address_space(3))) bf16x8*)(kp+512);
  kf[2]=*(const __attribute__((address_space(3))) bf16x8*)(kp+2048); kf[3]=*(const __attribute__((address_space(3))) bf16x8*)(kp+2560);
  kf[4]=*(const __attribute__((address_space(3))) bf16x8*)(kp+4096); kf[5]=*(const __attribute__((address_space(3))) bf16x8*)(kp+4608);
  kf[6]=*(const __attribute__((address_space(3))) bf16x8*)(kp+6144); kf[7]=*(const __attribute__((address_space(3))) bf16x8*)(kp+6656);
}
__device__ __forceinline__ void kload2(bf16x8*kf,lds_cptr kp,int j){ kf[2*j]=*(const __attribute__((address_space(3))) bf16x8*)(kp+j*2048); kf[2*j+1]=*(const __attribute__((address_space(3))) bf16x8*)(kp+j*2048+512); }
__device__ __forceinline__ s16x4 vtr(lds_cptr p){ return __builtin_bit_cast(s16x4,__builtin_amdgcn_ds_read_tr16_b64_v4i16((__attribute__((address_space(3))) v4i16_t*)p)); }
__device__ __forceinline__ float rowmax(const f32x16&p0,const f32x16&p1){
  float a=max3f(p0[0],p0[1],p1[0]),b=max3f(p0[2],p0[3],p1[1]);a=max3f(a,p1[2],p1[3]);
  #pragma unroll
  for(int r=4;r<16;r+=4){a=max3f(a,p0[r],p0[r+1]);b=max3f(b,p0[r+2],p0[r+3]);a=max3f(a,p1[r],p1[r+1]);b=max3f(b,p1[r+2],p1[r+3]);}
  const float m=max2f(a,b);
  auto rr=__builtin_amdgcn_permlane32_swap(__float_as_uint(m),__float_as_uint(m),false,false);
  return max2f(__uint_as_float(rr[0]),__uint_as_float(rr[1]));
}
__device__ __forceinline__ void pv(f32x16*o,int vb,bf16x8 pa0,bf16x8 pa1,bf16x8 pa2,bf16x8 pa3){
  #pragma unroll
  for(int d0=0;d0<2;++d0){s16x4 lo[4],hi[4];
    #pragma unroll
    for(int ks=0;ks<4;++ks){
      asm volatile("ds_read_b64_tr_b16 %0,%1 offset:%c2":"=&v"(lo[ks]):"v"(vb),"i"(d0*4096+ks*1024):"memory");
      asm volatile("ds_read_b64_tr_b16 %0,%1 offset:%c2":"=&v"(hi[ks]):"v"(vb),"i"(d0*4096+ks*1024+512):"memory");}
    asm volatile("s_waitcnt lgkmcnt(0)":::"memory");SBAR();
    #define PK(k) (bf16x8){lo[k][0],lo[k][1],lo[k][2],lo[k][3],hi[k][0],hi[k][1],hi[k][2],hi[k][3]}
    o[d0]=__builtin_amdgcn_mfma_f32_32x32x16_bf16(pa0,PK(0),o[d0],0,0,0);
    o[d0]=__builtin_amdgcn_mfma_f32_32x32x16_bf16(pa1,PK(1),o[d0],0,0,0);
    o[d0]=__builtin_amdgcn_mfma_f32_32x32x16_bf16(pa2,PK(2),o[d0],0,0,0);
    o[d0]=__builtin_amdgcn_mfma_f32_32x32x16_bf16(pa3,PK(3),o[d0],0,0,0);
    #undef PK
  }
}

#ifndef ATTN_STORE16
#define ATTN_STORE16(p,v) (*(u32x4*)(p)=(v))
#endif
template<int THRL,bool NOMAX> __device__ __forceinline__ void attn_unit(const bf16*Qb,const bf16*__restrict__ Kh,const bf16*__restrict__ Vh,bf16*Ob,const int NT,char*shm){
  int tid_=threadIdx.x; asm volatile("":"+v"(tid_));
  const int tid=tid_,lane=tid&63,r32=lane&31,hi=lane>>5; const int wid=__builtin_amdgcn_readfirstlane(tid>>6);
  const bf16*Qw=Qb+(long)(wid*QBLK)*QP;
  const unsigned lds0=(unsigned)(uintptr_t)shm;
  float*wsf=(float*)(shm+LDS_WS)+wid*64;
  const bf16*ksrc=Kh+(long)lane*KP+wid*8;
  const bf16*vsrc=Vh+(long)(16*(wid&3)+(lane>>2))*KP+(wid>>2)*32+(lane&3)*8;
  const unsigned kdst=lds0+LDS_K+wid*1024, vdst=lds0+LDS_V+wid*1024;
  #define DMA_K(t,slot) glds16(ksrc+(long)(t)*KVBLK*KP,(unsigned)__builtin_amdgcn_readfirstlane(kdst+(slot)))
  #define DMA_V(t,slot) glds16(vsrc+(long)(t)*KVBLK*KP,(unsigned)__builtin_amdgcn_readfirstlane(vdst+(slot)))
  const int vb0=(int)(lds0+LDS_V)+((lane>>4)&1)*32+(lane&3)*8+(4*hi+((lane&15)>>2))*64;
  const char*Kbase=shm+LDS_K; bf16x8 kf[8];
  const lds_cptr shm3=(lds_cptr)shm; const lds_cptr kp0=shm3+LDS_K+hi*1024+r32*16; const lds_cptr vp0=shm3+LDS_V+((lane>>4)&1)*32+(lane&3)*8+(4*hi+((lane&15)>>2))*64;
  DMA_K(0,0);DMA_V(0,0);DMA_K(1,SLOTB);
  bf16x8 qr[4];
  #pragma unroll
  for(int d0=0;d0<4;++d0)qr[d0]=*reinterpret_cast<const bf16x8*>(&Qw[(long)r32*QP+d0*16+hi*8]);
  float mhat=0.f,l_reg=0.f;f32x16 o[2];o[0]=f32x16{};o[1]=f32x16{};f32x16 negm=f32x16{};asm volatile("":"+v"(negm));
  #define CMASK(P0,P1,t) do{}while(0)
  bool resc=false;
  #define START(P0,P1) do{ resc=false; \
    if constexpr(!NOMAX){ const float rm=rowmax(P0,P1); const float dl=rm; mhat=fadd_s(mhat,dl); \
      _Pragma("unroll") for(int r=0;r<16;++r){P0[r]=fsub_s(P0[r],dl);P1[r]=fsub_s(P1[r],dl);} \
      _Pragma("unroll") for(int r=0;r<16;++r)negm[r]=-mhat; asm volatile("":"+v"(negm)); } \
    _Pragma("unroll") for(int r=0;r<16;++r)P0[r]=__builtin_amdgcn_exp2f(P0[r]); }while(0)
  #define RESC() do{ if(resc){ asm volatile("s_waitcnt lgkmcnt(0)":::"memory"); \
      _Pragma("unroll") for(int d_=0;d_<2;++d_) _Pragma("unroll") for(int r=0;r<16;++r)o[d_][r]*=wsf[crow(r,hi)]; } }while(0)
  f32x16 pA0,pA1,pB0,pB1;
  int sl_prev=0,sl_cur=0,sl_next=SLOTB;
  #define ROT() do{sl_prev=sl_cur;sl_cur=sl_next;sl_next=(sl_next==(NSLOT-1)*SLOTB)?0:sl_next+SLOTB;}while(0)
  DMA_K(2,2*SLOTB);
  WAIT_BAR(3);
  qkt(pA0,pA1,Kbase,qr,negm,r32,hi);asm volatile("s_nop 15\n\ts_nop 7":"+v"(pA0),"+v"(pA1));CMASK(pA0,pA1,0);
  START(pA0,pA1);
  _Pragma("unroll") for(int r=0;r<16;++r)pA1[r]=__builtin_amdgcn_exp2f(pA1[r]);
  WAIT_BAR(0);
  DMA_K(3,0);DMA_V(1,SLOTB);
  ROT();
  kload8(kf,kp0+sl_cur);
  WAIT_BAR(2);
  s16x4 vlo[8],vhi[8]; u32x4 pw0,pw1,pw2,pw3;
  #define PKW(P,B) cvtpk_s(P[B],P[B+1])
  #define PAF(k) __builtin_bit_cast(bf16x8,pw##k)
  #define VFR(i) (bf16x8){vlo[i][0],vlo[i][1],vlo[i][2],vlo[i][3],vhi[i][0],vhi[i][1],vhi[i][2],vhi[i][3]}
  #define PIN(x) asm volatile("":"+v"(x))
  #define MX3(a,b,c) __builtin_fmaxf(__builtin_fmaxf((a),(b)),(c))
  #define GAPA(MF,A0,A1,A2,A3,W0,W1,PW) do{ MF; sacc+=A0; sacc+=A1; sacc+=A2; sacc+=A3; PIN(sacc); W0; W1; PIN(PW); SBAR(); }while(0)
  #define EX(v) __builtin_amdgcn_exp2f(v)
  #define GAPB(MF,X,B) do{ MF; X[B]=EX(X[B]); X[B+1]=EX(X[B+1]); X[B+2]=EX(X[B+2]); X[B+3]=EX(X[B+3]); PIN(X); SBAR(); }while(0)
  #define VRD(i) do{ vlo[i]=vtr(vp_+(((i)>>2)*4096+((i)&3)*1024)); vhi[i]=vtr(vp_+(((i)>>2)*4096+((i)&3)*1024+512)); }while(0)
  #define KRD(G,j) do{ if(G){ kload2(kf,kp0+sl_next,j); SBAR(); } }while(0)
  #define STEP(C0,C1,P0,P1,t,GK,GV,GL) do{ SBAR(); \
    const lds_cptr vp_=vp0+sl_prev; \
    VRD(0); SBAR(); float sacc=(P0[0]+P0[1]); \
    GAPA(C0=__builtin_amdgcn_mfma_f32_32x32x16_bf16(kf[0],qr[0],negm,0,0,0), P0[2],P0[3],P0[4],P0[5],     pw0[0]=PKW(P0,0), pw0[1]=PKW(P0,2), pw0); \
    VRD(4); SBAR(); GAPA(C1=__builtin_amdgcn_mfma_f32_32x32x16_bf16(kf[1],qr[0],negm,0,0,0), P0[6],P0[7],P0[8],P0[9],     pw0[2]=PKW(P0,4), pw0[3]=PKW(P0,6), pw0); \
    VRD(1); SBAR(); GAPA(C0=__builtin_amdgcn_mfma_f32_32x32x16_bf16(kf[2],qr[1],C0,0,0,0),   P0[10],P0[11],P0[12],P0[13], pw1[0]=PKW(P0,8), pw1[1]=PKW(P0,10), pw1); \
    VRD(5); SBAR(); GAPA(C1=__builtin_amdgcn_mfma_f32_32x32x16_bf16(kf[3],qr[1],C1,0,0,0),   P0[14],P0[15],P1[0],P1[1],   pw1[2]=PKW(P0,12),pw1[3]=PKW(P0,14), pw1); \
    VRD(2); SBAR(); GAPA(C0=__builtin_amdgcn_mfma_f32_32x32x16_bf16(kf[4],qr[2],C0,0,0,0),   P1[2],P1[3],P1[4],P1[5],     pw2[0]=PKW(P1,0), pw2[1]=PKW(P1,2), pw2); \
    VRD(6); SBAR(); GAPA(C1=__builtin_amdgcn_mfma_f32_32x32x16_bf16(kf[5],qr[2],C1,0,0,0),   P1[6],P1[7],P1[8],P1[9],     pw2[2]=PKW(P1,4), pw2[3]=PKW(P1,6), pw2); \
    VRD(3); SBAR(); GAPA(C0=__builtin_amdgcn_mfma_f32_32x32x16_bf16(kf[6],qr[3],C0,0,0,0),   P1[10],P1[11],P1[12],P1[13], pw3[0]=PKW(P1,8), pw3[1]=PKW(P1,10), pw3); \
    VRD(7); SBAR(); GAPA(C1=__builtin_amdgcn_mfma_f32_32x32x16_bf16(kf[7],qr[3],C1,0,0,0),   P1[14],P1[15],0.f,0.f,       pw3[2]=PKW(P1,12),pw3[3]=PKW(P1,14), pw3); \
    l_reg+=sacc; \
    if(GK){DMA_K((t)+3,sl_cur);} if(GV){DMA_V((t)+1,sl_next);} \
    CMASK(C0,C1,t); \
    resc=false; \
    if constexpr(!NOMAX){ float a=MX3(C0[0],C0[1],C1[0]),b=MX3(C0[2],C0[3],C1[1]); a=MX3(a,C1[2],C1[3]); \
      _Pragma("unroll") for(int r=4;r<16;r+=4){a=MX3(a,C0[r],C0[r+1]);b=MX3(b,C0[r+2],C0[r+3]);a=MX3(a,C1[r],C1[r+1]);b=MX3(b,C1[r+2],C1[r+3]);} \
      float rm=__builtin_fmaxf(a,b); { auto rr=__builtin_amdgcn_permlane32_swap(__float_as_uint(rm),__float_as_uint(rm),false,false); rm=__builtin_fmaxf(__uint_as_float(rr[0]),__uint_as_float(rr[1])); } \
      if(__builtin_expect(__any(rm>(float)THRL),0)){ const float dl=__builtin_fmaxf(rm,0.f); mhat+=dl; \
        _Pragma("unroll") for(int r=0;r<16;++r){C0[r]-=dl;C1[r]-=dl;} \
        _Pragma("unroll") for(int r=0;r<16;++r)negm[r]=-mhat; asm volatile("":"+v"(negm)); \
        const float f=__builtin_amdgcn_exp2f(-dl); l_reg*=f; if(hi==0)wsf[r32]=f; resc=true; } } \
    SBAR(); \
    GAPB(o[0]=__builtin_amdgcn_mfma_f32_32x32x16_bf16(PAF(0),VFR(0),o[0],0,0,0), C0,0); \
    GAPB(o[1]=__builtin_amdgcn_mfma_f32_32x32x16_bf16(PAF(0),VFR(4),o[1],0,0,0), C0,4); \
    KRD(GL,0); GAPB(o[0]=__builtin_amdgcn_mfma_f32_32x32x16_bf16(PAF(1),VFR(1),o[0],0,0,0), C0,8); \
    KRD(GL,1); GAPB(o[1]=__builtin_amdgcn_mfma_f32_32x32x16_bf16(PAF(1),VFR(5),o[1],0,0,0), C0,12); \
    KRD(GL,2); GAPB(o[0]=__builtin_amdgcn_mfma_f32_32x32x16_bf16(PAF(2),VFR(2),o[0],0,0,0), C1,0); \
    KRD(GL,3); GAPB(o[1]=__builtin_amdgcn_mfma_f32_32x32x16_bf16(PAF(2),VFR(6),o[1],0,0,0), C1,4); \
    GAPB(o[0]=__builtin_amdgcn_mfma_f32_32x32x16_bf16(PAF(3),VFR(3),o[0],0,0,0), C1,8); \
    GAPB(o[1]=__builtin_amdgcn_mfma_f32_32x32x16_bf16(PAF(3),VFR(7),o[1],0,0,0), C1,12); \
    }while(0)
  int t=1;
  #undef CMASK
  #define CMASK(P0,P1,t) do{}while(0)
  for(;t+5<NT;t+=2){
    STEP(pB0,pB1,pA0,pA1,t,true,true,true);     WAIT_BAR(2); RESC(); ROT();
    STEP(pA0,pA1,pB0,pB1,t+1,true,true,true);   WAIT_BAR(2); RESC(); ROT();
  }
  #undef CMASK
  #define CMASK(P0,P1,t) do{}while(0)
  #define ENDW(tt) do{ if((tt)+3<NT){WAIT_BAR(2);} else if((tt)+2<NT){WAIT_BAR(1);} else {WAIT_BAR(0);} }while(0)
  for(;t+1<NT;t+=2){
    STEP(pB0,pB1,pA0,pA1,t,(t+3<NT),(t+1<NT),(t+1<NT));       ENDW(t);   RESC(); ROT();
    STEP(pA0,pA1,pB0,pB1,t+1,(t+4<NT),(t+2<NT),(t+2<NT));     ENDW(t+1); RESC(); ROT();
  }
  STEP(pB0,pB1,pA0,pA1,NT-1,false,false,false); RESC();
  { float sacc=pB0[0]+pB0[1]; _Pragma("unroll") for(int r=2;r<16;++r)sacc+=pB0[r]; _Pragma("unroll") for(int r=0;r<16;++r)sacc+=pB1[r]; l_reg+=sacc;
    pw0=(u32x4){PKW(pB0,0),PKW(pB0,2),PKW(pB0,4),PKW(pB0,6)};pw1=(u32x4){PKW(pB0,8),PKW(pB0,10),PKW(pB0,12),PKW(pB0,14)};pw2=(u32x4){PKW(pB1,0),PKW(pB1,2),PKW(pB1,4),PKW(pB1,6)};pw3=(u32x4){PKW(pB1,8),PKW(pB1,10),PKW(pB1,12),PKW(pB1,14)};
    SBAR(); pv(o,vb0+sl_cur,PAF(0),PAF(1),PAF(2),PAF(3)); }
  #undef PKW
  #undef PAF
  #undef VFR
  #undef PIN
  #undef MX3
  #undef GAPA
  #undef GAPB
  #undef EX
  #undef VRD
  #undef KRD
  #undef STEP
  #undef ENDW
  {auto rr=__builtin_amdgcn_permlane32_swap(__float_as_uint(l_reg),__float_as_uint(l_reg),false,false);l_reg=__uint_as_float(rr[0])+__uint_as_float(rr[1]);}
  if(hi==0)wsf[32+r32]=l_reg;asm volatile("s_waitcnt lgkmcnt(0)":::"memory");
  float rli[16];
  #pragma unroll
  for(int r=0;r<16;++r)rli[r]=__builtin_amdgcn_rcpf(wsf[32+crow(r,hi)]);
  bf16*Ow=Ob+(long)(wid*QBLK)*QP;
  { bf16*stg=(bf16*)(shm+LDS_OST)+wid*2048;
    #pragma unroll
    for(int r=0;r<16;++r){const int orow=crow(r,hi);
      #pragma unroll
      for(int d0=0;d0<2;++d0)stg[orow*64+d0*32+r32]=__float2bfloat16(o[d0][r]*rli[r]);}
    asm volatile("s_waitcnt lgkmcnt(0)":::"memory");
    #pragma unroll
    for(int i=0;i<4;++i){const int row=i*8+(lane>>3),ch=lane&7; const u32x4 v=*(const u32x4*)(stg+row*64+ch*8); ATTN_STORE16(Ow+(long)row*QP+ch*8,v);} }
  asm volatile("s_waitcnt lgkmcnt(0)\n\ts_barrier":::"memory");
  #undef DMA_K
  #undef DMA_V
  #undef CMASK
  #undef START
  #undef RESC
  #undef ROT
}
constexpr int ATTN_LDS_BYTES=LDS_BYTES;
#undef SBAR
#undef WAIT_BAR
}
#define XB_TMO      128
#define XB_XCNT(j)  (256  + 64 * (j))
#define XB_XSUB(j)  (1280 + 64 * (j))
#define XB_XGEN(j)  (2304 + 64 * (j))
#define XB_TOP      3328
#define XB_TOPGEN   3392
#define XCD_BAR_WORDS 3456
#define XB_SPIN_CAP (1u << 18)

__device__ __forceinline__ unsigned xb_ld(unsigned* p)              { return __hip_atomic_load(p, __ATOMIC_RELAXED, __HIP_MEMORY_SCOPE_AGENT); }
__device__ __forceinline__ unsigned xb_add(unsigned* p, unsigned v) { return __hip_atomic_fetch_add(p, v, __ATOMIC_RELAXED, __HIP_MEMORY_SCOPE_AGENT); }
__device__ __forceinline__ unsigned xb_xcc_id() { return (unsigned)__builtin_amdgcn_s_getreg((3 << 11) | 20) & 0xFu; }
#define XB_SPIN(cond, bar) do { unsigned _sp = 0; while (cond) { __builtin_amdgcn_s_sleep(1); \
    if ((++_sp & 255u) == 0u) { if (xb_ld(&(bar)[XB_TMO])) break; if (_sp > XB_SPIN_CAP) { atomicAdd(&(bar)[XB_TMO], 1u); break; } } } } while (0)

struct XcdBarrier {
    unsigned* bar; unsigned x;
    volatile LAS unsigned* st;
};

__device__ __forceinline__ XcdBarrier xcd_barrier_post(unsigned* bar, volatile LAS unsigned* st) {
    XcdBarrier b; b.bar = bar; b.x = xb_xcc_id(); b.st = st;
    if (threadIdx.x == 0) (void)xb_add(&bar[XB_XCNT(b.x)], 1u);
    return b;
}
__device__ __forceinline__ void xcd_barrier_complete(unsigned* bar, unsigned x, unsigned& nloc, unsigned& nx) {
    const unsigned G = gridDim.x * gridDim.y * gridDim.z;
    unsigned sum, cnt, mine, sp = 0u;
    for (;;) {
        sum = 0u; cnt = 0u; mine = 0u;
#pragma unroll
        for (unsigned j = 0; j < 16; ++j) { const unsigned c = xb_ld(&bar[XB_XCNT(j)]); sum += c; cnt += (c > 0u) ? 1u : 0u; mine = (j == x) ? c : mine; }
        if (sum == G) break;
        __builtin_amdgcn_s_sleep(1);
        if ((++sp & 255u) == 0u) { if (xb_ld(&bar[XB_TMO])) break; if (sp > XB_SPIN_CAP) { atomicAdd(&bar[XB_TMO], 1u); break; } }
    }
    nloc = mine > 0u ? mine : 1u; nx = cnt > 0u ? cnt : 1u;
}

__device__ __forceinline__ void xcd_barrier(const XcdBarrier& b) {
    asm volatile("s_waitcnt vmcnt(0)" ::: "memory");
    __syncthreads();
    if (threadIdx.x == 0) {
        unsigned* bar = b.bar;
        __builtin_amdgcn_s_waitcnt(0);
        unsigned nloc = b.st[0], nx = b.st[1];
        if (nloc == 0u) { xcd_barrier_complete(bar, b.x, nloc, nx); b.st[0] = nloc; b.st[1] = nx; }
        const unsigned old = xb_add(&bar[XB_XSUB(b.x)], 1u);
        const unsigned gen = old / nloc;
        if (old + 1u == (gen + 1u) * nloc) {
            __builtin_amdgcn_fence(__ATOMIC_RELEASE, "agent");
            asm volatile("s_waitcnt vmcnt(0)" ::: "memory");
            const unsigned og = xb_add(&bar[XB_TOP], 1u);
            const unsigned tg = og / nx;
            if (og + 1u == (tg + 1u) * nx) xb_add(&bar[XB_TOPGEN], 1u);
            else XB_SPIN(xb_ld(&bar[XB_TOPGEN]) == tg, bar);
            __builtin_amdgcn_fence(__ATOMIC_ACQUIRE, "agent");
            xb_add(&bar[XB_XGEN(b.x)], 1u);
            asm volatile("s_waitcnt vmcnt(0)" ::: "memory");
        } else {
            XB_SPIN(xb_ld(&bar[XB_XGEN(b.x)]) == gen, bar);
            __builtin_amdgcn_fence(__ATOMIC_ACQUIRE, "agent");
            asm volatile("s_waitcnt vmcnt(0)" ::: "memory");
        }
    }
    __syncthreads();
}


struct Frame {
    LAS unsigned char* lds;
    volatile LAS unsigned* MISC;
    gu32* ctl;
    int tid, lane, wave, G, bx;
    float* out; unsigned char* ws;
};
__device__ __forceinline__ const float* inptr(const Frame& F, int i) {
    const LAS unsigned* t = (const LAS unsigned*)(F.lds + PTRS_OFF) + 2 * i;
    const unsigned lo = __builtin_amdgcn_readfirstlane(t[0]), hi = __builtin_amdgcn_readfirstlane(t[1]);
    return (const float*)(((unsigned long long)hi << 32) | lo);
}
#define INP(i) inptr(F, (i))
#define PHASE_FRAME(F0) Frame F = (F0); { int t_ = F.tid; asm volatile("" : "+v"(t_)); F.tid = t_; F.lane = t_ & 63; F.wave = __builtin_amdgcn_readfirstlane(t_ >> 6); }
enum { I_X = 0, I_C, I_CTX, I_CCTX, I_WADA, I_BADA, I_N1G, I_N2G, I_WIN, I_LBL, I_HNG, I_QNG, I_KNG, I_WUA, I_WUB, I_WOUT, I_WRG, I_BRG, I_WRE, I_BRE, I_WG, I_WU, I_WD, I_FNG };

template <class RowMap> __device__ __forceinline__ void transpose_item(const float* W, int N, bf16* WT, int ldk, int koff, LAS float* scr, int kb, int nb, int lane, RowMap rm) {
    const int k0 = 64 * kb, n0 = 32 * nb;
    float tv[32];
#pragma unroll
    for (int i = 0; i < 32; ++i) tv[i] = W[(size_t)(k0 + 2 * i + (lane >> 5)) * N + n0 + (lane & 31)];
#pragma unroll
    for (int i = 0; i < 32; ++i) scr[(2 * i + (lane >> 5)) * 33 + (lane & 31)] = tv[i];
    LDS_WAIT(); asm volatile("" ::: "memory");
    const int c = lane & 7;
#pragma unroll
    for (int j = 0; j < 4; ++j) { const int n = (lane >> 3) + 8 * j; const LAS float* s = scr + (8 * c) * 33 + n;
        v4u o; o.x = pk2(s[0 * 33], s[1 * 33]); o.y = pk2(s[2 * 33], s[3 * 33]); o.z = pk2(s[4 * 33], s[5 * 33]); o.w = pk2(s[6 * 33], s[7 * 33]);
        *(GAS v4u*)(WT + (size_t)rm(n0 + n) * ldk + koff + k0 + 8 * c) = o; }
    LDS_WAIT(); asm volatile("" ::: "memory");
}
__device__ __forceinline__ unsigned pk4_f8(float a, float b, float c, float d) { int r = 0; r = __builtin_amdgcn_cvt_pk_fp8_f32(a, b, r, false); r = __builtin_amdgcn_cvt_pk_fp8_f32(c, d, r, true); return (unsigned)r; }
template <class RowMap> __device__ __forceinline__ void transpose_item_f8(const float* W, int N, unsigned char* WT8, int ldk, int koff, LAS float* scr, int kb, int nb, int lane, RowMap rm, float mul) {
    const int k0 = 64 * kb, n0 = 32 * nb;
    float tv[32];
#pragma unroll
    for (int i = 0; i < 32; ++i) tv[i] = W[(size_t)(k0 + 2 * i + (lane >> 5)) * N + n0 + (lane & 31)];
#pragma unroll
    for (int i = 0; i < 32; ++i) scr[(2 * i + (lane >> 5)) * 33 + (lane & 31)] = tv[i] * mul;
    LDS_WAIT(); asm volatile("" ::: "memory");
    const int c = lane & 7;
#pragma unroll
    for (int j = 0; j < 4; ++j) { const int n = (lane >> 3) + 8 * j; const LAS float* s = scr + (8 * c) * 33 + n;
        v2u o; o.x = pk4_f8(s[0 * 33], s[1 * 33], s[2 * 33], s[3 * 33]); o.y = pk4_f8(s[4 * 33], s[5 * 33], s[6 * 33], s[7 * 33]);
        *(GAS v2u*)(WT8 + (size_t)rm(n0 + n) * ldk + koff + k0 + 8 * c) = o; }
    LDS_WAIT(); asm volatile("" ::: "memory");
}
__device__ __forceinline__ int pperm(int c) { return (c & ~31) | (((c >> 2) & 1) << 4) | (((c >> 3) & 3) << 2) | (c & 3); }
struct RmId { __device__ __forceinline__ int operator()(int n) const { return n; } };
struct RmPerm { __device__ __forceinline__ int operator()(int n) const { return pperm(n); } };
struct RmGate { int up; __device__ __forceinline__ int operator()(int n) const { return 256 * (n >> 7) + 128 * up + pperm(n & 127); } };
struct RmWin { __device__ __forceinline__ int operator()(int n) const {
    if (n < 2048) { const int s = n >> 9, ch = n & 511, tile = ch >> 6, cw = ch & 63; return tile * 256 + 128 * (s >> 1) + 32 * (cw >> 4) + 16 * (s & 1) + (cw & 15); }
    if (n < 2560) return pperm(n);
    if (n < 3072) { const int hq = (n - 2560) >> 6, d = n & 63; return 2560 + (hq >> 2) * 256 + 128 * (d >> 5) + 32 * (hq & 3) + 16 * ((d >> 4) & 1) + (d & 15); }
    if (n < 3328) { const int hh = (n - 3072) >> 6, d = n & 63; return 3072 + 128 * (d >> 5) + 32 * hh + 16 * ((d >> 4) & 1) + (d & 15); }
    { const int q = n - 3328, gb = q >> 10, col = q & 1023; return 3328 + 256 * (col >> 7) + 128 * gb + pperm(col & 127); } } };
#define WSP(T, off) ((T*)(F.ws + (off)))

__device__ __forceinline__ void p0_prologue(const Frame& F0) {
    PHASE_FRAME(F0);
    LAS float* cact = (LAS float*)(F.lds);
    LAS float* red = (LAS float*)(F.lds + 69632);
    float* MOD = WSP(float, WS_MOD);
    for (int i = F.tid; i < 17 * 1024; i += NWAVES * 64) { const int r = i >> 10, k = i & 1023; const float v = r < 16 ? INP(I_C)[r * 1024 + k] : INP(I_CCTX)[k]; cact[i] = siluf_(v); }
    __syncthreads();
    for (int it = F.bx; it < 4 * 96; it += F.G) {
        const int l = it / 96, cgp = it % 96, col = cgp * 64 + F.lane;
        const float* w = INP(I_WADA) + (size_t)l * 1024 * 6144 + col;
        float acc[17];
#pragma unroll
        for (int r = 0; r < 17; ++r) acc[r] = 0.f;
        const int k0 = F.wave * 128;
#pragma unroll 1
        for (int kb = k0; kb < k0 + 128; kb += 16) {
            float wv[16];
#pragma unroll
            for (int kk = 0; kk < 16; ++kk) wv[kk] = w[(size_t)(kb + kk) * 6144];
#pragma unroll
            for (int kk = 0; kk < 16; ++kk)
#pragma unroll
                for (int r = 0; r < 17; ++r) acc[r] += cact[r * 1024 + kb + kk] * wv[kk]; }
#pragma unroll
        for (int r = 0; r < 17; ++r) red[(F.wave * 17 + r) * 64 + F.lane] = acc[r];
        __syncthreads();
        for (int i = F.tid; i < 17 * 64; i += NWAVES * 64) { const int r = i >> 6, ln = i & 63; float s = 0.f;
#pragma unroll
            for (int w8 = 0; w8 < 8; ++w8) s += red[(w8 * 17 + r) * 64 + ln];
            MOD[((size_t)l * 17 + r) * 6144 + cgp * 64 + ln] = s + INP(I_BADA)[l * 6144 + cgp * 64 + ln]; }
        __syncthreads();
    }
    { int* ident = (int*)(F.ws + WS_TAB + 65536); for (int i = F.bx * (NWAVES * 64) + F.tid; i < RCAP; i += F.G * NWAVES * 64) ident[i] = i; }
    if (F.bx == F.G - 1) {
        float* COS = WSP(float, WS_TAB); float* SIN = COS + 1024; float* LB = WSP(float, WS_TAB + 8192);
        for (int i = F.tid; i < 1024; i += NWAVES * 64) { const int pos = i >> 4, fi = i & 15;
            const float inv = (float)pow(10000.0, -(double)fi / 16.0); const float ang = (float)pos * inv;
            COS[i] = (float)cos((double)ang); SIN[i] = (float)sin((double)ang); }
        for (int i = F.tid; i < 1024; i += NWAVES * 64) { const int dir = i >> 9, ch = i & 511;
            float lg[4], mx = -1e30f;
#pragma unroll
            for (int l = 0; l < 4; ++l) { lg[l] = INP(I_LBL)[(dir * 4 + l) * 512 + ch]; mx = fmaxf(mx, lg[l]); }
            float den = 0.f;
#pragma unroll
            for (int l = 0; l < 4; ++l) { lg[l] = expf(lg[l] - mx); den += lg[l]; }
            float cum = 0.f;
#pragma unroll
            for (int l = 0; l < 4; ++l) { LB[(dir * 4 + l) * 512 + ch] = cum; if (l < 3) cum += lg[l + 1] / den; } }
    }
}

__device__ __forceinline__ void row_pass(const Frame& F0, int l, int mode) {
    PHASE_FRAME(F0);
    const int gw = F.bx * NWAVES + F.wave, NGW = F.G * NWAVES;
    const float* MOD = WSP(float, WS_MOD); bf16* XN = WSP(bf16, WS_XN);
    const bf16* HR = (mode == 2) ? WSP(bf16, Z_SG) : (const bf16*)F.out; bf16* HW = (bf16*)F.out;
    const unsigned char* YB = F.ws + Z_YB; const int* DEST = (const int*)(F.ws + WS_RT + RT_DEST); const float* WTS = (const float*)(F.ws + WS_RT + RT_W);
    const int nrows = (mode == 2) ? TL : TT;
#define RP_EI(j) (2 * F.lane + 128 * ((j) >> 1) + ((j) & 1))
    constexpr int NR = 2;
    int d0n[NR], d1n[NR]; float w0n[NR], w1n[NR];
#define RP_DEST(mb) do { _Pragma("unroll") for (int q = 0; q < NR; ++q) { const int m = (mb) + q * NGW; d0n[q] = 0; d1n[q] = 0; w0n[q] = 0.f; w1n[q] = 0.f; \
        if (m < nrows) { d0n[q] = DEST[2 * m]; d1n[q] = DEST[2 * m + 1]; w0n[q] = 0.0625f * WTS[2 * m]; w1n[q] = 0.0625f * WTS[2 * m + 1]; } } } while (0)
    if (mode != 0) RP_DEST(gw);
    for (int m0 = gw; m0 < nrows; m0 += NR * NGW) {
        int d0[NR], d1[NR]; float w0[NR], w1[NR];
#pragma unroll
        for (int q = 0; q < NR; ++q) { d0[q] = d0n[q]; d1[q] = d1n[q]; w0[q] = w0n[q]; w1[q] = w1n[q]; }
        f32x4 v[NR][4]; unsigned y0[NR][4], y1[NR][4];
#pragma unroll
        for (int q = 0; q < NR; ++q) { const int m = m0 + q * NGW; if (m < nrows) {
            if (mode == 0) { const float* src = (m < TL) ? INP(I_X) + (size_t)m * 1024 : INP(I_CTX) + (size_t)(m - TL) * 1024;
#pragma unroll
                for (int j = 0; j < 4; ++j) v[q][j] = *((const GAS f32x4*)src + RP_EI(j));
            } else {
#pragma unroll
                for (int jh = 0; jh < 2; ++jh) { const v4u hb = *((const GAS v4u*)(HR + (size_t)m * 1024) + F.lane + 64 * jh); v[q][2 * jh] = unpk4((v2u){hb.x, hb.y}); v[q][2 * jh + 1] = unpk4((v2u){hb.z, hb.w}); }
#pragma unroll
                for (int jh = 0; jh < 2; ++jh) { const v2u ya = *((const GAS v2u*)(YB + (size_t)d0[q] * 1024) + F.lane + 64 * jh), yb = *((const GAS v2u*)(YB + (size_t)d1[q] * 1024) + F.lane + 64 * jh);
                    y0[q][2 * jh] = ya.x; y0[q][2 * jh + 1] = ya.y; y1[q][2 * jh] = yb.x; y1[q][2 * jh + 1] = yb.y; }
            } } }
        if (mode != 0) RP_DEST(m0 + NR * NGW);
#pragma unroll
        for (int q = 0; q < NR; ++q) { const int m = m0 + q * NGW; if (m < nrows) {
            const bool latent = m < TL; const int brow = latent ? (m >> 12) : 16;
            if (mode != 0) {
                const float* g2 = MOD + ((size_t)(l - 1) * 17 + brow) * 6144 + 5120;
#pragma unroll
                for (int j = 0; j < 4; ++j) { const f32x4 gg = *((const GAS f32x4*)g2 + RP_EI(j));
                    const f32x2 a0 = __builtin_amdgcn_cvt_pk_f32_fp8((int)y0[q][j], false), a1 = __builtin_amdgcn_cvt_pk_f32_fp8((int)y0[q][j], true);
                    const f32x2 b0 = __builtin_amdgcn_cvt_pk_f32_fp8((int)y1[q][j], false), b1 = __builtin_amdgcn_cvt_pk_f32_fp8((int)y1[q][j], true);
                    v[q][j] += gg * ((f32x4){a0[0], a0[1], a1[0], a1[1]} * w0[q] + (f32x4){b0[0], b0[1], b1[0], b1[1]} * w1[q]); }
            }
            float ss = 0.f;
#pragma unroll
            for (int j = 0; j < 4; ++j) ss += (v[q][j][0] * v[q][j][0] + v[q][j][1] * v[q][j][1]) + (v[q][j][2] * v[q][j][2] + v[q][j][3] * v[q][j][3]);
            const float rs = rsqrtf(wave_sum(ss, F.lane) * (1.f / 1024.f) + EPSN);
            if (mode == 2) {
#pragma unroll
                for (int j = 0; j < 4; ++j) { const f32x4 g = *((const GAS f32x4*)INP(I_FNG) + RP_EI(j)); *((GAS f32x4*)(F.out + (size_t)m * 1024) + RP_EI(j)) = v[q][j] * rs * g; }
            } else {
                const float* mod = MOD + ((size_t)l * 17 + brow) * 6144; const float* ng = INP(I_N1G) + l * 1024;
#pragma unroll
                for (int jh = 0; jh < 2; ++jh) {
                    if (mode != 0) { const v2u p0 = pk4(v[q][2 * jh]), p1 = pk4(v[q][2 * jh + 1]); *((GAS v4u*)(HW + (size_t)m * 1024) + F.lane + 64 * jh) = (v4u){p0.x, p0.y, p1.x, p1.y}; }
                    f32x4 y[2];
#pragma unroll
                    for (int hh = 0; hh < 2; ++hh) { const int j = 2 * jh + hh;
                        const f32x4 g = *((const GAS f32x4*)ng + RP_EI(j)), sh = *((const GAS f32x4*)mod + RP_EI(j)), sc = *((const GAS f32x4*)(mod + 1024) + RP_EI(j));
                        y[hh] = v[q][j] * rs * g * (sc + 1.f) + sh; }
                    { const v2u p0 = pk4(y[0]), p1 = pk4(y[1]); *((GAS v4u*)(XN + (size_t)m * 1024) + F.lane + 64 * jh) = (v4u){p0.x, p0.y, p1.x, p1.y}; }
                    *((GAS v2u*)(F.ws + Z_OB + (size_t)m * 1024) + F.lane + 64 * jh) = (v2u){pk4_f8(y[0][0], y[0][1], y[0][2], y[0][3]), pk4_f8(y[1][0], y[1][1], y[1][2], y[1][3])}; }
            }
        } }
    }
}

__device__ __forceinline__ void convert_items(const Frame& F0, int l, int part, int nparts, int worker, int nworkers) {
    PHASE_FRAME(F0);
    LAS float* scr = (LAS float*)(F.lds + F.wave * 16384);
    unsigned char* W = F.ws + WS_W + (size_t)(l & 1) * W_PSTRIDE; unsigned char* WDN = F.ws + ((l & 1) ? W_DN1 : W_DN0);
    constexpr int N_IN = 16 * 168, N_UA = 8 * 32, N_OUT = 16 * 32, N_G = 32 * 256;
    constexpr int NITEMS = N_IN + 2 * N_UA + N_OUT + 3 * N_G;
    const int it_lo = (int)((long)NITEMS * part / nparts), it_hi = (int)((long)NITEMS * (part + 1) / nparts);
    for (int it = it_lo + worker; it < it_hi; it += nworkers) {
        int r = it;
        if (r < N_IN) { const int nb = r % 168;
            if (nb < 64) transpose_item(INP(I_WIN) + (size_t)l * 1024 * NZ, NZ, (bf16*)(W + W_IN), 1024, 0, scr, r / 168, nb, F.lane, RmWin{});
            else if (nb < 104) transpose_item_f8(INP(I_WIN) + (size_t)l * 1024 * NZ, NZ, W + W_IN8, 1024, 0, scr, r / 168, nb, F.lane, RmWin{}, 32.f);
            else transpose_item_f8(INP(I_WIN) + (size_t)l * 1024 * NZ, NZ, W + W_IN8 - (size_t)3328 * 1024, 1024, 0, scr, r / 168, nb, F.lane, RmWin{}, -32.f * 1.4426950408889634f);
            continue; } r -= N_IN;
        if (r < N_UA) { transpose_item(INP(I_WUA) + (size_t)l * 512 * 1024, 1024, (bf16*)(W + W_UP), 1024, 0, scr, r / 32, r % 32, F.lane, RmPerm{}); continue; } r -= N_UA;
        if (r < N_UA) { transpose_item(INP(I_WUB) + (size_t)l * 512 * 1024, 1024, (bf16*)(W + W_UP), 1024, 512, scr, r / 32, r % 32, F.lane, RmPerm{}); continue; } r -= N_UA;
        if (r < N_OUT) { transpose_item(INP(I_WOUT) + (size_t)l * 1024 * 1024, 1024, (bf16*)(W + W_OUT), 1024, 0, scr, r / 32, r % 32, F.lane, RmPerm{}); continue; } r -= N_OUT;
        if (r < N_G) { const int e = r >> 8, r2 = r & 255; transpose_item_f8(INP(I_WG) + ((size_t)l * 32 + e) * 1024 * 512, 512, W + W_GU + (size_t)e * 1024 * 1024, 1024, 0, scr, r2 / 16, r2 % 16, F.lane, RmGate{0}, 32.f); continue; } r -= N_G;
        if (r < N_G) { const int e = r >> 8, r2 = r & 255; transpose_item_f8(INP(I_WU) + ((size_t)l * 32 + e) * 1024 * 512, 512, W + W_GU + (size_t)e * 1024 * 1024, 1024, 0, scr, r2 / 16, r2 % 16, F.lane, RmGate{1}, 32.f); continue; } r -= N_G;
        { const int e = r >> 8, r2 = r & 255; transpose_item_f8(INP(I_WD) + ((size_t)l * 32 + e) * 512 * 1024, 1024, WDN + (size_t)e * 1024 * 512, 512, 0, scr, r2 / 32, r2 % 32, F.lane, RmPerm{}, 16.f); }
    }
}

__device__ __forceinline__ void convert_layer(const Frame& F0, int l, int worker, int nworkers) {
    PHASE_FRAME(F0);
    const int gw = worker, NGW = nworkers;
    const float* MOD = WSP(float, WS_MOD) + (size_t)l * 17 * 6144; float* WP = WSP(float, WS_WR); float* CV = WSP(float, WS_WR + WR_CVEC);
    const float* wrg = INP(I_WRG) + (size_t)l * 1024 * 4; const float* wre = INP(I_WRE) + (size_t)l * 1024 * 32; const float* n2g = INP(I_N2G) + l * 1024;
    const int gt = worker * 64 + F.lane, NGT = nworkers * 64;
    for (int i0 = gt; i0 < 17 * 1024 * 48; i0 += 8 * NGT) {
        float gv[8], mv[8], wv[8];
#pragma unroll
        for (int n = 0; n < 8; ++n) { const int i = i0 + n * NGT; gv[n] = 0.f; mv[n] = 0.f; wv[n] = 0.f;
            if (i < 17 * 1024 * 48) { const int b = i / (1024 * 48), k = (i / 48) & 1023, j = i % 48;
                gv[n] = n2g[k]; mv[n] = MOD[(size_t)b * 6144 + 4096 + k]; wv[n] = j < 4 ? wrg[k * 4 + j] : (j < 36 ? wre[k * 32 + (j - 4)] : 0.f); } }
#pragma unroll
        for (int n = 0; n < 8; ++n) { const int i = i0 + n * NGT;
            if (i < 17 * 1024 * 48) { const int b = i / (1024 * 48), k = (i / 48) & 1023, j = i % 48;
                const float wp = gv[n] * (1.f + mv[n]) * wv[n]; WP[i] = wp;
                const unsigned hi = f2bf(wp); const unsigned lo = f2bf(wp - bf2f((unsigned short)hi));
                bf16* q_ = WSP(bf16, WS_HC) + (size_t)b * 98304 + (k >> 5) * 3072 + ((k >> 3) & 3) * 768 + (j >> 4) * 128 + (j & 15) * 8 + (k & 7);
                q_[0] = (bf16)hi; q_[384] = (bf16)lo; } }
    }
    for (int it = gw; it < 17 * 48; it += NGW) { const int b = it / 48, j = it % 48; float s = 0.f;
        if (j < 36) { for (int k = F.lane; k < 1024; k += 64) { const float w = j < 4 ? wrg[k * 4 + j] : wre[k * 32 + (j - 4)]; s += MOD[(size_t)b * 6144 + 3072 + k] * w; }
            s = wave_sum(s, F.lane) + (j < 4 ? INP(I_BRG)[l * 4 + j] : INP(I_BRE)[l * 32 + (j - 4)]); }
        if (F.lane == 0) CV[it] = s; }
}

__device__ __forceinline__ void p3_scan(const Frame& F0) {
    PHASE_FRAME(F0);
    constexpr int PQ = 272, PT = 144;
    constexpr int O_Q = 0, O_V = O_Q + 2 * 64 * PQ, O_K = O_V + 2 * 64 * PT, O_A = O_K + 64 * PQ, O_ST = O_A + 64 * PT, O_DEC = O_ST + 64 * PQ;
    static_assert(O_DEC + 1536 <= RING_BYTES, "scan LDS");
    typedef short v4i16_t __attribute__((ext_vector_type(4)));
    LAS unsigned char* L = F.lds;
    const int tid = F.tid, lane = F.lane, wave = F.wave, fr = lane & 15, fq = lane >> 4;
    const float* DEC = WSP(float, Z_DEC);
    for (int u0 = F.bx; u0 < 256; u0 += F.G) {
        const int unit = (u0 & ~15) | ((u0 & 7) << 1) | ((u0 >> 3) & 1);
        const int dvh = unit & 1, dir = (unit >> 1) & 1, hd = (unit >> 2) & 3, b = unit >> 4;
        const bf16* Qp = dir ? WSP(bf16, Z_QB) : WSP(bf16, Z_QF); const bf16* Kp = dir ? WSP(bf16, Z_KB) : WSP(bf16, Z_KF); const bf16* Vp = WSP(bf16, Z_VA);
        bf16* Op = dir ? WSP(bf16, Z_OB) + hd * 128 + dvh * 64 : WSP(bf16, Z_Y2) + hd * 128 + dvh * 64; const int opitch = dir ? 512 : 1024;
        f32x4 S[4];
#pragma unroll
        for (int vt = 0; vt < 4; ++vt) S[vt] = (f32x4){0.f, 0.f, 0.f, 0.f};
        int prow[2], pc16[2];
#pragma unroll
        for (int i = 0; i < 2; ++i) { const int p = tid + 512 * i; prow[i] = p >> 4; pc16[i] = p & 15; }
        const int vrow = tid >> 3, vc8 = tid & 7;
        v4u gq[2][2], gk[2][2], gv[2]; f32x4 gdec[2];
        gdec[0] = (f32x4){0.f, 0.f, 0.f, 0.f}; gdec[1] = gdec[0];
#define SCAN_CG(s) ((s) < 4 ? (1024 + 4 * b + (dir ? 3 - (s) : (s))) : (64 * b + (dir ? 67 - (s) : (s) - 4)))
#define SCAN_LOAD(s, R) do { const int cg_ = SCAN_CG(s); const size_t r0_ = (size_t)cg_ * 64; \
        const size_t tq_ = ((size_t)cg_ * 4 + hd) * 64 * 128; (void)r0_; \
        _Pragma("unroll") for (int i = 0; i < 2; ++i) { gq[R][i] = *(const GAS v4u*)(Qp + tq_ + prow[i] * 128 + 8 * pc16[i]); gk[R][i] = *(const GAS v4u*)(Kp + tq_ + prow[i] * 128 + 8 * pc16[i]); } \
        gv[R] = *(const GAS v4u*)(Vp + (((size_t)cg_ * 4 + hd) * 2 + dvh) * 64 * 64 + vrow * 64 + 8 * vc8); \
        if (tid < 96) gdec[R] = *(const GAS f32x4*)(DEC + ((size_t)(cg_ * 2 + dir) * 3 + (tid >> 5)) * 512 + hd * 128 + 4 * (tid & 31)); } while (0)
#define SCAN_BAR() asm volatile("s_waitcnt lgkmcnt(0)\n\ts_barrier" ::: "memory")
#define SCAN_TRF(dst, base, pitch, c0, kk) do { const LAS unsigned char* p_ = (base) + (32 * (kk) + 8 * fq + ((lane & 15) >> 2)) * (pitch) + 2 * ((c0) + 4 * (lane & 3)); \
            const v4i16_t r0_ = __builtin_amdgcn_ds_read_tr16_b64_v4i16((LAS v4i16_t*)p_), r1_ = __builtin_amdgcn_ds_read_tr16_b64_v4i16((LAS v4i16_t*)(p_ + 4 * (pitch))); \
            dst = (bf16x8){r0_[0], r0_[1], r0_[2], r0_[3], r1_[0], r1_[1], r1_[2], r1_[3]}; } while (0)
#define SCAN_STEP(s, R) do { \
            const int cg = SCAN_CG(s); const int oq = O_Q + (R) * 64 * PQ, ov = O_V + (R) * 64 * PT; \
            _Pragma("unroll") for (int i = 0; i < 2; ++i) { \
                *(LAS v4u*)(L + oq + prow[i] * PQ + 16 * pc16[i]) = gq[R][i]; \
                *(LAS v4u*)(L + O_K + prow[i] * PQ + 16 * pc16[i]) = gk[R][i]; } \
            *(LAS v4u*)(L + ov + vrow * PT + 16 * vc8) = gv[R]; \
            if (tid < 96) *(LAS f32x4*)(L + O_DEC + (tid >> 5) * 512 + 16 * (tid & 31)) = gdec[R]; \
            SCAN_BAR(); \
            if ((s) + 2 < 68) SCAN_LOAD((s) + 2, R); \
            { const f32x4 dm4 = *(const LAS f32x4*)(L + O_DEC + 4 * (16 * wave + 4 * fq)); \
              _Pragma("unroll") for (int vt = 0; vt < 4; ++vt) *(LAS v2u*)(L + O_ST + (16 * vt + fr) * PQ + 2 * (16 * wave + 4 * fq)) = pk4(S[vt] * dm4); } \
            bf16x8 bqk[2][4], va[2];                        \
            { const int st_ = wave >> 1; bf16x8 af[4]; \
              _Pragma("unroll") for (int kk = 0; kk < 4; ++kk) af[kk] = *(const LAS bf16x8*)(L + O_K + (16 * st_ + fr) * PQ + 2 * (32 * kk + 8 * fq)); \
              _Pragma("unroll") for (int tl = 0; tl < 2; ++tl) _Pragma("unroll") for (int kk = 0; kk < 4; ++kk) bqk[tl][kk] = *(const LAS bf16x8*)(L + oq + (16 * (2 * (wave & 1) + tl) + fr) * PQ + 2 * (32 * kk + 8 * fq)); \
              _Pragma("unroll") for (int tl = 0; tl < 2; ++tl) { const int tt = 2 * (wave & 1) + tl; const int tq = 16 * tt + fr; f32x4 o = (f32x4){0.f, 0.f, 0.f, 0.f}; \
                  const bool dead = dir ? (st_ < tt) : (st_ > tt); \
                  if (!dead) { f32x4 a = (f32x4){0.f, 0.f, 0.f, 0.f}; \
                      _Pragma("unroll") for (int kk = 0; kk < 4; ++kk) a = __builtin_amdgcn_mfma_f32_16x16x32_bf16(af[kk], bqk[tl][kk], a, 0, 0, 0); \
                      _Pragma("unroll") for (int rg = 0; rg < 4; ++rg) { const int sk = 16 * st_ + 4 * fq + rg; const bool keep = dir ? (sk >= tq) : (sk <= tq); o[rg] = keep ? a[rg] : 0.f; } } \
                  *(LAS v2u*)(L + O_A + tq * PT + 2 * (16 * st_ + 4 * fq)) = pk4(o); } } \
            { const f32x4 dl4 = *(const LAS f32x4*)(L + O_DEC + 512 + 4 * (16 * wave + 4 * fq)), dlm4 = *(const LAS f32x4*)(L + O_DEC + 1024 + 4 * (16 * wave + 4 * fq)); \
              bf16x8 af[2]; \
              _Pragma("unroll") for (int kk = 0; kk < 2; ++kk) SCAN_TRF(af[kk], L + O_K, PQ, 16 * wave, kk); \
              _Pragma("unroll") for (int vt = 0; vt < 4; ++vt) { f32x4 g = (f32x4){0.f, 0.f, 0.f, 0.f}; \
                  _Pragma("unroll") for (int kk = 0; kk < 2; ++kk) { bf16x8 bv; SCAN_TRF(bv, L + ov, PT, 16 * vt, kk); g = __builtin_amdgcn_mfma_f32_16x16x32_bf16(af[kk], bv, g, 0, 0, 0); if (vt == (wave >> 1)) va[kk] = bv; } \
                  S[vt] = dl4 * S[vt] + dlm4 * g; } } \
            SCAN_BAR(); \
            { const int vt = wave >> 1; const size_t r0 = (size_t)cg * 64; \
              bf16x8 sa[4]; \
              _Pragma("unroll") for (int kk = 0; kk < 4; ++kk) sa[kk] = *(const LAS bf16x8*)(L + O_ST + (16 * vt + fr) * PQ + 2 * (32 * kk + 8 * fq)); \
              _Pragma("unroll") for (int tl = 0; tl < 2; ++tl) { const int tt = 2 * (wave & 1) + tl; f32x4 o = (f32x4){0.f, 0.f, 0.f, 0.f}; \
                  _Pragma("unroll") for (int kk = 0; kk < 4; ++kk) o = __builtin_amdgcn_mfma_f32_16x16x32_bf16(sa[kk], bqk[tl][kk], o, 0, 0, 0); \
                  _Pragma("unroll") for (int kk = 0; kk < 2; ++kk) { const bf16x8 ba = *(const LAS bf16x8*)(L + O_A + (16 * tt + fr) * PT + 2 * (32 * kk + 8 * fq)); o = __builtin_amdgcn_mfma_f32_16x16x32_bf16(va[kk], ba, o, 0, 0, 0); } \
                  *(GAS v2u*)(Op + (r0 + 16 * tt + fr) * opitch + 16 * vt + 4 * fq) = pk4(o); } } \
        } while (0)
        SCAN_LOAD(0, 0); SCAN_LOAD(1, 1);
#pragma unroll 1
        for (int s = 0; s < 68; s += 2) { SCAN_STEP(s, 0); SCAN_STEP(s + 1, 1); }
        SCAN_BAR();
#undef SCAN_CG
#undef SCAN_LOAD
#undef SCAN_BAR
#undef SCAN_TRF
#undef SCAN_STEP
    }
}

__device__ __forceinline__ void p4_attention(const Frame& F0, int l, bool need_ctx, char* lds_generic, bool dummy_out) {
    PHASE_FRAME(F0);
    bool nomax;
    { const float gq = fabsf(INP(I_QNG)[l * 64 + F.lane]), gk = fabsf(INP(I_KNG)[l * 64 + F.lane]); float mq = gq, mk = gk;
#pragma unroll
      for (int o = 1; o < 64; o <<= 1) { mq = fmaxf(mq, shx(mq, o, F.lane)); mk = fmaxf(mk, shx(mk, o, F.lane)); }
      const float bound = 64.f * QC2 * mq * mk; nomax = __builtin_amdgcn_readfirstlane(__builtin_bit_cast(int, bound)) < __builtin_bit_cast(int, 64.f) && bound == bound; }
    typedef attn_body::bf16 abf;
    abf* Y2 = (abf*)(F.ws + Z_Y2); const abf* KG = (const abf*)(F.ws + Z_KG); const abf* VG = (const abf*)(F.ws + Z_VG);
    const int nunits = 2048 + (need_ctx ? 128 : 0);
    for (int u = F.bx; u < nunits; u += F.G) {
        int b, h, kvh, NT; size_t qrow;
        if (u < 2048) { const int i_ = u >> 8, x_ = u & 7, j32 = (u & 255) >> 3; const int grp = (i_ >> 1) * 8 + x_, j = (i_ & 1) * 32 + j32; b = grp >> 1; kvh = grp & 1; h = 4 * kvh + (j >> 4); qrow = (size_t)b * SEQ + (size_t)(j & 15) * 256; NT = KVLEN / 64; }
        else { const int u2 = u - 2048; b = u2 >> 3; h = u2 & 7; kvh = h >> 2; qrow = (size_t)TL + (size_t)b * CTXL; NT = CTXL / 64; }
        abf* Qb = Y2 + qrow * 1024 + 512 + 64 * h;
        abf* Ob = dummy_out ? (abf*)(F.ws + WS_XN) + qrow * 1024 + 512 + 64 * h : Qb;
        if (nomax) attn_body::attn_unit<8, true>(Qb, KG + (size_t)b * KVLEN * 128 + 64 * kvh, VG + (size_t)b * KVLEN * 128 + 64 * kvh, Ob, NT, lds_generic);
        else attn_body::attn_unit<8, false>(Qb, KG + (size_t)b * KVLEN * 128 + 64 * kvh, VG + (size_t)b * KVLEN * 128 + 64 * kvh, Ob, NT, lds_generic);
    }
}

__device__ __forceinline__ void p5_headnorm(const Frame& F0, int l, int nrows) {
    PHASE_FRAME(F0);
    const int gw = F.bx * NWAVES + F.wave, NGW = F.G * NWAVES;
    bf16* Y2 = WSP(bf16, Z_Y2); const bf16* OB = WSP(bf16, Z_OB); const bf16* OG = WSP(bf16, Z_OG);
    const float* g = INP(I_HNG) + l * 512 + 8 * F.lane; const f32x4 g0 = *(const GAS f32x4*)g, g1 = *(const GAS f32x4*)(g + 4);
    for (int m = gw; m < nrows; m += NGW) {
        const v4u a = *(const GAS v4u*)(Y2 + (size_t)m * 1024 + 8 * F.lane), bb = *(const GAS v4u*)(OB + (size_t)m * 512 + 8 * F.lane), gg = *(const GAS v4u*)(OG + (size_t)m * 512 + 8 * F.lane);
        f32x4 o0 = unpk4((v2u){a.x, a.y}) + unpk4((v2u){bb.x, bb.y}), o1 = unpk4((v2u){a.z, a.w}) + unpk4((v2u){bb.z, bb.w});
        float ss = (o0[0] * o0[0] + o0[1] * o0[1]) + (o0[2] * o0[2] + o0[3] * o0[3]) + (o1[0] * o1[0] + o1[1] * o1[1]) + (o1[2] * o1[2] + o1[3] * o1[3]);
        ss += shx(ss, 1, F.lane); ss += shx(ss, 2, F.lane); ss += shx(ss, 4, F.lane); ss += shx(ss, 8, F.lane);
        const float rs = rsqrtf(ss * (1.f / 128.f) + EPSN);
        o0 = o0 * rs * g0 * unpk4((v2u){gg.x, gg.y}); o1 = o1 * rs * g1 * unpk4((v2u){gg.z, gg.w});
        const v2u p0 = pk4(o0), p1 = pk4(o1);
        *(GAS v4u*)(Y2 + (size_t)m * 1024 + 8 * F.lane) = (v4u){p0.x, p0.y, p1.x, p1.y};
    }
}

__device__ __forceinline__ void p9_router(const Frame& F0, int l, int nrows) {
    PHASE_FRAME(F0);
    LAS int* lcnt = (LAS int*)(F.lds + LDSCTL_OFF);
    LAS float* lgs = (LAS float*)(F.lds + F.wave * 4096);
    const float* MOD = WSP(float, WS_MOD) + (size_t)l * 17 * 6144; bf16* XN = WSP(bf16, WS_XN);
    const bf16* HB = (l == DEPTH - 1) ? WSP(bf16, Z_SG) : (const bf16*)F.out;
    const float* WP = WSP(float, WS_WR); const float* CV = WSP(float, WS_WR + WR_CVEC);
    int* INFO = (int*)(F.ws + WS_RT + RT_INFO); float* WTS = (float*)(F.ws + WS_RT + RT_W); int* CNT = (int*)(F.ws + WS_RT + RT_CNT);
    if (F.tid < 32) lcnt[F.tid] = 0;
    __syncthreads();
    const int lane = F.lane, i16 = lane & 15, kg = lane >> 4;
    for (int gamma = F.bx; gamma < TL / 128; gamma += F.G) {
        const int row0 = gamma * 128 + F.wave * 16; const int brow = row0 >> 12;
        const bf16* hbase = HB + (size_t)row0 * 1024;
        const bf16* hp = hbase + (size_t)i16 * 1024 + 8 * kg;
        const GAS bf16* wl = (const GAS bf16*)(F.ws + WS_HC) + (size_t)brow * 98304 + kg * 768 + i16 * 8;
        f32x4 a0 = (f32x4){0.f, 0.f, 0.f, 0.f}, a1 = a0, a2 = a0; float ss = 0.f;
        v4u hn[4];
#pragma unroll
        for (int jj = 0; jj < 4; ++jj) hn[jj] = *(const GAS v4u*)(hp + 32 * jj);
#pragma unroll 1
        for (int c8 = 0; c8 < 8; ++c8) {
            v4u hv[4]; bf16x8 wf[4][6];
#pragma unroll
            for (int jj = 0; jj < 4; ++jj) hv[jj] = hn[jj];
#pragma unroll
            for (int jj = 0; jj < 4; ++jj)
#pragma unroll
                for (int q = 0; q < 6; ++q) wf[jj][q] = *(const GAS bf16x8*)(wl + (size_t)(4 * c8 + jj) * 3072 + q * 128);
            if (c8 < 7) {
#pragma unroll
                for (int jj = 0; jj < 4; ++jj) hn[jj] = *(const GAS v4u*)(hp + 32 * (4 * (c8 + 1) + jj)); }
#pragma unroll
            for (int jj = 0; jj < 4; ++jj) { const f32x4 xl = pg8::unlo4(hv[jj]), xh = pg8::unhi4(hv[jj]); const bf16x8 ha = __builtin_bit_cast(bf16x8, hv[jj]);
                ss += ((xl[0] * xl[0] + xl[1] * xl[1]) + (xl[2] * xl[2] + xl[3] * xl[3])) + ((xh[0] * xh[0] + xh[1] * xh[1]) + (xh[2] * xh[2] + xh[3] * xh[3]));
                a0 = __builtin_amdgcn_mfma_f32_16x16x32_bf16(ha, wf[jj][0], a0, 0, 0, 0); a1 = __builtin_amdgcn_mfma_f32_16x16x32_bf16(ha, wf[jj][1], a1, 0, 0, 0); a2 = __builtin_amdgcn_mfma_f32_16x16x32_bf16(ha, wf[jj][2], a2, 0, 0, 0);
                a0 = __builtin_amdgcn_mfma_f32_16x16x32_bf16(ha, wf[jj][3], a0, 0, 0, 0); a1 = __builtin_amdgcn_mfma_f32_16x16x32_bf16(ha, wf[jj][4], a1, 0, 0, 0); a2 = __builtin_amdgcn_mfma_f32_16x16x32_bf16(ha, wf[jj][5], a2, 0, 0, 0); }
        }
        ss += shx(ss, 16, lane); ss += shx(ss, 32, lane);
        const float rs = rsqrtf(ss * (1.f / 1024.f) + EPSN);
#pragma unroll
        for (int rg = 0; rg < 4; ++rg) { lgs[(4 * kg + rg) * 49 + i16] = a0[rg]; lgs[(4 * kg + rg) * 49 + 16 + i16] = a1[rg]; lgs[(4 * kg + rg) * 49 + 32 + i16] = a2[rg]; }
        LDS_WAIT(); asm volatile("" ::: "memory");
        if (lane < 16) {
            const int row = row0 + lane; const float* cv = CV + brow * 48; const LAS float* lg = lgs + lane * 49;
            float gl[4]; int gsel = 0; float gm = -3.0e38f;
#pragma unroll
            for (int j = 0; j < 4; ++j) { gl[j] = lg[j] * rs + cv[j]; if (gl[j] > gm) { gm = gl[j]; gsel = j; } }
            float den = 0.f;
#pragma unroll
            for (int j = 0; j < 4; ++j) den += __expf(gl[j] - gm);
            const float pg = 1.f / den;
            float el[8];
#pragma unroll
            for (int j = 0; j < 8; ++j) {
                float v = lg[4 + j] * rs + cv[4 + j];
                const float v1 = lg[12 + j] * rs + cv[12 + j], v2 = lg[20 + j] * rs + cv[20 + j], v3 = lg[28 + j] * rs + cv[28 + j];
                v = gsel == 1 ? v1 : v; v = gsel == 2 ? v2 : v; v = gsel == 3 ? v3 : v; el[j] = v; }
            int t1 = 0; float m1 = -3.0e38f;
#pragma unroll
            for (int j = 0; j < 8; ++j) if (el[j] > m1) { m1 = el[j]; t1 = j; }
            int t2 = 0; float m2 = -3.0e38f;
#pragma unroll
            for (int j = 0; j < 8; ++j) if (j != t1 && el[j] > m2) { m2 = el[j]; t2 = j; }
            const float e2 = __expf(m2 - m1); const float w1 = pg / (1.f + e2), w2 = pg * e2 / (1.f + e2);
            const int e0 = gsel * 8 + t1, e1 = gsel * 8 + t2;
            const int lr0 = __hip_atomic_fetch_add(&lcnt[e0], 1, __ATOMIC_RELAXED, __HIP_MEMORY_SCOPE_WORKGROUP), lr1 = __hip_atomic_fetch_add(&lcnt[e1], 1, __ATOMIC_RELAXED, __HIP_MEMORY_SCOPE_WORKGROUP);
            *(GAS i32x4*)(INFO + 4 * (size_t)row) = (i32x4){e0, e1, lr0, lr1};
            *(GAS f32x2*)(WTS + 2 * (size_t)row) = (f32x2){w1, w2};
        }
        const float* n2g = INP(I_N2G) + l * 1024; const float* mod = MOD + (size_t)brow * 6144;
        f32x4 gsc[4], shv[4];
#pragma unroll
        for (int j = 0; j < 4; ++j) { const int e = 2 * lane + 128 * (j >> 1) + (j & 1); const f32x4 g = *((const GAS f32x4*)n2g + e), sc = *((const GAS f32x4*)(mod + 4096) + e); gsc[j] = g * (sc + 1.f); shv[j] = *((const GAS f32x4*)(mod + 3072) + e); }
#pragma unroll 1
        for (int r4 = 0; r4 < 16; r4 += 4) {
            v4u v[4][2];
#pragma unroll
            for (int q = 0; q < 4; ++q)
#pragma unroll
                for (int j = 0; j < 2; ++j) v[q][j] = *((const GAS v4u*)(hbase + (size_t)(r4 + q) * 1024) + lane + 64 * j);
#pragma unroll
            for (int q = 0; q < 4; ++q) { const float rsr = shl(rs, r4 + q);
#pragma unroll
                for (int j = 0; j < 2; ++j) { const f32x4 y0 = pg8::unlo4(v[q][j]) * rsr * gsc[2 * j] + shv[2 * j], y1 = pg8::unhi4(v[q][j]) * rsr * gsc[2 * j + 1] + shv[2 * j + 1];
                    *((GAS v2u*)((unsigned char*)XN + (size_t)(row0 + r4 + q) * 1024) + lane + 64 * j) = (v2u){pk4_f8(y0[0], y0[1], y0[2], y0[3]), pk4_f8(y1[0], y1[1], y1[2], y1[3])}; } }
        }
    }
    if (nrows > TL) {
        LAS float* red = (LAS float*)(F.lds + 32768);
        LAS float* ssp = red + 8 * 16 * 49;
        const int wave = F.wave, koff = 128 * wave + 8 * kg;
#pragma unroll 1
        for (int tj = F.bx; tj < TC / 16; tj += F.G) {
            const int row0 = TL + tj * 16;
            const bf16* hq = HB + (size_t)(row0 + i16) * 1024 + koff;
            v4u hw8[4];
#pragma unroll
            for (int jp = 0; jp < 4; ++jp) hw8[jp] = *(const GAS v4u*)(hq + 32 * jp);
            const unsigned wvo = (unsigned)((koff * 48 + i16) * 4);
            f32x4 a0 = (f32x4){0.f, 0.f, 0.f, 0.f}, a1 = a0, a2 = a0; float ss = 0.f;
#pragma unroll
            for (int jp = 0; jp < 4; ++jp) {
                float wv[2][4][3];
#pragma unroll
                for (int hf = 0; hf < 2; ++hf)
#pragma unroll
                    for (int c = 0; c < 4; ++c) { const GAS float* wr_ = (const GAS float*)((const GAS char*)(WP + ((size_t)16 * 1024 + 32 * jp) * 48) + wvo) + (4 * hf + c) * 48; wv[hf][c][0] = wr_[0]; wv[hf][c][1] = wr_[16]; wv[hf][c][2] = wr_[32]; }
#pragma unroll
                for (int hf = 0; hf < 2; ++hf) { const f32x4 x = hf ? pg8::unhi4(hw8[jp]) : pg8::unlo4(hw8[jp]); ss += (x[0] * x[0] + x[1] * x[1]) + (x[2] * x[2] + x[3] * x[3]);
#pragma unroll
                    for (int c = 0; c < 4; ++c) {
                        a0 = __builtin_amdgcn_mfma_f32_16x16x4f32(x[c], wv[hf][c][0], a0, 0, 0, 0);
                        a1 = __builtin_amdgcn_mfma_f32_16x16x4f32(x[c], wv[hf][c][1], a1, 0, 0, 0);
                        a2 = __builtin_amdgcn_mfma_f32_16x16x4f32(x[c], wv[hf][c][2], a2, 0, 0, 0); } }
            }
            ss += shx(ss, 16, lane); ss += shx(ss, 32, lane);
            { LAS float* rw = red + wave * (16 * 49);
#pragma unroll
              for (int rg = 0; rg < 4; ++rg) { rw[(4 * kg + rg) * 49 + i16] = a0[rg]; rw[(4 * kg + rg) * 49 + 16 + i16] = a1[rg]; rw[(4 * kg + rg) * 49 + 32 + i16] = a2[rg]; }
              if (kg == 0) ssp[wave * 16 + i16] = ss; }
            __syncthreads();
            float rs;
            { float sst = 0.f;
#pragma unroll
              for (int w = 0; w < 8; ++w) sst += ssp[w * 16 + i16];
              rs = rsqrtf(sst * (1.f / 1024.f) + EPSN); }
            if (F.tid < 16) {
                const int row = row0 + lane; const float* cv = CV + 16 * 48;
                float gl[4]; int gsel = 0; float gm = -3.0e38f;
#pragma unroll
                for (int j = 0; j < 4; ++j) { float s = 0.f;
#pragma unroll
                    for (int w = 0; w < 8; ++w) s += red[(w * 16 + lane) * 49 + j];
                    gl[j] = s * rs + cv[j]; if (gl[j] > gm) { gm = gl[j]; gsel = j; } }
                float den = 0.f;
#pragma unroll
                for (int j = 0; j < 4; ++j) den += __expf(gl[j] - gm);
                const float pg = 1.f / den;
                float el[8];
#pragma unroll
                for (int j = 0; j < 8; ++j) { float s = 0.f; const int col = 4 + 8 * gsel + j;
#pragma unroll
                    for (int w = 0; w < 8; ++w) s += red[(w * 16 + lane) * 49 + col];
                    el[j] = s * rs + cv[col]; }
                int t1 = 0; float m1 = -3.0e38f;
#pragma unroll
                for (int j = 0; j < 8; ++j) if (el[j] > m1) { m1 = el[j]; t1 = j; }
                int t2 = 0; float m2 = -3.0e38f;
#pragma unroll
                for (int j = 0; j < 8; ++j) if (j != t1 && el[j] > m2) { m2 = el[j]; t2 = j; }
                const float e2 = __expf(m2 - m1); const float w1 = pg / (1.f + e2), w2 = pg * e2 / (1.f + e2);
                const int e0 = gsel * 8 + t1, e1 = gsel * 8 + t2;
                const int lr0 = __hip_atomic_fetch_add(&lcnt[e0], 1, __ATOMIC_RELAXED, __HIP_MEMORY_SCOPE_WORKGROUP), lr1 = __hip_atomic_fetch_add(&lcnt[e1], 1, __ATOMIC_RELAXED, __HIP_MEMORY_SCOPE_WORKGROUP);
                *(GAS i32x4*)(INFO + 4 * (size_t)row) = (i32x4){e0, e1, lr0, lr1};
                *(GAS f32x2*)(WTS + 2 * (size_t)row) = (f32x2){w1, w2};
            }
            {
                const float* n2g = INP(I_N2G) + l * 1024; const float* mod = MOD + (size_t)16 * 6144;
                unsigned char* xr = (unsigned char*)XN + (size_t)(row0 + i16) * 1024 + koff;
#pragma unroll
                for (int jp = 0; jp < 4; ++jp) { v2u o;
#pragma unroll
                    for (int hf = 0; hf < 2; ++hf) { const int k = koff + 32 * jp + 4 * hf;
                        const f32x4 g = *(const GAS f32x4*)(n2g + k), sh = *(const GAS f32x4*)(mod + 3072 + k), sc = *(const GAS f32x4*)(mod + 4096 + k);
                        const f32x4 y = (hf ? pg8::unhi4(hw8[jp]) : pg8::unlo4(hw8[jp])) * rs * g * (sc + 1.f) + sh; const unsigned w4 = pk4_f8(y[0], y[1], y[2], y[3]); if (hf == 0) o.x = w4; else o.y = w4; }
                    *(GAS v2u*)(xr + 32 * jp) = o; }
            }
            __syncthreads();
        }
    }
    __syncthreads();
    if (F.tid < 32) CNT[F.bx * 32 + F.tid] = lcnt[F.tid];
}

__device__ __forceinline__ void p10_dispatch(const Frame& F0, int nrows) {
    PHASE_FRAME(F0);
    LAS int* cnts = (LAS int*)F.lds; LAS int* tot = (LAS int*)(F.lds + 32768); LAS int* base = tot + 32; LAS int* offs = base + 32;
    const int* CNT = (const int*)(F.ws + WS_RT + RT_CNT); const int* INFO = (const int*)(F.ws + WS_RT + RT_INFO); const float* WTS = (const float*)(F.ws + WS_RT + RT_W);
    int* DEST = (int*)(F.ws + WS_RT + RT_DEST); int* OFFT = (int*)(F.ws + WS_RT + RT_OFF); int* ROWTOK = (int*)(F.ws + WS_RT + RT_ROWTOK); float* ROWW = (float*)(F.ws + WS_RT + RT_ROWW);
    for (int i = F.tid; i < F.G * 32; i += NWAVES * 64) cnts[i] = CNT[i];
    __syncthreads();
    if (F.tid < 32) { int t = 0, bsum = 0; for (int blk = 0; blk < F.G; ++blk) { const int c = cnts[blk * 32 + F.tid]; if (blk < F.bx) bsum += c; t += c; } tot[F.tid] = t; base[F.tid] = bsum; }
    __syncthreads();
    if (F.tid == 0) { int o = 0; for (int e = 0; e < 32; ++e) { offs[e] = o; o += (tot[e] + 255) & ~255; } offs[32] = o; }
    __syncthreads();
    if (F.bx == 0 && F.tid < 33) OFFT[F.tid] = offs[F.tid] >> 8;
    const int nlat = (TL / 128 - F.bx + F.G - 1) / F.G, nctx = (nrows > TL && F.bx < TC / 16) ? (TC / 16 - F.bx + F.G - 1) / F.G : 0;
    for (int idx = F.tid; idx < nlat * 128 + nctx * 16; idx += NWAVES * 64) {
        int row; if (idx < nlat * 128) row = (F.bx + (idx >> 7) * F.G) * 128 + (idx & 127); else { const int i2 = idx - nlat * 128; row = TL + (F.bx + (i2 >> 4) * F.G) * 16 + (i2 & 15); }
        { const i32x4 inf = *(const GAS i32x4*)(INFO + 4 * (size_t)row); const f32x2 w = *(const GAS f32x2*)(WTS + 2 * (size_t)row);
            const int d0 = offs[inf.x] + base[inf.x] + inf.z, d1 = offs[inf.y] + base[inf.y] + inf.w;
            ROWTOK[d0] = row; ROWW[d0] = w.x; ROWTOK[d1] = row; ROWW[d1] = w.y; DEST[2 * row] = d0; DEST[2 * row + 1] = d1; }
    }
    for (int e = F.bx; e < 32; e += F.G) for (int r = offs[e] + tot[e] + F.tid; r < offs[e + 1]; r += NWAVES * 64) { ROWTOK[r] = 0; ROWW[r] = 0.f; }
}

__device__ __forceinline__ LAS int* load_toff(const Frame& F0) {
    PHASE_FRAME(F0);
    LAS int* toff = (LAS int*)(F.lds + LDSCTL_OFF);
    if (F.tid < 33) toff[F.tid] = ((const int*)(F.ws + WS_RT + RT_OFF))[F.tid];
    __syncthreads();
    return toff;
}
constexpr int NPH_LAYER = 10, NPHASE = 1 + DEPTH * NPH_LAYER + 1;
struct Args { const float* in[24]; float* out; unsigned char* ws; int ph_lo, ph_hi; };
__global__ void __launch_bounds__(NWAVES * 64, 2) fwd_kernel(Args args) {
    extern __shared__ __attribute__((aligned(16))) unsigned char lds[];
    Frame F;
    F.lds = (LAS unsigned char*)lds;
    F.MISC = (volatile LAS unsigned*)(F.lds + MISC_OFF);
    F.tid = threadIdx.x; F.lane = F.tid & 63; F.wave = __builtin_amdgcn_readfirstlane(F.tid >> 6);
    F.G = gridDim.x; F.bx = blockIdx.x;
    F.ws = args.ws; F.out = args.out; F.ctl = (gu32*)(args.ws + WS_CTL);
    if (F.tid < 24) { const unsigned long long pv = (unsigned long long)args.in[F.tid]; ((LAS unsigned*)(F.lds + PTRS_OFF))[2 * F.tid] = (unsigned)pv; ((LAS unsigned*)(F.lds + PTRS_OFF))[2 * F.tid + 1] = (unsigned)(pv >> 32); }
    for (int u = F.tid + (MISC_OFF - LDSCTL_OFF) / 4; u < (LDS_BYTES - LDSCTL_OFF) / 4; u += NWAVES * 64) ((LAS unsigned*)(F.lds + LDSCTL_OFF))[u] = 0u;
    __syncthreads();
    XcdBarrier bar; bar.bar = (unsigned*)(F.ctl + CW_BAR); bar.x = 0; bar.st = nullptr;
    if (!MK_PER_PHASE) bar = xcd_barrier_post((unsigned*)(F.ctl + CW_BAR), F.MISC + 8);
    const int lo = args.ph_lo, hi = args.ph_hi;
#ifndef PHASE_MASK
#define PHASE_MASK 0xFFFFu
#endif
#define PH_ON(j) (((PHASE_MASK) >> (j)) & 1u)
#ifndef WGM_IN
#define WGM_IN 8
#endif
#ifndef WGM_G8
#define WGM_G8 8
#endif
#ifndef WGM_N1
#define WGM_N1 8
#endif
#ifndef SWAP_IN
#define SWAP_IN 0
#endif
#ifndef CV_FIRST
#define CV_FIRST 1
#endif
#ifndef STG_IN
#define STG_IN 0
#define STG_G8 0
#define STG_MG 0
#define STG_OUT 0
#define STG_M1 0
#define STG_M2 0
#endif
#define STGD(x) ((x) >= 0 ? (grpB ? (x) : 0) : (grpB ? 0 : -(x)))
#ifndef PROBE_KDIV
#define PROBE_KDIV 1
#endif
#ifndef REP_MASK
#define REP_MASK 0u
#endif
#define NREP(j) (1 + (int)(((REP_MASK) >> (j)) & 1u))
#define IN(k) (lo <= (k) && (k) < hi)
#define SEAM(k) do { if (IN(k) && IN((k) + 1)) { if (MK_PER_PHASE) { if (F.tid == 0) __hip_atomic_store(F.ctl + CW_TMO, 0xBADBA0u, RLX_AGENT); } else { xcd_barrier(bar); if (NREP(14) > 1) { xcd_barrier(bar); xcd_barrier(bar); } } } } while (0)

#ifdef POISON_WS
    if (IN(0)) {
#define POISON_RANGE(bit, lo, hi) if ((POISON_WS >> (bit)) & 1) { v4u* p = (v4u*)(F.ws + (lo)); const size_t n = ((hi) - (lo)) / 16; \
            for (size_t i = (size_t)F.bx * 512 + F.tid; i < n; i += (size_t)F.G * 512) p[i] = (v4u){0xFFFFFFFFu, 0xFFFFFFFFu, 0xFFFFFFFFu, 0xFFFFFFFFu}; }
        POISON_RANGE(0, WS_MOD, WS_W)
        POISON_RANGE(1, WS_W, WS_XN)
        POISON_RANGE(2, WS_XN, WS_Z)
        POISON_RANGE(3, Z_QF, Z_Y2)
        POISON_RANGE(4, Z_Y2, Z_KG)
        POISON_RANGE(5, Z_KG, Z_SG)
        POISON_RANGE(6, Z_SG, Z_DEC)
        POISON_RANGE(7, Z_DEC, WS_END)
        POISON_RANGE(8, W_DN1, WS_NEED)
        xcd_barrier(bar);
    }
#endif
    if (PH_ON(12) && IN(0)) { for (int rep_ = 0; rep_ < 1 + 3 * (NREP(12) - 1); ++rep_) p0_prologue(F); }
    SEAM(0);

#pragma unroll 1
    for (int l = 0; l < DEPTH; ++l) {
        const int pb = 1 + l * NPH_LAYER;
        const bool need_ctx = l < DEPTH - 1;
        const bool grpB = (F.bx >> 3) & 1;
        const int nrows = need_ctx ? TT : TL;
        unsigned char* W = F.ws + WS_W + (size_t)(l & 1) * W_PSTRIDE; unsigned char* WDN = F.ws + ((l & 1) ? W_DN1 : W_DN0);
        const int cv_rem = (nrows / 256 * 4) % F.G, cv_nw = (cv_rem ? F.G - cv_rem : F.G) * NWAVES, cv_id = cv_rem ? ((int)F.bx - cv_rem) * NWAVES + F.wave : (int)F.bx * NWAVES + F.wave;
        if (PH_ON(0) && IN(pb + 0)) { row_pass(F, l, l == 0 ? 0 : 1); for (int rep_ = 0; rep_ < NREP(0); ++rep_) { if (l == 0) convert_items(F, 0, 0, 1, F.bx * NWAVES + F.wave, F.G * NWAVES); if (!need_ctx) convert_layer(F, l, F.bx * NWAVES + F.wave, F.G * NWAVES); }     } SEAM(pb + 0);
        if (PH_ON(1) && IN(pb + 1)) { for (int rep_ = 0; rep_ < NREP(1); ++rep_) {
            pg8::Gemm g{WSP(bf16, WS_XN), (const bf16*)(W + W_IN), 1024, 1024, 1024, 0, nullptr, STGD(STG_IN)}; pg8::StaticOrder S; S.init(TT, 2048, F.G, F.bx, WGM_IN);
            pg8::EpiZ E{F.ws, l, INP(I_QNG) + l * 64, INP(I_KNG) + l * 64};
#pragma unroll 1
            for (int pass_ = 0; pass_ < 2; ++pass_) {
            if ((pass_ == 0) == !(SWAP_IN && grpB)) pg8::gemm_phase<pg8::EpiZ, pg8::StaticOrder, true, false>(F.lds + RING_OFF, g, S, E);
            else {
                pg8::Gemm g8{WSP(bf16, Z_OB), (const bf16*)(W + W_IN8), 512, 512, 512, 0, (const int*)(F.ws + WS_TAB + 65536), STGD(STG_G8)}; pg8::StaticOrder S8; S8.init(TT, 3328, F.G, F.bx, WGM_G8);
                pg8::EpiF8 E8{pg8::EpiGates{F.ws + Z_SG}, E};
                pg8::gemm_phase<pg8::EpiF8, pg8::StaticOrder, true, true, true, 0x7A7A7A7A, true>(F.lds + RING_OFF, g8, S8, E8);
            } }
        } } SEAM(pb + 1);
        if (PH_ON(2) && IN(pb + 2)) { for (int rep_ = 0; rep_ < NREP(2); ++rep_) { p3_scan(F); } } SEAM(pb + 2);
        if (PH_ON(3) && IN(pb + 3)) { if (NREP(3) > 1) p4_attention(F, l, need_ctx, (char*)lds + RING_OFF, true); p4_attention(F, l, need_ctx, (char*)lds + RING_OFF, false); p5_headnorm(F, l, nrows); } SEAM(pb + 3);
        if (PH_ON(5) && IN(pb + 4)) { for (int rep_ = 0; rep_ < NREP(5); ++rep_) {
            pg8::Gemm g{WSP(bf16, Z_Y2), (const bf16*)(W + W_UP), 1024, 1024, 1024, 0, nullptr, STGD(STG_MG)}; pg8::StaticOrder S; S.init(nrows, 1024, F.G, F.bx, need_ctx ? WGM_N1 : 8);
            pg8::EpiMergeF E{WSP(bf16, WS_XN), F.ws + Z_SG};
            const bool cv_first = CV_FIRST && grpB;
            if (need_ctx && cv_id >= 0 && cv_first) { convert_items(F, l + 1, 0, 2, cv_id, cv_nw); convert_layer(F, l, cv_id, cv_nw); __syncthreads(); }
            pg8::gemm_phase<pg8::EpiMergeF, pg8::StaticOrder, true, false>(F.lds + RING_OFF, g, S, E);
            if (need_ctx && cv_id >= 0 && !cv_first) { convert_items(F, l + 1, 0, 2, cv_id, cv_nw); convert_layer(F, l, cv_id, cv_nw); }
        } } SEAM(pb + 4);
        if (PH_ON(7) && IN(pb + 5)) {
            pg8::Gemm g{WSP(bf16, WS_XN), (const bf16*)(W + W_OUT), 1024, 1024, 1024, 0, nullptr, STGD(STG_OUT)}; pg8::StaticOrder S; S.init(nrows, 1024, F.G, F.bx, need_ctx ? WGM_N1 : 8);
            pg8::EpiOut E{l == DEPTH - 1 ? WSP(bf16, Z_SG) : (bf16*)F.out, (const bf16*)F.out, WSP(float, WS_MOD) + (size_t)l * 17 * 6144, INP(I_X), INP(I_CTX), l == 0};
            const bool cv_first = CV_FIRST && grpB;
            if (need_ctx && cv_id >= 0 && cv_first) { convert_items(F, l + 1, 1, 2, cv_id, cv_nw); __syncthreads(); }
            pg8::gemm_phase<pg8::EpiOut, pg8::StaticOrder, true, false>(F.lds + RING_OFF, g, S, E);
            if (need_ctx && cv_id >= 0 && !cv_first) convert_items(F, l + 1, 1, 2, cv_id, cv_nw);
        } SEAM(pb + 5);
        if (PH_ON(8) && IN(pb + 6)) { for (int rep_ = 0; rep_ < NREP(8); ++rep_) { p9_router(F, l, nrows); } } SEAM(pb + 6);
        if (PH_ON(9) && IN(pb + 7)) { for (int rep_ = 0; rep_ < NREP(9); ++rep_) { p10_dispatch(F, nrows); } } SEAM(pb + 7);
        if (PH_ON(10) && IN(pb + 8)) { for (int rep_ = 0; rep_ < NREP(10); ++rep_) {
            LAS int* toff = load_toff(F);
            pg8::Gemm g{WSP(bf16, WS_XN), (const bf16*)(W + W_GU), (NREP(10) > 1 && rep_ == 0) ? 512 / PROBE_KDIV : 512, 512, 512, (size_t)1024 * 512, (const int*)(F.ws + WS_RT + RT_ROWTOK), STGD(STG_M1)}; pg8::MoeOrder S{toff, F.G, F.bx};
            pg8::EpiSwiGLU E{F.ws + Z_H};
            pg8::gemm_phase<pg8::EpiSwiGLU, pg8::MoeOrder, true, true, true>(F.lds + RING_OFF, g, S, E);
        } } SEAM(pb + 8);
        if (PH_ON(11) && IN(pb + 9)) { for (int rep_ = 0; rep_ < NREP(11); ++rep_) {
            LAS int* toff = load_toff(F);
            pg8::Gemm g{WSP(bf16, Z_H), (const bf16*)(WDN), 256, 256, 256, (size_t)1024 * 256, (const int*)(F.ws + WS_TAB + 65536), STGD(STG_M2)}; pg8::MoeOrder S{toff, F.G, F.bx};
            pg8::EpiDown E{F.ws + Z_YB, (const float*)(F.ws + WS_RT + RT_ROWW)};
            pg8::gemm_phase<pg8::EpiDown, pg8::MoeOrder, true, true, true, 0x7B7B7B7B, true>(F.lds + RING_OFF, g, S, E);
        } } SEAM(pb + 9);
    }
    if (PH_ON(13) && IN(NPHASE - 1)) { row_pass(F, DEPTH, 2); }
#undef IN
#undef SEAM
}

extern "C" void kernel_launch(void* const* d_in, const int* in_sizes, int n_in, void* d_out, int out_size, void* d_ws, size_t ws_size, hipStream_t stream) {
    static int grid = 0;
    if (grid == 0) {
        if (n_in != 24 || in_sizes[0] != TL * D || out_size != TL * D || ws_size < WS_NEED) { fprintf(stderr, "kernel_launch: unexpected problem shape / workspace (%d inputs, ws %zu, need %zu); nothing launched\n", n_in, ws_size, (size_t)WS_NEED); grid = -1; return; }
        int dev = 0, cus = 0, per_cu = 0;
        if (hipGetDevice(&dev) != hipSuccess || hipDeviceGetAttribute(&cus, hipDeviceAttributeMultiprocessorCount, dev) != hipSuccess) { grid = -1; return; }
        if (hipFuncSetAttribute((const void*)fwd_kernel, hipFuncAttributeMaxDynamicSharedMemorySize, LDS_BYTES) != hipSuccess) { fprintf(stderr, "kernel_launch: hipFuncSetAttribute failed\n"); grid = -1; return; }
        if (hipOccupancyMaxActiveBlocksPerMultiprocessor(&per_cu, (const void*)fwd_kernel, NWAVES * 64, LDS_BYTES) != hipSuccess || per_cu < 1) { fprintf(stderr, "kernel_launch: occupancy query reports %d blocks per CU\n", per_cu); }
        (void)hipGetLastError();
        grid = cus;
        if (grid > 256) grid = 256;
    }
    if (grid < 0) return;
    if (hipMemsetAsync((char*)d_ws + WS_CTL, 0, CTL_ZERO_BYTES, stream) != hipSuccess) return;
    Args a{};
    for (int i = 0; i < 24; ++i) a.in[i] = (const float*)d_in[i];
    a.out = (float*)d_out; a.ws = (unsigned char*)d_ws;
#if MK_PER_PHASE
    for (int p = 0; p < NPHASE; ++p) { a.ph_lo = p; a.ph_hi = p + 1; hipLaunchKernelGGL(fwd_kernel, dim3(grid), dim3(NWAVES * 64), LDS_BYTES, stream, a); }
#else
    a.ph_lo = 0; a.ph_hi = NPHASE;
    hipLaunchKernelGGL(fwd_kernel, dim3(grid), dim3(NWAVES * 64), LDS_BYTES, stream, a);
#endif
    const hipError_t le = hipPeekAtLastError();
    if (le != hipSuccess) fprintf(stderr, "kernel_launch: launch failed: %s\n", hipGetErrorName(le));
}
```
